# Optimizing an MI355X kernel written in HIP

```python
import math
import jax, jax.numpy as jnp
from jax import lax
import numpy as np

D_MODEL = 1024
BATCH = 8
SEQ = 2048
DEPTH = 2

POOL_WINDOWS = (2, 4, 8, 16)
POOL_WIDTH = D_MODEL // 2
POOL_GROUP = POOL_WIDTH // len(POOL_WINDOWS)
ATTN_HEADS = 16
ATTN_HEAD_DIM = D_MODEL // ATTN_HEADS
ATTN_WIDTH = ATTN_HEADS * ATTN_HEAD_DIM
IDX_HEADS = 8
IDX_HEAD_DIM = 64
TOPK_MAX = 256
TOPK_DIVISOR = 4
Q_BLOCK = 128
REL_BUCKETS = 32
REL_MAX_DISTANCE = 128
S5_WIDTH = D_MODEL // 2
S5_GROUP = 16
S5_GROUPS = S5_WIDTH // S5_GROUP
S5_STATE = 64
DT_MIN = 1e-3
DT_MAX = 1e-1
N_BRANCHES = 3
FFN_HIDDEN = ((8 * D_MODEL // 3 + 255) // 256) * 256
NORM_EPS = 1e-6

IN_SIZES = (POOL_WIDTH, ATTN_WIDTH, ATTN_HEAD_DIM, ATTN_HEAD_DIM, IDX_HEADS * IDX_HEAD_DIM, IDX_HEAD_DIM, IDX_HEADS, S5_WIDTH, N_BRANCHES * D_MODEL)
IN_WIDTH = POOL_WIDTH + ATTN_WIDTH + 2 * ATTN_HEAD_DIM + IDX_HEADS * IDX_HEAD_DIM + IDX_HEAD_DIM + IDX_HEADS + S5_WIDTH + N_BRANCHES * D_MODEL

kernel_name = 'hybrid_gated_pool_dsa_s5_block'


def rms_norm(x, g):
    xf = x.astype(jnp.float32)
    y = xf * lax.rsqrt(jnp.mean(xf * xf, axis=-1, keepdims=True) + NORM_EPS)
    return (y * g.astype(jnp.float32)).astype(x.dtype)


def split_columns(z):
    parts = []
    start = 0
    for size in IN_SIZES:
        parts.append(z[..., start:start + size])
        start += size
    return parts


def pool_mixer(u, mix_w, scale):
    b, s, _ = u.shape
    uf = u.astype(jnp.float32)
    csum = jnp.cumsum(uf, axis=1)
    pos = jnp.arange(s, dtype=jnp.float32)[:, None]
    outs = []
    for gi, w in enumerate(POOL_WINDOWS):
        sl = slice(gi * POOL_GROUP, (gi + 1) * POOL_GROUP)
        c = csum[..., sl]
        c_prev = jnp.pad(c, ((0, 0), (w, 0), (0, 0)))[:, :s]
        count = jnp.minimum(pos + 1.0, float(w))
        outs.append((c - c_prev) / count - uf[..., sl])
    d = jnp.stack(outs, axis=2).astype(u.dtype)
    y = jnp.einsum('bsgc,gcd->bsgd', d, mix_w).reshape(b, s, POOL_WIDTH)
    return y * scale


def rel_bucket(dist):
    max_exact = REL_BUCKETS // 2
    d_f = jnp.maximum(dist, 1).astype(jnp.float32)
    large = max_exact + (jnp.log(d_f / max_exact) / math.log(REL_MAX_DISTANCE / max_exact) * (REL_BUCKETS - max_exact)).astype(jnp.int32)
    large = jnp.minimum(large, REL_BUCKETS - 1)
    return jnp.where(dist < max_exact, dist, large)


def sparse_attention(q, k, v, qi, ki, wi, rel_bias):
    b, s = q.shape[0], q.shape[1]
    topk = min(TOPK_MAX, s // TOPK_DIVISOR)
    nb = s // Q_BLOCK
    idx_scale = (IDX_HEADS ** -0.5) * (IDX_HEAD_DIM ** -0.5)
    attn_scale = ATTN_HEAD_DIM ** -0.5
    key_pos = jnp.arange(s, dtype=jnp.int32)
    gather = jax.vmap(lambda table, idx: table[idx])

    def to_blocks(a):
        return jnp.moveaxis(a.reshape((b, nb, Q_BLOCK) + a.shape[2:]), 1, 0)

    def block(args):
        qb, qib, wib, start = args
        q_pos = start + jnp.arange(Q_BLOCK, dtype=jnp.int32)
        causal = key_pos[None, :] <= q_pos[:, None]
        rel = jax.nn.relu(jnp.einsum('bqhd,bsd->bqhs', qib, ki))
        score = jnp.einsum('bqhs,bqh->bqs', rel, wib) * idx_scale
        score = jnp.where(causal[None], score, -jnp.inf)
        _, sel = lax.top_k(score, topk)
        k_sel = gather(k, sel)
        v_sel = gather(v, sel)
        dist = q_pos[None, :, None] - sel
        bias = rel_bias[rel_bucket(jnp.maximum(dist, 0))]
        logits = jnp.einsum('bqhd,bqkd->bqhk', qb, k_sel).astype(jnp.float32) * attn_scale
        logits = logits + jnp.moveaxis(bias, -1, 2).astype(jnp.float32)
        logits = jnp.where((dist >= 0)[:, :, None, :], logits, jnp.finfo(jnp.float32).min)
        p = jax.nn.softmax(logits, axis=-1).astype(v.dtype)
        return jnp.einsum('bqhk,bqkd->bqhd', p, v_sel)

    starts = jnp.arange(nb, dtype=jnp.int32) * Q_BLOCK
    out = lax.map(block, (to_blocks(q), to_blocks(qi), to_blocks(wi), starts))
    return jnp.moveaxis(out, 0, 1).reshape(b, s, ATTN_WIDTH)


def _ssm_combine(earlier, later):
    a1r, a1i, b1r, b1i = earlier
    a2r, a2i, b2r, b2i = later
    ar = a2r * a1r - a2i * a1i
    ai = a2r * a1i + a2i * a1r
    br = a2r * b1r - a2i * b1i + b2r
    bi = a2r * b1i + a2i * b1r + b2i
    return (ar, ai, br, bi)


def s5_mixer(u, lam_re, lam_im, log_dt, b_re, b_im, c_re, c_im, d_skip, glu_w):
    b, s, _ = u.shape
    uf = u.astype(jnp.float32)
    ug = uf.reshape(b, s, S5_GROUPS, S5_GROUP)
    dt = jnp.exp(log_dt.astype(jnp.float32))[:, None]
    lr = lam_re.astype(jnp.float32)
    li = lam_im.astype(jnp.float32)
    mag = jnp.exp(lr * dt)
    a_re = mag * jnp.cos(li * dt)
    a_im = mag * jnp.sin(li * dt)
    den = lr * lr + li * li
    coef_re = ((a_re - 1.0) * lr + a_im * li) / den
    coef_im = (a_im * lr - (a_re - 1.0) * li) / den
    br = b_re.astype(jnp.float32)
    bi = b_im.astype(jnp.float32)
    bbar_re = coef_re[..., None] * br - coef_im[..., None] * bi
    bbar_im = coef_re[..., None] * bi + coef_im[..., None] * br
    bu_re = jnp.einsum('bsgi,gni->bsgn', ug, bbar_re)
    bu_im = jnp.einsum('bsgi,gni->bsgn', ug, bbar_im)
    a_re_t = jnp.broadcast_to(a_re[None, None], (1, s, S5_GROUPS, S5_STATE))
    a_im_t = jnp.broadcast_to(a_im[None, None], (1, s, S5_GROUPS, S5_STATE))
    _, _, x_re, x_im = lax.associative_scan(_ssm_combine, (a_re_t, a_im_t, bu_re, bu_im), axis=1)
    y = jnp.einsum('bsgn,gin->bsgi', x_re, c_re.astype(jnp.float32)) - jnp.einsum('bsgn,gin->bsgi', x_im, c_im.astype(jnp.float32))
    y = y.reshape(b, s, S5_WIDTH) + d_skip.astype(jnp.float32) * uf
    z = jax.nn.gelu(y).astype(u.dtype)
    a, g = jnp.split(z @ glu_w, 2, axis=-1)
    return a * jax.nn.sigmoid(g)


def setup_inputs(seed: int = 0) -> dict:
    key = jax.random.key(seed)
    ks = jax.random.split(key, 24)
    f32 = jnp.float32

    def nrm(k, shape, scale):
        return jax.random.normal(k, shape, f32) * scale

    def gain(k, width):
        return 1.0 + 0.02 * jax.random.normal(k, (DEPTH, width), f32)

    lam_im0 = jnp.pi * jnp.arange(S5_STATE, dtype=f32)
    return {
        'x': nrm(ks[0], (BATCH, SEQ, D_MODEL), 1.0),
        'norm_mix_pre': gain(ks[1], D_MODEL),
        'norm_mix_post': gain(ks[2], D_MODEL),
        'norm_ffn_pre': gain(ks[3], D_MODEL),
        'norm_ffn_post': gain(ks[4], D_MODEL),
        'w_in': nrm(ks[5], (DEPTH, D_MODEL, IN_WIDTH), D_MODEL ** -0.5),
        'pool_mix_w': nrm(ks[6], (DEPTH, len(POOL_WINDOWS), POOL_GROUP, POOL_GROUP), POOL_GROUP ** -0.5),
        'pool_scale': gain(ks[7], POOL_WIDTH),
        'pool_out_w': nrm(ks[8], (DEPTH, POOL_WIDTH, D_MODEL), POOL_WIDTH ** -0.5),
        'attn_out_w': nrm(ks[9], (DEPTH, ATTN_WIDTH, D_MODEL), ATTN_WIDTH ** -0.5),
        'rel_bias': nrm(ks[10], (REL_BUCKETS, ATTN_HEADS), 0.5),
        's5_lambda_re': -0.5 + 0.01 * jax.random.normal(ks[11], (DEPTH, S5_GROUPS, S5_STATE), f32),
        's5_lambda_im': lam_im0[None, None, :] + 0.01 * jax.random.normal(ks[12], (DEPTH, S5_GROUPS, S5_STATE), f32),
        's5_log_dt': jax.random.uniform(ks[13], (DEPTH, S5_GROUPS), f32, math.log(DT_MIN), math.log(DT_MAX)),
        's5_b_re': nrm(ks[14], (DEPTH, S5_GROUPS, S5_STATE, S5_GROUP), (2 * S5_GROUP) ** -0.5),
        's5_b_im': nrm(ks[15], (DEPTH, S5_GROUPS, S5_STATE, S5_GROUP), (2 * S5_GROUP) ** -0.5),
        's5_c_re': nrm(ks[16], (DEPTH, S5_GROUPS, S5_GROUP, S5_STATE), S5_STATE ** -0.5),
        's5_c_im': nrm(ks[17], (DEPTH, S5_GROUPS, S5_GROUP, S5_STATE), S5_STATE ** -0.5),
        's5_d': nrm(ks[18], (DEPTH, S5_WIDTH), 1.0),
        's5_glu_w': nrm(ks[19], (DEPTH, S5_WIDTH, 2 * D_MODEL), S5_WIDTH ** -0.5),
        'w_out': nrm(ks[20], (DEPTH, D_MODEL, D_MODEL), D_MODEL ** -0.5),
        'ffn_w_in': nrm(ks[21], (DEPTH, D_MODEL, 2 * FFN_HIDDEN), D_MODEL ** -0.5),
        'ffn_w_out': nrm(ks[22], (DEPTH, FFN_HIDDEN, D_MODEL), FFN_HIDDEN ** -0.5),
    }


def reference(x, norm_mix_pre, norm_mix_post, norm_ffn_pre, norm_ffn_post, w_in, pool_mix_w, pool_scale, pool_out_w, attn_out_w, rel_bias, s5_lambda_re, s5_lambda_im, s5_log_dt, s5_b_re, s5_b_im, s5_c_re, s5_c_im, s5_d, s5_glu_w, w_out, ffn_w_in, ffn_w_out):
    b, s, _ = x.shape
    for l in range(DEPTH):
        h = rms_norm(x, norm_mix_pre[l])
        z = h @ w_in[l]
        pool_u, q, k, v, qi, ki, wi, s5_u, gates = split_columns(z)
        y_pool = pool_mixer(pool_u, pool_mix_w[l], pool_scale[l]) @ pool_out_w[l]
        y_attn = sparse_attention(q.reshape(b, s, ATTN_HEADS, ATTN_HEAD_DIM), k, v, qi.reshape(b, s, IDX_HEADS, IDX_HEAD_DIM), ki, wi, rel_bias) @ attn_out_w[l]
        y_s5 = s5_mixer(s5_u, s5_lambda_re[l], s5_lambda_im[l], s5_log_dt[l], s5_b_re[l], s5_b_im[l], s5_c_re[l], s5_c_im[l], s5_d[l], s5_glu_w[l])
        g = jax.nn.sigmoid(gates.reshape(b, s, N_BRANCHES, D_MODEL))
        merged = g[:, :, 0] * y_pool + g[:, :, 1] * y_attn + g[:, :, 2] * y_s5
        x = x + rms_norm(merged @ w_out[l], norm_mix_post[l])
        h = rms_norm(x, norm_ffn_pre[l])
        gate, up = jnp.split(h @ ffn_w_in[l], 2, axis=-1)
        f = (jax.nn.silu(gate) * up) @ ffn_w_out[l]
        x = x + rms_norm(f, norm_ffn_post[l])
    return x
```

```cpp
#include <hip/hip_runtime.h>
#include <cstdio>
#include <cstdint>
namespace pg8 {
#define PG8_LAS __attribute__((address_space(3)))
typedef unsigned short bf16_t;
typedef short bf16x8 __attribute__((ext_vector_type(8)));
typedef float f32x4 __attribute__((ext_vector_type(4)));
typedef unsigned u32x4 __attribute__((ext_vector_type(4)));
constexpr int BM = 256, BK = 64, HALF = 128, HTB = HALF * BK * 2  , STAGE_BYTES = 8 * HTB, NXCD = 8, WGM = 8;

__host__ __device__ __forceinline__ int lds_byte(int r, int c) { const int st = (r >> 4) * 2 + (c >> 5), rr = r & 15, cc = c & 31, ob = rr * 64 + cc * 2; return st * 1024 + (ob ^ (((ob >> 9) & 1) << 5)); }
__host__ __device__ __forceinline__ void stage_rc(int b, int& R, int& C) { const int st = b / 1024, sb = b % 1024, swz = sb ^ (((sb >> 9) & 1) << 5); R = (st >> 1) * 16 + swz / 64; C = (st & 1) * 32 + (swz % 64) / 2; }
__host__ __device__ __forceinline__ int perm32(int rho) { const int n = rho >> 4, i = rho & 15; return 8 * (i >> 2) + 4 * n + (i & 3); }

struct Unit { int pm, pn; };
struct Gemm { const bf16_t* A; const bf16_t* Bt; int M, N, K; };

struct StaticOrder {
    int nM, nN, nwg, G, c;
    __host__ __device__ void init(int M, int N, int G_, int c_) { nM = M / BM; nN = N / BM; nwg = nM * nN; G = G_; c = c_; }
    __host__ __device__ bool next(int i, Unit& u) const {
        const long L = (long)i * G + c; if (L >= nwg) return false;
        int wgid = (int)L; { const int q = nwg / NXCD, r = nwg % NXCD, xcd = wgid % NXCD, off = wgid / NXCD; wgid = (xcd < r ? xcd * (q + 1) : r * (q + 1) + (xcd - r) * q) + off; }
        const int nig = WGM * nN, gid = wgid / nig, fm = gid * WGM, gsz = (nM - fm) < WGM ? (nM - fm) : WGM;
        u.pm = fm + ((wgid % nig) % gsz); u.pn = (wgid % nig) / gsz; return true;
    }
    __device__ __forceinline__ void a_ready(const Unit&) const {}
    __device__ __forceinline__ void done(const Unit&) const {}
};

__device__ __forceinline__ unsigned cvt_pk_bf16(float lo, float hi) { unsigned r; asm volatile("v_cvt_pk_bf16_f32 %0, %1, %2" : "=v"(r) : "v"(lo), "v"(hi)); return r; }
typedef float f32x2 __attribute__((ext_vector_type(2)));
__device__ __forceinline__ float sigm(float x) { return __builtin_amdgcn_rcpf(1.0f + __expf(-x)); }
__device__ __forceinline__ float bf_lo(unsigned w) { return __uint_as_float(w << 16); }
__device__ __forceinline__ float bf_hi(unsigned w) { return __uint_as_float(w & 0xffff0000u); }
__device__ __forceinline__ u32x4 pack8(const f32x4& v0, const f32x4& v1) { u32x4 w; w.x = cvt_pk_bf16(v0[0], v0[1]); w.y = cvt_pk_bf16(v0[2], v0[3]); w.z = cvt_pk_bf16(v1[0], v1[1]); w.w = cvt_pk_bf16(v1[2], v1[3]); return w; }

struct EpiF32 {
    static constexpr bool PERM = false, AFTER_DRAIN = false;
    float* C; int ldc;
    __device__ __forceinline__ void operator()(const f32x4 (&acc)[2][2][4][2], const Unit& u, int wr, int wc, int fr, int fq) const {
        const int row0 = u.pm * BM + wr * 64 + fr, col0 = u.pn * BM + wc * 32 + 4 * fq;
#pragma unroll
        for (int ai = 0; ai < 2; ++ai)
#pragma unroll
            for (int m = 0; m < 4; ++m) { float* rowp = C + (size_t)(row0 + ai * HALF + m * 16) * ldc + col0;
#pragma unroll
                for (int bj = 0; bj < 2; ++bj)
#pragma unroll
                    for (int n = 0; n < 2; ++n) *(f32x4*)(rowp + bj * HALF + n * 16) = acc[ai][bj][m][n]; }
    }
};
struct EpiRoute {
    static constexpr bool PERM = true, AFTER_DRAIN = false;
    bf16_t *poolu, *s5u, *q, *qi, *kvx, *gates;
    __device__ __forceinline__ void operator()(const f32x4 (&acc)[2][2][4][2], const Unit& u, int wr, int wc, int fr, int fq) const {
        const int row0 = u.pm * BM + wr * 64 + fr; const int pn = u.pn;
        bf16_t* base; int ld, colt, mode = 0;
        if (pn < 2) { base = poolu; ld = 512; colt = pn * 256; }
        else if (pn < 4) { base = s5u; ld = 512; colt = (pn - 2) * 256; }
        else if (pn < 8) { base = q; ld = 1024; colt = (pn - 4) * 256; mode = 2; }
        else if (pn < 10) { base = qi; ld = 512; colt = (pn - 8) * 256; }
        else if (pn == 10) { base = kvx; ld = 256; colt = 0; }
        else { base = gates; ld = 3072; colt = (pn - 11) * 256; mode = 1; }
        const int col0 = colt + wc * 32 + 8 * fq;
#pragma unroll
        for (int ai = 0; ai < 2; ++ai)
#pragma unroll
            for (int m = 0; m < 4; ++m) { bf16_t* rowp = base + (size_t)(row0 + ai * HALF + m * 16) * ld + col0;
#pragma unroll
                for (int bj = 0; bj < 2; ++bj) { f32x4 v0 = acc[ai][bj][m][0], v1 = acc[ai][bj][m][1];
                    if (mode == 1) {
#pragma unroll
                        for (int j = 0; j < 4; ++j) { v0[j] = sigm(v0[j]); v1[j] = sigm(v1[j]); } }
                    else if (mode == 2) { v0 = v0 * 0.125f; v1 = v1 * 0.125f; }
                    *(u32x4*)(rowp + bj * HALF) = pack8(v0, v1); } }
    }
};
struct EpiGlu {
    static constexpr bool PERM = true, AFTER_DRAIN = false;
    bf16_t* merged; const bf16_t* gates;
    __device__ __forceinline__ void operator()(const f32x4 (&acc)[2][2][4][2], const Unit& u, int wr, int wc, int fr, int fq) const {
        const int row0 = u.pm * BM + wr * 64 + fr, col0 = u.pn * HALF + wc * 32 + 8 * fq;
#pragma unroll
        for (int ai = 0; ai < 2; ++ai)
#pragma unroll
            for (int m = 0; m < 4; ++m) { const size_t row = (size_t)(row0 + ai * HALF + m * 16);
                const u32x4 g = *(const u32x4*)(gates + row * 3072 + 2048 + col0);
                f32x4 a0 = acc[ai][0][m][0], a1 = acc[ai][0][m][1]; const f32x4 s0 = acc[ai][1][m][0], s1 = acc[ai][1][m][1];
#pragma unroll
                for (int j = 0; j < 4; ++j) { a0[j] *= sigm(s0[j]); a1[j] *= sigm(s1[j]); }
                a0[0] *= bf_lo(g.x); a0[1] *= bf_hi(g.x); a0[2] *= bf_lo(g.y); a0[3] *= bf_hi(g.y);
                a1[0] *= bf_lo(g.z); a1[1] *= bf_hi(g.z); a1[2] *= bf_lo(g.w); a1[3] *= bf_hi(g.w);
                *(u32x4*)(merged + row * 1024 + col0) = pack8(a0, a1);
                asm volatile("" ::: "memory"); }
    }
};
template <int GOFF> struct EpiAccum {
    static constexpr bool PERM = true, AFTER_DRAIN = false;
    bf16_t* merged; const bf16_t* gates;
    __device__ __forceinline__ void operator()(const f32x4 (&acc)[2][2][4][2], const Unit& u, int wr, int wc, int fr, int fq) const {
        const int row0 = u.pm * BM + wr * 64 + fr, col0 = u.pn * BM + wc * 32 + 8 * fq;
#pragma unroll
        for (int ai = 0; ai < 2; ++ai)
#pragma unroll
            for (int m = 0; m < 4; ++m) { const size_t row = (size_t)(row0 + ai * HALF + m * 16);
#pragma unroll
                for (int bj = 0; bj < 2; ++bj) { const int c = col0 + bj * HALF;
                    const u32x4 g = *(const u32x4*)(gates + row * 3072 + GOFF + c); const u32x4 o = *(const u32x4*)(merged + row * 1024 + c);
                    f32x4 a0 = acc[ai][bj][m][0], a1 = acc[ai][bj][m][1];
                    a0[0] = a0[0] * bf_lo(g.x) + bf_lo(o.x); a0[1] = a0[1] * bf_hi(g.x) + bf_hi(o.x); a0[2] = a0[2] * bf_lo(g.y) + bf_lo(o.y); a0[3] = a0[3] * bf_hi(g.y) + bf_hi(o.y);
                    a1[0] = a1[0] * bf_lo(g.z) + bf_lo(o.z); a1[1] = a1[1] * bf_hi(g.z) + bf_hi(o.z); a1[2] = a1[2] * bf_lo(g.w) + bf_lo(o.w); a1[3] = a1[3] * bf_hi(g.w) + bf_hi(o.w);
                    *(u32x4*)(merged + row * 1024 + c) = pack8(a0, a1); }
                asm volatile("" ::: "memory"); }
    }
};
struct EpiSwiglu {
    static constexpr bool PERM = true, AFTER_DRAIN = false;
    bf16_t* hid; int ldh;
    __device__ __forceinline__ void operator()(const f32x4 (&acc)[2][2][4][2], const Unit& u, int wr, int wc, int fr, int fq) const {
        const int row0 = u.pm * BM + wr * 64 + fr, col0 = u.pn * HALF + wc * 32 + 8 * fq;
#pragma unroll
        for (int ai = 0; ai < 2; ++ai)
#pragma unroll
            for (int m = 0; m < 4; ++m) { const size_t row = (size_t)(row0 + ai * HALF + m * 16);
                f32x4 g0 = acc[ai][0][m][0], g1 = acc[ai][0][m][1]; const f32x4 u0 = acc[ai][1][m][0], u1 = acc[ai][1][m][1];
#pragma unroll
                for (int j = 0; j < 4; ++j) { g0[j] = g0[j] * sigm(g0[j]) * u0[j]; g1[j] = g1[j] * sigm(g1[j]) * u1[j]; }
                *(u32x4*)(hid + row * ldh + col0) = pack8(g0, g1); }
    }
};
struct PairOrder {
    StaticOrder base;
    __device__ bool next(int i, Unit& u) const { Unit b; if (!base.next(i >> 1, b)) return false; u.pm = b.pm; u.pn = 2 * b.pn + (i & 1); return true; }
    __device__ __forceinline__ void a_ready(const Unit&) const {}
    __device__ __forceinline__ void done(const Unit&) const {}
};

template <class Epi, class Sched, bool ALIGN_EPI = false, bool SP2 = false>
__device__ __forceinline__ void gemm_phase(PG8_LAS unsigned char* lds, const Gemm g, const Sched& S, const Epi& E) {
    int tid_ = threadIdx.x; asm volatile("" : "+v"(tid_));
    const int tid = tid_, wid = __builtin_amdgcn_readfirstlane(tid >> 6), lane = tid & 63, wr = wid >> 2, wc = wid & 3, fr = lane & 15, fq = lane >> 4;
    const int K = g.K, nt = K / BK;
    unsigned voffA[2], voffB[2];
#pragma unroll
    for (int i = 0; i < 2; ++i) { int R, C; stage_rc(tid * 16 + i * 8192, R, C); const int Rb = Epi::PERM ? ((R & ~31) + perm32(R & 31)) : R;
        voffA[i] = (unsigned)(R * K + C) * 2u; voffB[i] = (unsigned)(Rb * K + C) * 2u; }
    const size_t kstep = (size_t)(BK * 2);
    const size_t hstep = (size_t)HALF * K * 2;
    const size_t tstep = 2 * hstep;
    const unsigned ldsw = (unsigned)wid * 1024u;
    const int aoff = lds_byte(wr * 64 + fr, fq * 8), boff = lds_byte(wc * 32 + fr, fq * 8);
#define PG8_SA(b, h) (((b) * 2 + (h)) * HTB)
#define PG8_SB(b, h) ((4 + (b) * 2 + (h)) * HTB)
#define PG8_STAGE(bufoff, gbase, voff) do { _Pragma("unroll") for (int _i = 0; _i < 2; ++_i) \
        __builtin_amdgcn_global_load_lds((const unsigned*)((const char*)(gbase) + (voff)[_i]), (PG8_LAS unsigned*)(lds + (bufoff) + ldsw + _i * 8192), 16, 0, 0); } while (0)
#define PG8_LDA(dst, b, h) do { _Pragma("unroll") for (int m = 0; m < 4; ++m) _Pragma("unroll") for (int k = 0; k < 2; ++k) dst[m][k] = *(const PG8_LAS bf16x8*)(lds + PG8_SA(b, h) + aoff + m * 2048 + k * 1024); } while (0)
#define PG8_LDB(dst, b, h) do { _Pragma("unroll") for (int n = 0; n < 2; ++n) _Pragma("unroll") for (int k = 0; k < 2; ++k) dst[n][k] = *(const PG8_LAS bf16x8*)(lds + PG8_SB(b, h) + boff + n * 2048 + k * 1024); } while (0)
#define PG8_MMA(ai, bj, At, Bt) do { __builtin_amdgcn_s_setprio(1); _Pragma("unroll") for (int m = 0; m < 4; ++m) _Pragma("unroll") for (int n = 0; n < 2; ++n) _Pragma("unroll") for (int k = 0; k < 2; ++k) \
        acc[ai][bj][m][n] = __builtin_amdgcn_mfma_f32_16x16x32_bf16(Bt[n][k], At[m][k], acc[ai][bj][m][n], 0, 0, 0); __builtin_amdgcn_s_setprio(0); } while (0)
#define PG8_WAIT_V(n) asm volatile("s_waitcnt vmcnt(" #n ")" ::: "memory")
#define PG8_WAIT_L(n) asm volatile("s_waitcnt lgkmcnt(" #n ")" ::: "memory")
#define PG8_BAR __builtin_amdgcn_s_barrier()
#define PG8_SCHED __builtin_amdgcn_sched_barrier(0)
    Unit cur, nxt; int ui = 0;
    if (!S.next(0, cur)) return;
    f32x4 acc[2][2][4][2];
#pragma unroll
    for (int a = 0; a < 2; ++a)
#pragma unroll
        for (int b = 0; b < 2; ++b)
#pragma unroll
            for (int m = 0; m < 4; ++m)
#pragma unroll
                for (int n = 0; n < 2; ++n) acc[a][b][m][n] = (f32x4){0.f, 0.f, 0.f, 0.f};
    bf16x8 At[4][2], B0[2][2], B1[2][2];
    const char* cA = (const char*)g.A + (size_t)cur.pm * tstep; const char* cB = (const char*)g.Bt + (size_t)cur.pn * tstep;
    S.a_ready(cur);
    if constexpr (SP2) {
        PG8_STAGE(PG8_SB(0, 0), cB, voffB); PG8_STAGE(PG8_SB(0, 1), cB + hstep, voffB); PG8_STAGE(PG8_SA(0, 0), cA, voffA); PG8_STAGE(PG8_SA(0, 1), cA + hstep, voffA);
        if (wr == 1) PG8_BAR;
        PG8_WAIT_V(2); PG8_BAR;
        PG8_STAGE(PG8_SB(1, 0), cB + kstep, voffB); PG8_STAGE(PG8_SA(1, 0), cA + kstep, voffA); PG8_STAGE(PG8_SB(1, 1), cB + hstep + kstep, voffB);
        PG8_WAIT_V(6); PG8_BAR;
    } else {
        PG8_STAGE(PG8_SB(0, 0), cB, voffB); PG8_STAGE(PG8_SA(0, 0), cA, voffA); PG8_STAGE(PG8_SB(0, 1), cB + hstep, voffB); PG8_STAGE(PG8_SA(0, 1), cA + hstep, voffA);
        if (wr == 1) PG8_BAR;
        PG8_WAIT_V(4); PG8_BAR;
        PG8_STAGE(PG8_SB(1, 0), cB + kstep, voffB); PG8_STAGE(PG8_SA(1, 0), cA + kstep, voffA); PG8_STAGE(PG8_SB(1, 1), cB + hstep + kstep, voffB);
        PG8_WAIT_V(6); PG8_BAR;
    }
    for (;;) {
        const bool has_next = S.next(ui + 1, nxt);
        const char* nA = has_next ? (const char*)g.A + (size_t)nxt.pm * tstep : cA; const char* nB = has_next ? (const char*)g.Bt + (size_t)nxt.pn * tstep : cB;
        for (int t = 0; t < nt; t += 2) {
            const bool last = (t == nt - 2);
            const char* a1 = cA + (size_t)(t + 1) * kstep;
            const char* a2 = last ? nA : cA + (size_t)(t + 2) * kstep; const char* b2 = last ? nB : cB + (size_t)(t + 2) * kstep;
            const char* a3 = a2 + kstep; const char* b3 = b2 + kstep;
            if (last && has_next) S.a_ready(nxt);
            if constexpr (SP2) {
            PG8_LDB(B0, 0, 0); PG8_LDB(B1, 0, 1); PG8_SCHED; PG8_LDA(At, 0, 0); PG8_STAGE(PG8_SA(1, 1), a1 + hstep, voffA);
            PG8_WAIT_V(8); PG8_WAIT_L(0); PG8_BAR; PG8_MMA(0, 0, At, B0); PG8_MMA(0, 1, At, B1); PG8_BAR; PG8_SCHED;
            PG8_LDA(At, 0, 1); PG8_STAGE(PG8_SB(0, 0), b2, voffB); PG8_STAGE(PG8_SB(0, 1), b2 + hstep, voffB); PG8_STAGE(PG8_SA(0, 0), a2, voffA);
            PG8_WAIT_V(8); PG8_WAIT_L(0); PG8_BAR; PG8_MMA(1, 0, At, B0); PG8_MMA(1, 1, At, B1); PG8_BAR; PG8_SCHED;
            PG8_LDB(B0, 1, 0); PG8_LDB(B1, 1, 1); PG8_SCHED; PG8_LDA(At, 1, 0); PG8_STAGE(PG8_SA(0, 1), a2 + hstep, voffA);
            PG8_WAIT_V(8); PG8_WAIT_L(0); PG8_BAR; PG8_MMA(0, 0, At, B0); PG8_MMA(0, 1, At, B1); PG8_BAR; PG8_SCHED;
            PG8_LDA(At, 1, 1); PG8_STAGE(PG8_SB(1, 0), b3, voffB); PG8_STAGE(PG8_SB(1, 1), b3 + hstep, voffB); PG8_STAGE(PG8_SA(1, 0), a3, voffA);
            PG8_WAIT_V(8); PG8_WAIT_L(0); PG8_BAR; PG8_MMA(1, 0, At, B0); PG8_MMA(1, 1, At, B1); PG8_BAR; PG8_SCHED;
            } else {
            PG8_LDB(B0, 0, 0); PG8_SCHED; PG8_LDA(At, 0, 0); PG8_STAGE(PG8_SA(1, 1), a1 + hstep, voffA);
            PG8_WAIT_L(8); PG8_BAR; PG8_WAIT_L(0); PG8_MMA(0, 0, At, B0); PG8_BAR; PG8_SCHED;
            PG8_LDB(B1, 0, 1); PG8_STAGE(PG8_SB(0, 0), b2, voffB);
            PG8_BAR; PG8_WAIT_L(0); PG8_MMA(0, 1, At, B1); PG8_BAR;
            PG8_LDA(At, 0, 1); PG8_STAGE(PG8_SA(0, 0), a2, voffA);
            PG8_BAR; PG8_WAIT_L(0); PG8_MMA(1, 0, At, B0); PG8_BAR; PG8_SCHED;
            PG8_STAGE(PG8_SB(0, 1), b2 + hstep, voffB);
            PG8_WAIT_V(6); PG8_BAR; PG8_MMA(1, 1, At, B1); PG8_BAR;
            PG8_LDB(B0, 1, 0); PG8_SCHED; PG8_LDA(At, 1, 0); PG8_STAGE(PG8_SA(0, 1), a2 + hstep, voffA);
            PG8_WAIT_L(8); PG8_BAR; PG8_WAIT_L(0); PG8_MMA(0, 0, At, B0); PG8_BAR; PG8_SCHED;
            PG8_LDB(B1, 1, 1); PG8_STAGE(PG8_SB(1, 0), b3, voffB);
            PG8_BAR; PG8_WAIT_L(0); PG8_MMA(0, 1, At, B1); PG8_BAR;
            PG8_LDA(At, 1, 1); PG8_STAGE(PG8_SA(1, 0), a3, voffA);
            PG8_BAR; PG8_WAIT_L(0); PG8_MMA(1, 0, At, B0); PG8_BAR; PG8_SCHED;
            PG8_STAGE(PG8_SB(1, 1), b3 + hstep, voffB);
            PG8_WAIT_V(6); PG8_BAR; PG8_MMA(1, 1, At, B1); PG8_BAR;
            }
        }
        if constexpr (ALIGN_EPI) { if (wr == 0) PG8_BAR; }
        if constexpr (!Epi::AFTER_DRAIN) { E(acc, cur, wr, wc, fr, fq); S.done(cur); }
        if (!has_next) break;
#pragma unroll
        for (int a = 0; a < 2; ++a)
#pragma unroll
            for (int b = 0; b < 2; ++b)
#pragma unroll
                for (int m = 0; m < 4; ++m)
#pragma unroll
                    for (int n = 0; n < 2; ++n) acc[a][b][m][n] = (f32x4){0.f, 0.f, 0.f, 0.f};
        cur = nxt; cA = nA; cB = nB; ++ui;
        if constexpr (ALIGN_EPI) { if (wr == 1) PG8_BAR; }
    }
    PG8_WAIT_V(0);
    if constexpr (!ALIGN_EPI) { if (wr == 0) PG8_BAR; }
    PG8_BAR;
    if constexpr (Epi::AFTER_DRAIN) { E.fused(acc, cur, wr, wc, fr, fq, lds, wid, lane); S.done(cur); }
#undef PG8_SA
#undef PG8_SB
#undef PG8_STAGE
#undef PG8_LDA
#undef PG8_LDB
#undef PG8_MMA
#undef PG8_WAIT_V
#undef PG8_WAIT_L
#undef PG8_BAR
#undef PG8_SCHED
}
}

constexpr int NWAVES = 8;
constexpr int BATCH = 8, SEQ = 2048, D = 1024, M = BATCH * SEQ;
constexpr int INW = 5832, N1P = 5888, FF = 2816, NLAYER = 2;
constexpr float NORM_EPS = 1e-6f;
constexpr size_t MiB = 1u << 20;
constexpr size_t WS_CTL = 0, CTL_ZERO_BYTES = 1 * MiB;
constexpr size_t WS_WINT = 1 * MiB;
constexpr size_t WS_ATTNOT = WS_WINT + (size_t)N1P * D * 2;
constexpr size_t WS_POOLET = WS_ATTNOT + 2 * MiB;
constexpr size_t WS_GLUT = WS_POOLET + 1 * MiB;
constexpr size_t WS_WOUTT = WS_GLUT + 2 * MiB;
constexpr size_t WS_S5T = WS_WOUTT + 2 * MiB;
constexpr size_t WS_S5P = WS_S5T + 4 * MiB;
constexpr size_t WS_S5Q = WS_S5P + 2 * MiB;
constexpr size_t WS_S5A = WS_S5Q + 2 * MiB;
constexpr size_t WS_BIAS = WS_S5A + 65536;
static_assert(WS_BIAS + 8192 <= 29 * MiB, "weights region");
constexpr size_t WS_HB = 29 * MiB;
constexpr size_t WS_DP = WS_HB, WS_ZB = WS_HB + 16 * MiB;
constexpr size_t WS_POOLU = 61 * MiB, WS_S5U = 77 * MiB;
constexpr size_t WS_MERGED = WS_POOLU;
constexpr size_t WS_FFNINT = WS_POOLU, WS_FFNOUTT = WS_POOLU + 11 * MiB;
constexpr size_t WS_Q = 93 * MiB, WS_QI = 125 * MiB, WS_KVX = 141 * MiB, WS_GATES = 149 * MiB;
constexpr size_t WS_F = WS_Q;
constexpr size_t WS_HID = 157 * MiB;
constexpr size_t WS_END = 245 * MiB;
static_assert(WS_FFNOUTT + (size_t)D * FF * 2 <= WS_Q && WS_HID + (size_t)M * FF * 2 <= WS_END && WS_F + (size_t)M * D * 4 <= WS_HID, "d_ws map");
constexpr int CW_BAR = 4096;
constexpr int RING_OFF = 0, RING_BYTES = 131072;
constexpr int LDSCTL_OFF = RING_BYTES, MISC_OFF = LDSCTL_OFF + 320;
constexpr int LDS_BYTES = 147456;
constexpr int NPHASE = 1 + 8 * NLAYER;

#define GAS __attribute__((address_space(1)))
#define LAS __attribute__((address_space(3)))
typedef unsigned short bf16;
typedef unsigned v4u __attribute__((ext_vector_type(4)));
typedef float f32x4 __attribute__((ext_vector_type(4)));
typedef short bf16x8 __attribute__((ext_vector_type(8)));
typedef GAS unsigned gu32;
typedef GAS unsigned long long gu64;
#define RLX_AGENT __ATOMIC_RELAXED, __HIP_MEMORY_SCOPE_AGENT
#define LDS_WAIT() asm volatile("s_waitcnt lgkmcnt(0)" ::: "memory")
#define VM_WAIT() asm volatile("s_waitcnt vmcnt(0)" ::: "memory")
__device__ __forceinline__ unsigned long long rt() { return __builtin_amdgcn_s_memrealtime(); }
__device__ __forceinline__ unsigned f2bf(float f) { unsigned u = __builtin_bit_cast(unsigned, f); return (u + 0x7fffu + ((u >> 16) & 1u)) >> 16; }
__device__ __forceinline__ unsigned pk2(float lo, float hi) { return f2bf(lo) | (f2bf(hi) << 16); }
#define XB_TMO      128
#define XB_XCNT(j)  (256  + 64 * (j))
#define XB_XSUB(j)  (1280 + 64 * (j))
#define XB_XGEN(j)  (2304 + 64 * (j))
#define XB_TOP      3328
#define XB_TOPGEN   3392
#define XCD_BAR_WORDS 3456
#define XB_SPIN_CAP (1u << 18)

__device__ __forceinline__ unsigned xb_ld(unsigned* p)              { return __hip_atomic_load(p, __ATOMIC_RELAXED, __HIP_MEMORY_SCOPE_AGENT); }
__device__ __forceinline__ unsigned xb_add(unsigned* p, unsigned v) { return __hip_atomic_fetch_add(p, v, __ATOMIC_RELAXED, __HIP_MEMORY_SCOPE_AGENT); }
__device__ __forceinline__ unsigned xb_xcc_id() { return (unsigned)__builtin_amdgcn_s_getreg((3 << 11) | 20) & 0xFu; }
#define XB_SPIN(cond, bar) do { unsigned _sp = 0; while (cond) { __builtin_amdgcn_s_sleep(1); \
    if ((++_sp & 255u) == 0u) { if (xb_ld(&(bar)[XB_TMO])) break; if (_sp > XB_SPIN_CAP) { atomicAdd(&(bar)[XB_TMO], 1u); break; } } } } while (0)

struct XcdBarrier {
    unsigned* bar; unsigned x;
    volatile LAS unsigned* st;
};

__device__ __forceinline__ XcdBarrier xcd_barrier_post(unsigned* bar, volatile LAS unsigned* st) {
    XcdBarrier b; b.bar = bar; b.x = xb_xcc_id(); b.st = st;
    if (threadIdx.x == 0) (void)xb_add(&bar[XB_XCNT(b.x)], 1u);
    return b;
}
__device__ __forceinline__ void xcd_barrier_complete(unsigned* bar, unsigned x, unsigned& nloc, unsigned& nx) {
    const unsigned G = gridDim.x * gridDim.y * gridDim.z;
    unsigned sum, cnt, mine, sp = 0u;
    for (;;) {
        sum = 0u; cnt = 0u; mine = 0u;
#pragma unroll
        for (unsigned j = 0; j < 16; ++j) { const unsigned c = xb_ld(&bar[XB_XCNT(j)]); sum += c; cnt += (c > 0u) ? 1u : 0u; mine = (j == x) ? c : mine; }
        if (sum == G) break;
        __builtin_amdgcn_s_sleep(1);
        if ((++sp & 255u) == 0u) { if (xb_ld(&bar[XB_TMO])) break; if (sp > XB_SPIN_CAP) { atomicAdd(&bar[XB_TMO], 1u); break; } }
    }
    nloc = mine > 0u ? mine : 1u; nx = cnt > 0u ? cnt : 1u;
}

__device__ __forceinline__ void xcd_barrier(const XcdBarrier& b) {
    asm volatile("s_waitcnt vmcnt(0)" ::: "memory");
    __syncthreads();
    if (threadIdx.x == 0) {
        unsigned* bar = b.bar;
        __builtin_amdgcn_s_waitcnt(0);
        unsigned nloc = b.st[0], nx = b.st[1];
        if (nloc == 0u) { xcd_barrier_complete(bar, b.x, nloc, nx); b.st[0] = nloc; b.st[1] = nx; }
        const unsigned old = xb_add(&bar[XB_XSUB(b.x)], 1u);
        const unsigned gen = old / nloc;
        if (old + 1u == (gen + 1u) * nloc) {
            __builtin_amdgcn_fence(__ATOMIC_RELEASE, "agent");
            asm volatile("s_waitcnt vmcnt(0)" ::: "memory");
            const unsigned og = xb_add(&bar[XB_TOP], 1u);
            const unsigned tg = og / nx;
            if (og + 1u == (tg + 1u) * nx) xb_add(&bar[XB_TOPGEN], 1u);
            else XB_SPIN(xb_ld(&bar[XB_TOPGEN]) == tg, bar);
            __builtin_amdgcn_fence(__ATOMIC_ACQUIRE, "agent");
            xb_add(&bar[XB_XGEN(b.x)], 1u);
            asm volatile("s_waitcnt vmcnt(0)" ::: "memory");
        } else {
            XB_SPIN(xb_ld(&bar[XB_XGEN(b.x)]) == gen, bar);
            __builtin_amdgcn_fence(__ATOMIC_ACQUIRE, "agent");
            asm volatile("s_waitcnt vmcnt(0)" ::: "memory");
        }
    }
    __syncthreads();
}

typedef short s16x4 __attribute__((ext_vector_type(4)));
typedef short v4i16_t __attribute__((ext_vector_type(4)));
typedef unsigned short u16x4 __attribute__((ext_vector_type(4)));
typedef unsigned v2u __attribute__((ext_vector_type(2)));
typedef float f32x2v __attribute__((ext_vector_type(2)));
#define DI __device__ __forceinline__
struct Frame {
    LAS unsigned char* lds;
    int tid, lane, wave, G;
};
DI float wave_sum(float v) {
#pragma unroll
    for (int o = 1; o < 64; o <<= 1) v += __shfl_xor(v, o);
    return v;
}
DI bf16x8 ldg16(const bf16* p) { return *(const GAS bf16x8*)p; }
DI bf16x8 ldg16o(const bf16* ub, unsigned off) { return *(const GAS bf16x8*)((const GAS unsigned char*)ub + off); }
DI v4u ldg16u(const bf16* ub, unsigned off) { return *(const GAS v4u*)((const GAS unsigned char*)ub + off); }
DI float bf2f(bf16 b) { return __uint_as_float(((unsigned)b) << 16); }
DI float bflo(unsigned w) { return __uint_as_float(w << 16); }
DI float bfhi(unsigned w) { return __uint_as_float(w & 0xffff0000u); }
#define MFMA16(a, b, c) __builtin_amdgcn_mfma_f32_16x16x32_bf16((a), (b), (c), 0, 0, 0)

struct MapId { DI int operator()(int n) const { return n; } };
struct MapWin { DI int operator()(int n) const {
    if (n < 512) return n;
    if (n < 1536) return n + 512;
    if (n < 1600) return n - 1536 + 2560;
    if (n < 1664) return n - 1600 + 2624;
    if (n < 2176) return n - 1664 + 2048;
    if (n < 2240) return n - 2176 + 2688;
    if (n < 2248) return n - 2240 + 2752;
    if (n < 2760) return n - 2248 + 512;
    return n - 2760 + 2816; } };
struct MapIl { int half; DI int operator()(int n) const { const int hi = n >= half ? 1 : 0, m = n - hi * half; return (m >> 7) * 256 + hi * 128 + (m & 127); } };
template <class Map> DI void transpose_item(const float* W, int K, int Ns, bf16* WT, LAS float* scr, int item, int lane, const Map& map) {
    const int nblk = (Ns + 31) / 32, kb = item / nblk, nb = item % nblk, k0 = 64 * kb, n0 = 32 * nb;
    const int nl = n0 + (lane & 31);
#pragma unroll 8
    for (int i = 0; i < 32; ++i) { const int kk = 2 * i + (lane >> 5); scr[kk * 33 + (lane & 31)] = nl < Ns ? W[(size_t)(k0 + kk) * Ns + nl] : 0.f; }
    LDS_WAIT(); asm volatile("" ::: "memory");
    const int c = lane & 7;
#pragma unroll
    for (int j = 0; j < 4; ++j) { const int nn = (lane >> 3) + 8 * j; const LAS float* s = scr + (8 * c) * 33 + nn;
        if (n0 + nn < Ns) { const int dr = map(n0 + nn);
            v4u o; o.x = pk2(s[0 * 33], s[1 * 33]); o.y = pk2(s[2 * 33], s[3 * 33]); o.z = pk2(s[4 * 33], s[5 * 33]); o.w = pk2(s[6 * 33], s[7 * 33]);
            *(GAS v4u*)(WT + (size_t)dr * K + k0 + 8 * c) = o; } }
    LDS_WAIT(); asm volatile("" ::: "memory");
}
struct In {
    const float *x, *n_mix_pre, *n_mix_post, *n_ffn_pre, *n_ffn_post, *w_in, *pool_mix_w, *pool_scale, *pool_out_w, *attn_out_w, *rel_bias, *lam_re, *lam_im, *log_dt,
                *b_re, *b_im, *c_re, *c_im, *s5_d, *glu_w, *w_out, *ffn_w_in, *ffn_w_out;
};
struct Args { In in; float* out; unsigned char* ws; int ph_lo, ph_hi; };
typedef const __attribute__((address_space(4))) Args* KArgs;
DI KArgs kargs() { KArgs p = (KArgs)__builtin_amdgcn_kernarg_segment_ptr(); asm volatile("" : "+s"(p)); return p; }
template <class T> DI T* opq(T* p) { asm volatile("" : "+s"(p)); return p; }
DI int opqv(int v) { asm volatile("" : "+v"(v)); return v; }

DI void convert_A(Frame& F, KArgs A, unsigned char* ws, int l) {
    LAS float* scr = (LAS float*)(F.lds + RING_OFF + F.wave * 16384);
    const int gw = blockIdx.x * NWAVES + F.wave, NGW = F.G * NWAVES;
    const int gt = blockIdx.x * (NWAVES * 64) + F.tid, NGT = F.G * NWAVES * 64;
    bf16* WINT = (bf16*)(ws + WS_WINT); bf16* ATTNOT = (bf16*)(ws + WS_ATTNOT); bf16* POOLET = (bf16*)(ws + WS_POOLET); bf16* GLUT = (bf16*)(ws + WS_GLUT); bf16* WOUTT = (bf16*)(ws + WS_WOUTT);
    constexpr int I_WIN = (D / 64) * ((INW + 31) / 32), I_SQ = (D / 64) * (D / 32), I_GLU = (512 / 64) * (2048 / 32);
    constexpr int NITEMS = I_WIN + 2 * I_SQ + I_GLU;
    for (int it = gw; it < NITEMS; it += NGW) {
        int r = it;
        if (r < I_WIN) { transpose_item(A->in.w_in + (size_t)l * D * INW, D, INW, WINT, scr, r, F.lane, MapWin{}); continue; } r -= I_WIN;
        if (r < I_SQ) { transpose_item(A->in.attn_out_w + (size_t)l * D * D, D, D, ATTNOT, scr, r, F.lane, MapId{}); continue; } r -= I_SQ;
        if (r < I_SQ) { transpose_item(A->in.w_out + (size_t)l * D * D, D, D, WOUTT, scr, r, F.lane, MapId{}); continue; } r -= I_SQ;
        transpose_item(A->in.glu_w + (size_t)l * 512 * 2048, 512, 2048, GLUT, scr, r, F.lane, MapIl{1024});
    }
    for (int i = gt; i < 56 * D / 8; i += NGT) *(GAS v4u*)(WINT + (size_t)2760 * D + (size_t)i * 8) = (v4u){0u, 0u, 0u, 0u};
    {   const float* mw = A->in.pool_mix_w + (size_t)l * 4 * 128 * 128; const float* sc = A->in.pool_scale + (size_t)l * 512; const float* pw = A->in.pool_out_w + (size_t)l * 512 * D;
        for (int idx = gt; idx < 512 * D; idx += NGT) { const int n = idx & (D - 1), gc = idx >> 10, g = gc >> 7;
            const float* mrow = mw + (size_t)gc * 128; float s = 0.f;
            for (int d = 0; d < 128; ++d) s += mrow[d] * sc[g * 128 + d] * pw[(size_t)(g * 128 + d) * D + n];
            POOLET[(size_t)n * 512 + gc] = (bf16)f2bf(s); } }
    if (blockIdx.x == 0) { float* BT = (float*)(ws + WS_BIAS);
        for (int i = F.tid; i < 128 * 16; i += NWAVES * 64) { const int d = i >> 4, h = i & 15;
            int bk = d; if (d >= 16) { bk = 16 + (int)(logf((float)d / 16.0f) / logf(8.0f) * 16.0f); bk = bk > 31 ? 31 : bk; }
            BT[i] = A->in.rel_bias[bk * 16 + h]; } }
    {   bf16* S5T = (bf16*)(ws + WS_S5T); bf16* S5P = (bf16*)(ws + WS_S5P); bf16* S5Q = (bf16*)(ws + WS_S5Q); float* S5A = (float*)(ws + WS_S5A);
        LAS float* apr = (LAS float*)(F.lds + RING_OFF);
        LAS float* api = apr + 17 * 64;
        LAS float* bbr = api + 17 * 64;
        LAS float* bbi = bbr + 64 * 16;
        LAS float* Kt = bbi + 64 * 16;
        __syncthreads();
        for (int task = blockIdx.x; task < 256; task += F.G) { const int g = task & 31, sub = task >> 5; const int lg = l * 32 + g;
            if (F.tid < 64) { const int n = F.tid;
                const float lr = A->in.lam_re[lg * 64 + n], li = A->in.lam_im[lg * 64 + n], dt = expf(A->in.log_dt[lg]);
                const float mag = expf(lr * dt), ar = mag * cosf(li * dt), ai = mag * sinf(li * dt), den = lr * lr + li * li;
                const float cr = ((ar - 1.0f) * lr + ai * li) / den, ci = (ai * lr - (ar - 1.0f) * li) / den;
                float pr = 1.f, pi = 0.f;
                for (int t = 0; t <= 16; ++t) { apr[t * 64 + n] = pr; api[t * 64 + n] = pi; const float nr = pr * ar - pi * ai, ni = pr * ai + pi * ar; pr = nr; pi = ni; }
                for (int c = 0; c < 16; ++c) { const float br = A->in.b_re[((size_t)lg * 64 + n) * 16 + c], bi = A->in.b_im[((size_t)lg * 64 + n) * 16 + c];
                    bbr[n * 16 + c] = cr * br - ci * bi; bbi[n * 16 + c] = cr * bi + ci * br; }
                if (sub == 0) { S5A[(g * 64 + n) * 2] = apr[16 * 64 + n]; S5A[(g * 64 + n) * 2 + 1] = api[16 * 64 + n]; }
            }
            __syncthreads();
            const float* Cre = A->in.c_re + (size_t)lg * 16 * 64; const float* Cim = A->in.c_im + (size_t)lg * 16 * 64;
            for (int e = F.tid; e < 4096; e += NWAVES * 64) { const int t = e >> 8, i = (e >> 4) & 15, c = e & 15; float s = 0.f;
                for (int n = 0; n < 64; ++n) { const float Cr = Cre[i * 64 + n], Ci = Cim[i * 64 + n], pr = apr[t * 64 + n], pi = api[t * 64 + n];
                    const float er = Cr * pr - Ci * pi, ei = Cr * pi + Ci * pr; s += er * bbr[n * 16 + c] - ei * bbi[n * 16 + c]; }
                Kt[e] = s; }
            __syncthreads();
            for (int e = F.tid; e < 32 * 256; e += NWAVES * 64) { const int r = sub * 32 + (e >> 8), k = e & 255, j = r >> 4, i = r & 15, s = k >> 4, c = k & 15;
                float v = (j >= s) ? Kt[((j - s) * 16 + i) * 16 + c] : 0.f; if (j == s && i == c) v += A->in.s5_d[l * 512 + g * 16 + i];
                S5T[((size_t)g * 256 + r) * 256 + k] = (bf16)f2bf(v); }
            for (int e = F.tid; e < 16 * 256; e += NWAVES * 64) { const int row = sub * 16 + (e >> 8), k = e & 255, n = row & 63, im = row >> 6, s = k >> 4, c = k & 15;
                const float pr = apr[(15 - s) * 64 + n], pi = api[(15 - s) * 64 + n], br = bbr[n * 16 + c], bi = bbi[n * 16 + c];
                const float v = im ? (pr * bi + pi * br) : (pr * br - pi * bi);
                S5P[((size_t)g * 128 + row) * 256 + k] = (bf16)f2bf(v); }
            for (int e = F.tid; e < 32 * 128; e += NWAVES * 64) { const int r = sub * 32 + (e >> 7), k = e & 127, j = r >> 4, i = r & 15, n = k & 63, im = k >> 6;
                const float Cr = Cre[i * 64 + n], Ci = Cim[i * 64 + n], pr = apr[(j + 1) * 64 + n], pi = api[(j + 1) * 64 + n];
                const float v = im ? -(Cr * pi + Ci * pr) : (Cr * pr - Ci * pi);
                S5Q[((size_t)g * 256 + r) * 128 + k] = (bf16)f2bf(v); }
            __syncthreads();
        }
    }
}
DI void convert_B(Frame& F, KArgs A, unsigned char* ws, int l) {
    LAS float* scr = (LAS float*)(F.lds + RING_OFF + F.wave * 16384);
    const int gw = blockIdx.x * NWAVES + F.wave, NGW = F.G * NWAVES;
    bf16* FFNINT = (bf16*)(ws + WS_FFNINT); bf16* FFNOUTT = (bf16*)(ws + WS_FFNOUTT);
    constexpr int I_IN = (D / 64) * (2 * FF / 32), I_OUT = (FF / 64) * (D / 32);
    for (int it = gw; it < I_IN + I_OUT; it += NGW) {
        if (it < I_IN) transpose_item(A->in.ffn_w_in + (size_t)l * D * 2 * FF, D, 2 * FF, FFNINT, scr, it, F.lane, MapIl{FF});
        else transpose_item(A->in.ffn_w_out + (size_t)l * FF * D, FF, D, FFNOUTT, scr, it - I_IN, F.lane, MapId{});
    }
}
DI void rms_rows_to_bf16(Frame& F, const float* x, const float* g, bf16* hb) {
    const int gw = blockIdx.x * NWAVES + F.wave, NGW = F.G * NWAVES;
    f32x4 gv[4];
#pragma unroll
    for (int j = 0; j < 4; ++j) gv[j] = ((const GAS f32x4*)g)[F.lane + 64 * j];
    for (int m = gw; m < M; m += NGW) {
        const GAS f32x4* xr = (const GAS f32x4*)(x + (size_t)m * D) + F.lane; f32x4 v[4]; float s = 0.f;
#pragma unroll
        for (int j = 0; j < 4; ++j) { v[j] = xr[64 * j]; s += (v[j].x * v[j].x + v[j].y * v[j].y) + (v[j].z * v[j].z + v[j].w * v[j].w); }
        const float rstd = 1.0f / sqrtf(wave_sum(s) * (1.f / D) + NORM_EPS);
        GAS v2u* o8 = (GAS v2u*)(hb + (size_t)m * D) + F.lane;
#pragma unroll
        for (int j = 0; j < 4; ++j) { v2u o; o.x = pk2(v[j].x * rstd * gv[j].x, v[j].y * rstd * gv[j].y); o.y = pk2(v[j].z * rstd * gv[j].z, v[j].w * rstd * gv[j].w); o8[64 * j] = o; }
    }
}
DI void norm_phase(Frame& F, const float* xin, float* xout, const float* f, const float* gpost, const float* gpre, bf16* hb) {
    const int gw = blockIdx.x * NWAVES + F.wave, NGW = F.G * NWAVES;
    for (int m = gw; m < M; m += NGW) {
        const GAS f32x4* fr = (const GAS f32x4*)(f + (size_t)m * D) + F.lane; const GAS f32x4* xr = (const GAS f32x4*)(xin + (size_t)m * D) + F.lane;
        f32x4 v[4], xv[4]; float s = 0.f;
#pragma unroll
        for (int j = 0; j < 4; ++j) { v[j] = fr[64 * j]; xv[j] = xr[64 * j]; s += (v[j].x * v[j].x + v[j].y * v[j].y) + (v[j].z * v[j].z + v[j].w * v[j].w); }
        const float rstd = 1.0f / sqrtf(wave_sum(s) * (1.f / D) + NORM_EPS); float s2 = 0.f;
        GAS f32x4* xo = (GAS f32x4*)(xout + (size_t)m * D) + F.lane;
#pragma unroll
        for (int j = 0; j < 4; ++j) { const f32x4 gp = ((const GAS f32x4*)gpost)[F.lane + 64 * j]; xv[j] = xv[j] + v[j] * rstd * gp; xo[64 * j] = xv[j];
            s2 += (xv[j].x * xv[j].x + xv[j].y * xv[j].y) + (xv[j].z * xv[j].z + xv[j].w * xv[j].w); }
        if (gpre) { const float rstd2 = 1.0f / sqrtf(wave_sum(s2) * (1.f / D) + NORM_EPS);
            GAS v2u* o8 = (GAS v2u*)(hb + (size_t)m * D) + F.lane;
#pragma unroll
            for (int j = 0; j < 4; ++j) { const f32x4 gq = ((const GAS f32x4*)gpre)[F.lane + 64 * j]; v2u o; o.x = pk2(xv[j].x * rstd2 * gq.x, xv[j].y * rstd2 * gq.y); o.y = pk2(xv[j].z * rstd2 * gq.z, xv[j].w * rstd2 * gq.w); o8[64 * j] = o; } }
    }
}

DI void pool_stencil(Frame& F, const bf16* POOLU, bf16* DP) {
    const int gt = blockIdx.x * (NWAVES * 64) + F.tid, NGT = F.G * NWAVES * 64;
    for (int idx = gt; idx < M * 64; idx += NGT) {
        const int t = idx >> 6, cc = idx & 63, ch0 = cc * 8, gi = cc >> 4, w = 2 << gi, pos = t & (SEQ - 1);
        const int nw = (pos + 1) < w ? (pos + 1) : w;
        float a[8], u0[8];
#pragma unroll
        for (int j = 0; j < 8; ++j) { a[j] = 0.f; u0[j] = 0.f; }
        for (int i = 0; i < nw; ++i) { const v4u v = *(const GAS v4u*)(POOLU + (size_t)(t - i) * 512 + ch0);
            const float e[8] = {bflo(v.x), bfhi(v.x), bflo(v.y), bfhi(v.y), bflo(v.z), bfhi(v.z), bflo(v.w), bfhi(v.w)};
#pragma unroll
            for (int j = 0; j < 8; ++j) { a[j] += e[j]; if (i == 0) u0[j] = e[j]; } }
        const float inv = 1.0f / (float)nw; v4u o;
        o.x = pk2(a[0] * inv - u0[0], a[1] * inv - u0[1]); o.y = pk2(a[2] * inv - u0[2], a[3] * inv - u0[3]);
        o.z = pk2(a[4] * inv - u0[4], a[5] * inv - u0[5]); o.w = pk2(a[6] * inv - u0[6], a[7] * inv - u0[7]);
        *(GAS v4u*)(DP + (size_t)t * 512 + ch0) = o;
    }
}
DI float gelu_tanh(float y) { const float u = 0.7978845608028654f * (y + 0.044715f * y * y * y); const float th = 1.0f - 2.0f * __builtin_amdgcn_rcpf(__expf(2.0f * u) + 1.0f); return 0.5f * y * (1.0f + th); }
constexpr int S5_SLD = 129, S5_XLD = 136, S5_XOFF = 69632;
DI void s5_unit(Frame& F, int b, int g, const bf16* S5U_, const bf16* S5T_, const bf16* S5P_, const bf16* S5Q_, const float* S5A_, bf16* ZB_) {
    const bf16* S5U = opq(S5U_); const bf16* S5T = opq(S5T_); const bf16* S5P = opq(S5P_); const bf16* S5Q = opq(S5Q_); const float* S5A = opq(S5A_); bf16* ZB = opq(ZB_);
    LAS float* Ssm = (LAS float*)(F.lds + RING_OFF);
    LAS bf16* XB = (LAS bf16*)(F.lds + RING_OFF + S5_XOFF);
    const int w = F.wave, lane = opqv(F.lane), fr = lane & 15, qd = lane >> 4;
    const bf16* Tg = S5T + (size_t)g * 65536; const bf16* Pg = S5P + (size_t)g * 32768; const bf16* Qg = S5Q + (size_t)g * 32768;
    const bf16* Ub = S5U + (size_t)b * SEQ * 512 + g * 16;
    f32x4 accY[2][8], accS[8];
#pragma unroll
    for (int ct = 0; ct < 8; ++ct) { accS[ct] = (f32x4){0.f, 0.f, 0.f, 0.f}; accY[0][ct] = accS[ct]; accY[1][ct] = accS[ct]; }
#pragma unroll 1
    for (int ks = 0; ks < 8; ++ks) {
        bf16x8 bfr[8];
        const int s = 2 * ks + (qd >> 1), c0 = 8 * (qd & 1);
#pragma unroll
        for (int ct = 0; ct < 8; ++ct) bfr[ct] = ldg16o(Ub + (size_t)ct * 16 * 16 * 512, (unsigned)((fr * 16 + s) * 512 + c0) * 2u);
        const bf16x8 aP = ldg16o(Pg + (size_t)(16 * w) * 256 + 32 * ks, (unsigned)(fr * 256 + 8 * qd) * 2u);
#pragma unroll
        for (int ct = 0; ct < 8; ++ct) accS[ct] = MFMA16(aP, bfr[ct], accS[ct]);
        if (ks <= w) {
            const bf16x8 aT0 = ldg16o(Tg + (size_t)(32 * w) * 256 + 32 * ks, (unsigned)(fr * 256 + 8 * qd) * 2u), aT1 = ldg16o(Tg + (size_t)(32 * w + 16) * 256 + 32 * ks, (unsigned)(fr * 256 + 8 * qd) * 2u);
#pragma unroll
            for (int ct = 0; ct < 8; ++ct) { accY[0][ct] = MFMA16(aT0, bfr[ct], accY[0][ct]); accY[1][ct] = MFMA16(aT1, bfr[ct], accY[1][ct]); }
        }
    }
#pragma unroll
    for (int ct = 0; ct < 8; ++ct)
#pragma unroll
        for (int r = 0; r < 4; ++r) Ssm[(16 * w + 4 * qd + r) * S5_SLD + 16 * ct + fr] = accS[ct][r];
    __syncthreads();
    if (F.tid < 64) { const int n = F.tid; const float ar = S5A[(g * 64 + n) * 2], ai = S5A[(g * 64 + n) * 2 + 1]; float xr = 0.f, xi = 0.f;
        for (int c = 0; c < 128; ++c) { XB[c * S5_XLD + n] = (bf16)f2bf(xr); XB[c * S5_XLD + 64 + n] = (bf16)f2bf(xi);
            const float sr = Ssm[n * S5_SLD + c], si = Ssm[(64 + n) * S5_SLD + c];
            const float nr = ar * xr - ai * xi + sr, ni = ar * xi + ai * xr + si; xr = nr; xi = ni; } }
    __syncthreads();
#pragma unroll 1
    for (int ks = 0; ks < 4; ++ks) {
        const bf16x8 aQ0 = ldg16o(Qg + (size_t)(32 * w) * 128 + 32 * ks, (unsigned)(fr * 128 + 8 * qd) * 2u), aQ1 = ldg16o(Qg + (size_t)(32 * w + 16) * 128 + 32 * ks, (unsigned)(fr * 128 + 8 * qd) * 2u);
#pragma unroll
        for (int ct = 0; ct < 8; ++ct) { const bf16x8 bx = *(const LAS bf16x8*)(XB + (16 * ct + fr) * S5_XLD + 32 * ks + 8 * qd);
            accY[0][ct] = MFMA16(aQ0, bx, accY[0][ct]); accY[1][ct] = MFMA16(aQ1, bx, accY[1][ct]); }
    }
#pragma unroll
    for (int rt = 0; rt < 2; ++rt)
#pragma unroll
        for (int ct = 0; ct < 8; ++ct) { const int tok = (16 * ct + fr) * 16 + 2 * w + rt; const f32x4 y = accY[rt][ct];
            v2u o; o.x = pk2(gelu_tanh(y[0]), gelu_tanh(y[1])); o.y = pk2(gelu_tanh(y[2]), gelu_tanh(y[3]));
            *(GAS v2u*)(ZB + (size_t)(b * SEQ + tok) * 512 + g * 16 + 4 * qd) = o; }
    __syncthreads();
}
constexpr int AT_BIAS_OFF = 0, AT_SEL_OFF = 8192, AT_V_OFF = 24576, AT_VLD = 144  ;
DI s16x4 vtr(const LAS unsigned char* p) { return __builtin_bit_cast(s16x4, __builtin_amdgcn_ds_read_tr16_b64_v4i16((LAS v4i16_t*)p)); }
#define MEMBAR() asm volatile("" ::: "memory")
DI void attn_unit(Frame& F, int b, int tile, const bf16* QI_, const bf16* KVX_, bf16* QA_, const float* BIAS_) {
    const bf16* QI = opq(QI_); const bf16* KVX = opq(KVX_); bf16* QA = opq(QA_); const float* BIAS = opq(BIAS_);
    LAS float* biasL = (LAS float*)(F.lds + RING_OFF + AT_BIAS_OFF);
    const int w = F.wave;
    LAS unsigned short* selw = (LAS unsigned short*)(F.lds + RING_OFF + AT_SEL_OFF) + w * 512;
    for (int i = F.tid; i < 2048; i += NWAVES * 64) biasL[i] = BIAS[i];
    { LAS v4u* z = (LAS v4u*)selw; z[F.lane] = (v4u){0u, 0u, 0u, 0u}; }
    __syncthreads();
    const size_t rowb = (size_t)b * SEQ;
    const int tb = tile * 16 + 2 * w;
    const int nkp = ((tb + 1) / 16 + 2) / 2;
    unsigned key[64];
    {
        const int lane = opqv(F.lane), fr = lane & 15, qd = lane >> 4, tq = tb + (qd >> 1), odd = qd & 1;
        bf16x8 aQ[2];
#pragma unroll
        for (int ks = 0; ks < 2; ++ks) aQ[ks] = ldg16(QI + (rowb + tb + (fr >> 3)) * 512 + (fr & 7) * 64 + 32 * ks + 8 * qd);
        const v2u wraw = *(const GAS v2u*)(KVX + (rowb + tq) * 256 + 192 + 4 * odd);
        const float wv[4] = {bflo(wraw.x), bfhi(wraw.x), bflo(wraw.y), bfhi(wraw.y)};
        const unsigned koff = (unsigned)(fr * 256 + 8 * qd) * 2u;
#pragma unroll 1
        for (int ch = 0; ch * 16 < nkp; ++ch) {
            unsigned tmp[16];
            const bf16* kub = KVX + (rowb + 512 * ch) * 256 + 128;
#pragma unroll
            for (int j = 0; j < 16; ++j) {
                const bf16x8 e0 = ldg16o(kub + (2 * j) * 16 * 256, koff), e1 = ldg16o(kub + (2 * j) * 16 * 256 + 32, koff);
                const bf16x8 o0 = ldg16o(kub + (2 * j + 1) * 16 * 256, koff), o1 = ldg16o(kub + (2 * j + 1) * 16 * 256 + 32, koff);
                f32x4 cE = (f32x4){0.f, 0.f, 0.f, 0.f}, cO = cE;
                cE = MFMA16(aQ[0], e0, cE); cE = MFMA16(aQ[1], e1, cE); cO = MFMA16(aQ[0], o0, cO); cO = MFMA16(aQ[1], o1, cO);
                float sE = 0.f, sO = 0.f;
#pragma unroll
                for (int r = 0; r < 4; ++r) { sE += wv[r] * fmaxf(cE[r], 0.f); sO += wv[r] * fmaxf(cO[r], 0.f); }
                sE += __shfl_xor(sE, 16); sO += __shfl_xor(sO, 16);
                float s = odd ? sO : sE; s += 0.0f;
                const unsigned bits = __float_as_uint(s); const unsigned sk = bits ^ ((unsigned)((int)bits >> 31) | 0x80000000u);
                tmp[j] = (512 * ch + 32 * j + 16 * odd + fr <= tq) ? sk : 0u;
                if ((j & 1) == 1) MEMBAR();
            }
#define KEYCASE(c) case c: _Pragma("unroll") for (int j = 0; j < 16; ++j) key[16 * c + j] = tmp[j]; break;
            switch (ch) { KEYCASE(0) KEYCASE(1) KEYCASE(2) default: _Pragma("unroll") for (int j = 0; j < 16; ++j) key[48 + j] = tmp[j]; break; }
#undef KEYCASE
        }
    }
    unsigned theta = 0u;
#pragma unroll 1
    for (int bit = 31; bit >= 0; --bit) {
        const unsigned cand = theta | (1u << bit); int cnt = 0;
#pragma unroll
        for (int ch = 0; ch < 4; ++ch) if (ch * 16 < nkp) {
#pragma unroll
            for (int j = 0; j < 16; ++j) cnt += (key[ch * 16 + j] >= cand) ? 1 : 0; }
        cnt += __shfl_xor(cnt, 1); cnt += __shfl_xor(cnt, 2); cnt += __shfl_xor(cnt, 4); cnt += __shfl_xor(cnt, 8); cnt += __shfl_xor(cnt, 16);
        if (cnt >= 256) theta = cand;
    }
    int nsel;
    {
        const int lane = opqv(F.lane), fr = lane & 15, qd = lane >> 4, odd = qd & 1;
        int cgt = 0;
#pragma unroll
        for (int ch = 0; ch < 4; ++ch) if (ch * 16 < nkp) {
#pragma unroll
            for (int j = 0; j < 16; ++j) cgt += (key[ch * 16 + j] > theta) ? 1 : 0; }
        cgt += __shfl_xor(cgt, 1); cgt += __shfl_xor(cgt, 2); cgt += __shfl_xor(cgt, 4); cgt += __shfl_xor(cgt, 8); cgt += __shfl_xor(cgt, 16);
        const int quota = (theta == 0u) ? 0 : (256 - cgt);
        int base = 0, eqseen = 0; const unsigned below = (1u << (lane & 31)) - 1u; const int sh = 32 * (qd >> 1);
        LAS unsigned short* sl = selw + (qd >> 1) * 256;
#pragma unroll 1
        for (int ch = 0; ch * 16 < nkp; ++ch) {
            unsigned tmp[16];
#define KEYCASE(c) case c: _Pragma("unroll") for (int j = 0; j < 16; ++j) tmp[j] = key[16 * c + j]; break;
            switch (ch) { KEYCASE(0) KEYCASE(1) KEYCASE(2) default: _Pragma("unroll") for (int j = 0; j < 16; ++j) tmp[j] = key[48 + j]; break; }
#undef KEYCASE
#pragma unroll
            for (int j = 0; j < 16; ++j) {
                const bool gtk = tmp[j] > theta, eqk = (tmp[j] == theta) && (theta != 0u);
                const unsigned long long be = __ballot(eqk); const unsigned e32 = (unsigned)(be >> sh); const int pe = __popc(e32 & below);
                const bool take = gtk || (eqk && (eqseen + pe) < quota);
                const unsigned long long bt = __ballot(take); const unsigned t32 = (unsigned)(bt >> sh); const int pt = __popc(t32 & below);
                if (take) sl[base + pt] = (unsigned short)(512 * ch + 32 * j + 16 * odd + fr);
                base += __popc(t32); eqseen += __popc(e32);
            }
        }
        nsel = base;
    }
#pragma unroll 1
    for (int qq = 0; qq < 2; ++qq) {
        const int lane = opqv(F.lane), fr = lane & 15, qd = lane >> 4;
        LAS unsigned char* Vs = F.lds + RING_OFF + AT_V_OFF + w * (64 * AT_VLD);
        const int t = tb + qq; const int ns = __shfl(nsel, 32 * qq);
        const LAS unsigned short* sl = selw + qq * 256;
        bf16* qrow = QA + (rowb + t) * 1024;
        bf16x8 bq[2];
#pragma unroll
        for (int ks = 0; ks < 2; ++ks) bq[ks] = ldg16(qrow + fr * 64 + 32 * ks + 8 * qd);
        f32x4 st[16];
#pragma unroll
        for (int blk = 0; blk < 16; ++blk) { const int kidx = sl[16 * blk + fr];
            const unsigned ko = (unsigned)(kidx * 256 + 8 * qd) * 2u; const bf16x8 a0 = ldg16o(KVX + rowb * 256, ko), a1 = ldg16o(KVX + rowb * 256 + 32, ko);
            f32x4 c = (f32x4){0.f, 0.f, 0.f, 0.f}; c = MFMA16(a0, bq[0], c); c = MFMA16(a1, bq[1], c); st[blk] = c;
            if ((blk & 3) == 3) MEMBAR(); }
        float mx = -3.0e38f;
#pragma unroll
        for (int blk = 0; blk < 16; ++blk) { const u16x4 k4 = *(const LAS u16x4*)(sl + 16 * blk + 4 * qd);
#pragma unroll
            for (int r = 0; r < 4; ++r) { int dist = t - (int)k4[r]; dist = dist < 0 ? 0 : (dist > 127 ? 127 : dist);
                float lg = st[blk][r] + biasL[dist * 16 + fr]; if (16 * blk + 4 * qd + r >= ns) lg = -1.0e30f; st[blk][r] = lg; mx = fmaxf(mx, lg); } }
        mx = fmaxf(mx, __shfl_xor(mx, 16)); mx = fmaxf(mx, __shfl_xor(mx, 32));
        float sum = 0.f;
#pragma unroll
        for (int blk = 0; blk < 16; ++blk)
#pragma unroll
            for (int r = 0; r < 4; ++r) { const float p = __expf(st[blk][r] - mx); st[blk][r] = p; sum += p; }
        sum += __shfl_xor(sum, 16); sum += __shfl_xor(sum, 32);
        const float inv = 1.0f / sum;
        f32x4 o[4];
#pragma unroll
        for (int nb = 0; nb < 4; ++nb) o[nb] = (f32x4){0.f, 0.f, 0.f, 0.f};
#pragma unroll
        for (int vr = 0; vr < 4; ++vr) {
            v4u vv[8];
#pragma unroll
            for (int i = 0; i < 8; ++i) { const int piece = lane + 64 * i, row = piece >> 3, pc = piece & 7; const int kidx = sl[64 * vr + row];
                vv[i] = ldg16u(KVX + rowb * 256 + 64, (unsigned)(kidx * 256 + 8 * pc) * 2u); }
#pragma unroll
            for (int i = 0; i < 8; ++i) { const int piece = lane + 64 * i, row = piece >> 3, pc = piece & 7; *(LAS v4u*)(Vs + row * AT_VLD + pc * 16) = vv[i]; }
            MEMBAR();
#pragma unroll
            for (int kk = 0; kk < 2; ++kk) {
                const f32x4 p0 = st[4 * vr + 2 * kk] * inv, p1 = st[4 * vr + 2 * kk + 1] * inv;
                const v4u pw = (v4u){pk2(p0[0], p0[1]), pk2(p0[2], p0[3]), pk2(p1[0], p1[1]), pk2(p1[2], p1[3])};
                const bf16x8 pa = __builtin_bit_cast(bf16x8, pw);
                const int q4 = fr >> 2, p4 = fr & 3;
#pragma unroll
                for (int nb = 0; nb < 4; ++nb) {
                    const s16x4 lo = vtr(Vs + (32 * kk + 4 * qd + q4) * AT_VLD + (16 * nb + 4 * p4) * 2);
                    const s16x4 hi = vtr(Vs + (32 * kk + 16 + 4 * qd + q4) * AT_VLD + (16 * nb + 4 * p4) * 2);
                    const bf16x8 bv = (bf16x8){lo[0], lo[1], lo[2], lo[3], hi[0], hi[1], hi[2], hi[3]};
                    o[nb] = MFMA16(pa, bv, o[nb]);
                }
            }
            MEMBAR();
        }
#pragma unroll
        for (int nb = 0; nb < 4; ++nb)
#pragma unroll
            for (int r = 0; r < 4; ++r) qrow[(4 * qd + r) * 64 + 16 * nb + fr] = (bf16)f2bf(o[nb][r]);
    }
    __syncthreads();
}

#ifndef PH_MASK
#define PH_MASK 0x1ff
#endif
#define PH_ON(k) (((PH_MASK) >> (k)) & 1)
#ifndef MK_SP2
#define MK_SP2 true
#endif
#ifndef MK_ALIGN
#define MK_ALIGN true
#endif
__global__ void __launch_bounds__(NWAVES * 64, 2) hybrid_fwd(Args args) {
    extern __shared__ __attribute__((aligned(16))) unsigned char lds[];
#define MKFRAME() Frame F; F.lds = (LAS unsigned char*)lds; F.tid = opqv((int)threadIdx.x); F.lane = F.tid & 63; F.wave = __builtin_amdgcn_readfirstlane(F.tid >> 6); F.G = gridDim.x
    const int lo = args.ph_lo, hi = args.ph_hi;
    {   KArgs A = kargs(); gu32* ctl = (gu32*)(A->ws + WS_CTL); MKFRAME();
        for (int u = F.tid; u < (LDS_BYTES - LDSCTL_OFF) / 4; u += NWAVES * 64) ((LAS unsigned*)(F.lds + LDSCTL_OFF))[u] = 0u;
        __syncthreads();
        volatile LAS unsigned* MISC = (volatile LAS unsigned*)(F.lds + MISC_OFF);
        (void)xcd_barrier_post((unsigned*)(ctl + CW_BAR), MISC + 8); }
#define IN(k) (lo <= (k) && (k) < hi)
#define BOTH(k) (IN(k) && IN((k) + 1))
#define GRID_BAR() do { KArgs Ab = kargs(); XcdBarrier bar; bar.bar = (unsigned*)((gu32*)(Ab->ws + WS_CTL) + CW_BAR); bar.x = xb_xcc_id(); bar.st = (volatile LAS unsigned*)((LAS unsigned char*)lds + MISC_OFF) + 8; xcd_barrier(bar); } while (0)
#define WSP(T, off) ((T*)(ws + (off)))

    if (PH_ON(0) && IN(0)) { KArgs A = kargs(); unsigned char* ws = A->ws; MKFRAME();
        convert_A(F, A, ws, 0); rms_rows_to_bf16(F, A->in.x, A->in.n_mix_pre, WSP(bf16, WS_HB)); if (BOTH(0)) GRID_BAR(); }

#pragma unroll 1
    for (int l = 0; l < NLAYER; ++l) {
        const int pb = 1 + 8 * l;
        if (PH_ON(1) && IN(pb)) { KArgs A = kargs(); unsigned char* ws = A->ws; MKFRAME();
            pg8::Gemm g{WSP(bf16, WS_HB), WSP(bf16, WS_WINT), M, N1P, D}; pg8::StaticOrder S; S.init(M, N1P, F.G, (int)blockIdx.x);
            pg8::EpiRoute E{WSP(bf16, WS_POOLU), WSP(bf16, WS_S5U), WSP(bf16, WS_Q), WSP(bf16, WS_QI), WSP(bf16, WS_KVX), WSP(bf16, WS_GATES)};
            pg8::gemm_phase<pg8::EpiRoute, pg8::StaticOrder, MK_ALIGN, MK_SP2>(F.lds + RING_OFF, g, S, E);
            if (BOTH(pb)) GRID_BAR();
        }
        if (PH_ON(2) && IN(pb + 1)) { KArgs A = kargs(); unsigned char* ws = A->ws; MKFRAME();
#ifndef NO_POOL
            pool_stencil(F, WSP(bf16, WS_POOLU), WSP(bf16, WS_DP));
#endif
#ifndef NO_S5
#pragma unroll 1
            for (int u = blockIdx.x; u < 256; u += F.G) s5_unit(F, u >> 5, u & 31, WSP(bf16, WS_S5U), WSP(bf16, WS_S5T), WSP(bf16, WS_S5P), WSP(bf16, WS_S5Q), WSP(float, WS_S5A), WSP(bf16, WS_ZB));
#endif
#ifndef NO_ATTN
#pragma unroll 1
            for (int u4 = 4 * blockIdx.x; u4 < 1024; u4 += 4 * F.G) {
#pragma unroll 1
                for (int h = 0; h < 4; ++h) { const int u = u4 >> 2, b = u >> 5, j = u & 31; const int tile = (h & 2 ? 64 : 0) + ((h & 1) ? 63 - j : j);
                    attn_unit(F, b, tile, WSP(bf16, WS_QI), WSP(bf16, WS_KVX), WSP(bf16, WS_Q), WSP(float, WS_BIAS)); } }
#endif
            if (BOTH(pb + 1)) GRID_BAR();
        }
        if (PH_ON(3) && IN(pb + 2)) {
            { KArgs A = kargs(); unsigned char* ws = A->ws; MKFRAME();
              pg8::Gemm g{WSP(bf16, WS_ZB), WSP(bf16, WS_GLUT), M, 2048, 512}; pg8::PairOrder S; S.base.init(M, D, F.G, (int)blockIdx.x);
              pg8::EpiGlu E{WSP(bf16, WS_MERGED), WSP(bf16, WS_GATES)};
              pg8::gemm_phase<pg8::EpiGlu, pg8::PairOrder, MK_ALIGN, MK_SP2>(F.lds + RING_OFF, g, S, E); }
            VM_WAIT(); __builtin_amdgcn_fence(__ATOMIC_ACQUIRE, "agent"); VM_WAIT(); __syncthreads();
            { KArgs A = kargs(); unsigned char* ws = A->ws; MKFRAME();
              pg8::Gemm g{WSP(bf16, WS_DP), WSP(bf16, WS_POOLET), M, D, 512}; pg8::StaticOrder S; S.init(M, D, F.G, (int)blockIdx.x);
              pg8::EpiAccum<0> E{WSP(bf16, WS_MERGED), WSP(bf16, WS_GATES)};
              pg8::gemm_phase<pg8::EpiAccum<0>, pg8::StaticOrder, MK_ALIGN, MK_SP2>(F.lds + RING_OFF, g, S, E); }
            VM_WAIT(); __builtin_amdgcn_fence(__ATOMIC_ACQUIRE, "agent"); VM_WAIT(); __syncthreads();
            { KArgs A = kargs(); unsigned char* ws = A->ws; MKFRAME();
              pg8::Gemm g{WSP(bf16, WS_Q), WSP(bf16, WS_ATTNOT), M, D, D}; pg8::StaticOrder S; S.init(M, D, F.G, (int)blockIdx.x);
              pg8::EpiAccum<1024> E{WSP(bf16, WS_MERGED), WSP(bf16, WS_GATES)};
              pg8::gemm_phase<pg8::EpiAccum<1024>, pg8::StaticOrder, MK_ALIGN, MK_SP2>(F.lds + RING_OFF, g, S, E); }
            if (BOTH(pb + 2)) GRID_BAR();
        }
        if (PH_ON(4) && IN(pb + 3)) { KArgs A = kargs(); unsigned char* ws = A->ws; MKFRAME();
            pg8::Gemm g{WSP(bf16, WS_MERGED), WSP(bf16, WS_WOUTT), M, D, D}; pg8::StaticOrder S; S.init(M, D, F.G, (int)blockIdx.x);
            pg8::EpiF32 E{WSP(float, WS_F), D};
            pg8::gemm_phase<pg8::EpiF32, pg8::StaticOrder, MK_ALIGN, MK_SP2>(F.lds + RING_OFF, g, S, E);
            if (BOTH(pb + 3)) GRID_BAR();
        }
        if (PH_ON(5) && IN(pb + 4)) { KArgs A = kargs(); unsigned char* ws = A->ws; MKFRAME();
            convert_B(F, A, ws, l);
            norm_phase(F, l == 0 ? A->in.x : (const float*)A->out, A->out, WSP(float, WS_F), A->in.n_mix_post + l * D, A->in.n_ffn_pre + l * D, WSP(bf16, WS_HB));
            if (BOTH(pb + 4)) GRID_BAR();
        }
        if (PH_ON(6) && IN(pb + 5)) { KArgs A = kargs(); unsigned char* ws = A->ws; MKFRAME();
            pg8::Gemm g{WSP(bf16, WS_HB), WSP(bf16, WS_FFNINT), M, 2 * FF, D}; pg8::StaticOrder S; S.init(M, 2 * FF, F.G, (int)blockIdx.x);
            pg8::EpiSwiglu E{WSP(bf16, WS_HID), FF};
            pg8::gemm_phase<pg8::EpiSwiglu, pg8::StaticOrder, MK_ALIGN, MK_SP2>(F.lds + RING_OFF, g, S, E);
            if (BOTH(pb + 5)) GRID_BAR();
        }
        if (PH_ON(7) && IN(pb + 6)) { KArgs A = kargs(); unsigned char* ws = A->ws; MKFRAME();
            pg8::Gemm g{WSP(bf16, WS_HID), WSP(bf16, WS_FFNOUTT), M, D, FF}; pg8::StaticOrder S; S.init(M, D, F.G, (int)blockIdx.x);
            pg8::EpiF32 E{WSP(float, WS_F), D};
            pg8::gemm_phase<pg8::EpiF32, pg8::StaticOrder, MK_ALIGN, MK_SP2>(F.lds + RING_OFF, g, S, E);
            if (BOTH(pb + 6)) GRID_BAR();
        }
        if (PH_ON(8) && IN(pb + 7)) { KArgs A = kargs(); unsigned char* ws = A->ws; MKFRAME();
            if (l + 1 < NLAYER) convert_A(F, A, ws, l + 1);
            norm_phase(F, (const float*)A->out, A->out, WSP(float, WS_F), A->in.n_ffn_post + l * D, (l + 1 < NLAYER) ? A->in.n_mix_pre + (l + 1) * D : (const float*)nullptr, WSP(bf16, WS_HB));
            if (BOTH(pb + 7)) GRID_BAR();
        }
    }
#undef WSP
#undef IN
#undef BOTH
#undef GRID_BAR
}

#ifndef MK_ONE_LAUNCH
#define MK_ONE_LAUNCH 0
#endif
extern "C" void kernel_launch(void* const* d_in, const int* in_sizes, int n_in, void* d_out, int out_size, void* d_ws, size_t ws_size, hipStream_t stream) {
    static int grid = 0;
    if (grid == 0) {
        if (n_in != 23 || in_sizes[0] != M * D || out_size != M * D || ws_size < WS_END) { fprintf(stderr, "kernel_launch: unexpected shapes (n_in %d, in0 %d, out %d, ws %zu); nothing launched\n", n_in, n_in > 0 ? in_sizes[0] : -1, out_size, ws_size); grid = -1; return; }
        int dev = 0, cus = 0, per_cu = 0;
        if (hipGetDevice(&dev) != hipSuccess || hipDeviceGetAttribute(&cus, hipDeviceAttributeMultiprocessorCount, dev) != hipSuccess) { grid = -1; return; }
        if (hipFuncSetAttribute((const void*)hybrid_fwd, hipFuncAttributeMaxDynamicSharedMemorySize, LDS_BYTES) != hipSuccess) { fprintf(stderr, "kernel_launch: hipFuncSetAttribute failed\n"); grid = -1; return; }
        if (hipOccupancyMaxActiveBlocksPerMultiprocessor(&per_cu, (const void*)hybrid_fwd, NWAVES * 64, LDS_BYTES) != hipSuccess || per_cu < 1) { fprintf(stderr, "kernel_launch: occupancy query says %d\n", per_cu); per_cu = 1; }
        (void)hipGetLastError();
        grid = cus;
    }
    if (grid < 0) return;
    if (hipMemsetAsync((char*)d_ws + WS_CTL, 0, CTL_ZERO_BYTES, stream) != hipSuccess) return;
    Args a{};
    const float** ip = (const float**)&a.in;
    for (int i = 0; i < 23; ++i) ip[i] = (const float*)d_in[i];
    a.out = (float*)d_out; a.ws = (unsigned char*)d_ws;
#if MK_ONE_LAUNCH
    a.ph_lo = 0; a.ph_hi = NPHASE;
    hipLaunchKernelGGL(hybrid_fwd, dim3(grid), dim3(NWAVES * 64), LDS_BYTES, stream, a);
#else
    for (int ph = 0; ph < NPHASE; ++ph) { a.ph_lo = ph; a.ph_hi = ph + 1;
        hipLaunchKernelGGL(hybrid_fwd, dim3(grid), dim3(NWAVES * 64), LDS_BYTES, stream, a); }
#endif
}
```

```cpp
#include <hip/hip_runtime.h>
#include <cstdio>
#include <cstdint>
namespace pg8 {
#define PG8_LAS __attribute__((address_space(3)))
typedef unsigned short bf16_t;
typedef short bf16x8 __attribute__((ext_vector_type(8)));
typedef float f32x4 __attribute__((ext_vector_type(4)));
typedef unsigned u32x4 __attribute__((ext_vector_type(4)));
constexpr int BM = 256, BK = 64, HALF = 128, HTB = HALF * BK * 2  , STAGE_BYTES = 8 * HTB, NXCD = 8, WGM = 8;

__host__ __device__ __forceinline__ int lds_byte(int r, int c) { const int st = (r >> 4) * 2 + (c >> 5), rr = r & 15, cc = c & 31, ob = rr * 64 + cc * 2; return st * 1024 + (ob ^ (((ob >> 9) & 1) << 5)); }
__host__ __device__ __forceinline__ void stage_rc(int b, int& R, int& C) { const int st = b / 1024, sb = b % 1024, swz = sb ^ (((sb >> 9) & 1) << 5); R = (st >> 1) * 16 + swz / 64; C = (st & 1) * 32 + (swz % 64) / 2; }
__host__ __device__ __forceinline__ int perm32(int rho) { const int n = rho >> 4, i = rho & 15; return 8 * (i >> 2) + 4 * n + (i & 3); }

struct Unit { int pm, pn; };
struct Gemm { const bf16_t* A; const bf16_t* Bt; int M, N, K; };

struct StaticOrder {
    int nM, nN, nwg, G, c;
    __host__ __device__ void init(int M, int N, int G_, int c_) { nM = M / BM; nN = N / BM; nwg = nM * nN; G = G_; c = c_; }
    __host__ __device__ bool next(int i, Unit& u) const {
        const long L = (long)i * G + c; if (L >= nwg) return false;
        int wgid = (int)L; { const int q = nwg / NXCD, r = nwg % NXCD, xcd = wgid % NXCD, off = wgid / NXCD; wgid = (xcd < r ? xcd * (q + 1) : r * (q + 1) + (xcd - r) * q) + off; }
        const int nig = WGM * nN, gid = wgid / nig, fm = gid * WGM, gsz = (nM - fm) < WGM ? (nM - fm) : WGM;
        u.pm = fm + ((wgid % nig) % gsz); u.pn = (wgid % nig) / gsz; return true;
    }
    __device__ __forceinline__ void a_ready(const Unit&) const {}
    __device__ __forceinline__ void done(const Unit&) const {}
};

__device__ __forceinline__ unsigned cvt_pk_bf16(float lo, float hi) { unsigned r; asm volatile("v_cvt_pk_bf16_f32 %0, %1, %2" : "=v"(r) : "v"(lo), "v"(hi)); return r; }
typedef float f32x2 __attribute__((ext_vector_type(2)));
__device__ __forceinline__ float sigm(float x) { return __builtin_amdgcn_rcpf(1.0f + __expf(-x)); }
__device__ __forceinline__ float bf_lo(unsigned w) { return __uint_as_float(w << 16); }
__device__ __forceinline__ float bf_hi(unsigned w) { return __uint_as_float(w & 0xffff0000u); }
__device__ __forceinline__ u32x4 pack8(const f32x4& v0, const f32x4& v1) { u32x4 w; w.x = cvt_pk_bf16(v0[0], v0[1]); w.y = cvt_pk_bf16(v0[2], v0[3]); w.z = cvt_pk_bf16(v1[0], v1[1]); w.w = cvt_pk_bf16(v1[2], v1[3]); return w; }

struct EpiF32 {
    static constexpr bool PERM = false, AFTER_DRAIN = false;
    float* C; int ldc;
    __device__ __forceinline__ void operator()(const f32x4 (&acc)[2][2][4][2], const Unit& u, int wr, int wc, int fr, int fq) const {
        const int row0 = u.pm * BM + wr * 64 + fr, col0 = u.pn * BM + wc * 32 + 4 * fq;
#pragma unroll
        for (int ai = 0; ai < 2; ++ai)
#pragma unroll
            for (int m = 0; m < 4; ++m) { float* rowp = C + (size_t)(row0 + ai * HALF + m * 16) * ldc + col0;
#pragma unroll
                for (int bj = 0; bj < 2; ++bj)
#pragma unroll
                    for (int n = 0; n < 2; ++n) *(f32x4*)(rowp + bj * HALF + n * 16) = acc[ai][bj][m][n]; }
    }
};
struct EpiRoute {
    static constexpr bool PERM = true, AFTER_DRAIN = false;
    bf16_t *poolu, *s5u, *q, *qi, *kvx, *gates;
    __device__ __forceinline__ void operator()(const f32x4 (&acc)[2][2][4][2], const Unit& u, int wr, int wc, int fr, int fq) const {
        const int row0 = u.pm * BM + wr * 64 + fr; const int pn = u.pn;
        bf16_t* base; int ld, colt, mode = 0;
        if (pn < 2) { base = poolu; ld = 512; colt = pn * 256; }
        else if (pn < 4) { base = s5u; ld = 512; colt = (pn - 2) * 256; }
        else if (pn < 8) { base = q; ld = 1024; colt = (pn - 4) * 256; mode = 2; }
        else if (pn < 10) { base = qi; ld = 512; colt = (pn - 8) * 256; }
        else if (pn == 10) { base = kvx; ld = 256; colt = 0; }
        else { base = gates; ld = 3072; colt = (pn - 11) * 256; mode = 1; }
        const int col0 = colt + wc * 32 + 8 * fq;
#pragma unroll
        for (int ai = 0; ai < 2; ++ai)
#pragma unroll
            for (int m = 0; m < 4; ++m) { bf16_t* rowp = base + (size_t)(row0 + ai * HALF + m * 16) * ld + col0;
#pragma unroll
                for (int bj = 0; bj < 2; ++bj) { f32x4 v0 = acc[ai][bj][m][0], v1 = acc[ai][bj][m][1];
                    if (mode == 1) {
#pragma unroll
                        for (int j = 0; j < 4; ++j) { v0[j] = sigm(v0[j]); v1[j] = sigm(v1[j]); } }
                    else if (mode == 2) { v0 = v0 * 0.125f; v1 = v1 * 0.125f; }
                    *(u32x4*)(rowp + bj * HALF) = pack8(v0, v1); } }
    }
};
struct EpiGlu {
    static constexpr bool PERM = true, AFTER_DRAIN = false;
    bf16_t* merged; const bf16_t* gates;
    __device__ __forceinline__ void operator()(const f32x4 (&acc)[2][2][4][2], const Unit& u, int wr, int wc, int fr, int fq) const {
        const int row0 = u.pm * BM + wr * 64 + fr, col0 = u.pn * HALF + wc * 32 + 8 * fq;
#pragma unroll
        for (int ai = 0; ai < 2; ++ai)
#pragma unroll
            for (int m = 0; m < 4; ++m) { const size_t row = (size_t)(row0 + ai * HALF + m * 16);
                const u32x4 g = *(const u32x4*)(gates + row * 3072 + 2048 + col0);
                f32x4 a0 = acc[ai][0][m][0], a1 = acc[ai][0][m][1]; const f32x4 s0 = acc[ai][1][m][0], s1 = acc[ai][1][m][1];
#pragma unroll
                for (int j = 0; j < 4; ++j) { a0[j] *= sigm(s0[j]); a1[j] *= sigm(s1[j]); }
                a0[0] *= bf_lo(g.x); a0[1] *= bf_hi(g.x); a0[2] *= bf_lo(g.y); a0[3] *= bf_hi(g.y);
                a1[0] *= bf_lo(g.z); a1[1] *= bf_hi(g.z); a1[2] *= bf_lo(g.w); a1[3] *= bf_hi(g.w);
                *(u32x4*)(merged + row * 1024 + col0) = pack8(a0, a1);
                asm volatile("" ::: "memory"); }
    }
};
template <int GOFF> struct EpiAccum {
    static constexpr bool PERM = true, AFTER_DRAIN = false;
    bf16_t* merged; const bf16_t* gates;
    __device__ __forceinline__ void operator()(const f32x4 (&acc)[2][2][4][2], const Unit& u, int wr, int wc, int fr, int fq) const {
        const int row0 = u.pm * BM + wr * 64 + fr, col0 = u.pn * BM + wc * 32 + 8 * fq;
#pragma unroll
        for (int ai = 0; ai < 2; ++ai)
#pragma unroll
            for (int m = 0; m < 4; ++m) { const size_t row = (size_t)(row0 + ai * HALF + m * 16);
#pragma unroll
                for (int bj = 0; bj < 2; ++bj) { const int c = col0 + bj * HALF;
                    const u32x4 g = *(const u32x4*)(gates + row * 3072 + GOFF + c); const u32x4 o = *(const u32x4*)(merged + row * 1024 + c);
                    f32x4 a0 = acc[ai][bj][m][0], a1 = acc[ai][bj][m][1];
                    a0[0] = a0[0] * bf_lo(g.x) + bf_lo(o.x); a0[1] = a0[1] * bf_hi(g.x) + bf_hi(o.x); a0[2] = a0[2] * bf_lo(g.y) + bf_lo(o.y); a0[3] = a0[3] * bf_hi(g.y) + bf_hi(o.y);
                    a1[0] = a1[0] * bf_lo(g.z) + bf_lo(o.z); a1[1] = a1[1] * bf_hi(g.z) + bf_hi(o.z); a1[2] = a1[2] * bf_lo(g.w) + bf_lo(o.w); a1[3] = a1[3] * bf_hi(g.w) + bf_hi(o.w);
                    *(u32x4*)(merged + row * 1024 + c) = pack8(a0, a1); }
                asm volatile("" ::: "memory"); }
    }
};
struct EpiSwiglu {
    static constexpr bool PERM = true, AFTER_DRAIN = false;
    bf16_t* hid; int ldh;
    __device__ __forceinline__ void operator()(const f32x4 (&acc)[2][2][4][2], const Unit& u, int wr, int wc, int fr, int fq) const {
        const int row0 = u.pm * BM + wr * 64 + fr, col0 = u.pn * HALF + wc * 32 + 8 * fq;
#pragma unroll
        for (int ai = 0; ai < 2; ++ai)
#pragma unroll
            for (int m = 0; m < 4; ++m) { const size_t row = (size_t)(row0 + ai * HALF + m * 16);
                f32x4 g0 = acc[ai][0][m][0], g1 = acc[ai][0][m][1]; const f32x4 u0 = acc[ai][1][m][0], u1 = acc[ai][1][m][1];
#pragma unroll
                for (int j = 0; j < 4; ++j) { g0[j] = g0[j] * sigm(g0[j]) * u0[j]; g1[j] = g1[j] * sigm(g1[j]) * u1[j]; }
                *(u32x4*)(hid + row * ldh + col0) = pack8(g0, g1); }
    }
};
struct PairOrder {
    StaticOrder base;
    __device__ bool next(int i, Unit& u) const { Unit b; if (!base.next(i >> 1, b)) return false; u.pm = b.pm; u.pn = 2 * b.pn + (i & 1); return true; }
    __device__ __forceinline__ void a_ready(const Unit&) const {}
    __device__ __forceinline__ void done(const Unit&) const {}
};

template <class Epi, class Sched, bool ALIGN_EPI = false, bool SP2 = false>
__device__ __forceinline__ void gemm_phase(PG8_LAS unsigned char* lds, const Gemm g, const Sched& S, const Epi& E) {
    int tid_ = threadIdx.x; asm volatile("" : "+v"(tid_));
    const int tid = tid_, wid = __builtin_amdgcn_readfirstlane(tid >> 6), lane = tid & 63, wr = wid >> 2, wc = wid & 3, fr = lane & 15, fq = lane >> 4;
    const int K = g.K, nt = K / BK;
    unsigned voffA[2], voffB[2];
#pragma unroll
    for (int i = 0; i < 2; ++i) { int R, C; stage_rc(tid * 16 + i * 8192, R, C); const int Rb = Epi::PERM ? ((R & ~31) + perm32(R & 31)) : R;
        voffA[i] = (unsigned)(R * K + C) * 2u; voffB[i] = (unsigned)(Rb * K + C) * 2u; }
    const size_t kstep = (size_t)(BK * 2);
    const size_t hstep = (size_t)HALF * K * 2;
    const size_t tstep = 2 * hstep;
    const unsigned ldsw = (unsigned)wid * 1024u;
    const int aoff = lds_byte(wr * 64 + fr, fq * 8), boff = lds_byte(wc * 32 + fr, fq * 8);
#define PG8_SA(b, h) (((b) * 2 + (h)) * HTB)
#define PG8_SB(b, h) ((4 + (b) * 2 + (h)) * HTB)
#define PG8_STAGE(bufoff, gbase, voff) do { _Pragma("unroll") for (int _i = 0; _i < 2; ++_i) \
        __builtin_amdgcn_global_load_lds((const unsigned*)((const char*)(gbase) + (voff)[_i]), (PG8_LAS unsigned*)(lds + (bufoff) + ldsw + _i * 8192), 16, 0, 0); } while (0)
#define PG8_LDA(dst, b, h) do { _Pragma("unroll") for (int m = 0; m < 4; ++m) _Pragma("unroll") for (int k = 0; k < 2; ++k) dst[m][k] = *(const PG8_LAS bf16x8*)(lds + PG8_SA(b, h) + aoff + m * 2048 + k * 1024); } while (0)
#define PG8_LDB(dst, b, h) do { _Pragma("unroll") for (int n = 0; n < 2; ++n) _Pragma("unroll") for (int k = 0; k < 2; ++k) dst[n][k] = *(const PG8_LAS bf16x8*)(lds + PG8_SB(b, h) + boff + n * 2048 + k * 1024); } while (0)
#define PG8_MMA(ai, bj, At, Bt) do { __builtin_amdgcn_s_setprio(1); _Pragma("unroll") for (int m = 0; m < 4; ++m) _Pragma("unroll") for (int n = 0; n < 2; ++n) _Pragma("unroll") for (int k = 0; k < 2; ++k) \
        acc[ai][bj][m][n] = __builtin_amdgcn_mfma_f32_16x16x32_bf16(Bt[n][k], At[m][k], acc[ai][bj][m][n], 0, 0, 0); __builtin_amdgcn_s_setprio(0); } while (0)
#define PG8_WAIT_V(n) asm volatile("s_waitcnt vmcnt(" #n ")" ::: "memory")
#define PG8_WAIT_L(n) asm volatile("s_waitcnt lgkmcnt(" #n ")" ::: "memory")
#define PG8_BAR __builtin_amdgcn_s_barrier()
#define PG8_SCHED __builtin_amdgcn_sched_barrier(0)
    Unit cur, nxt; int ui = 0;
    if (!S.next(0, cur)) return;
    f32x4 acc[2][2][4][2];
#pragma unroll
    for (int a = 0; a < 2; ++a)
#pragma unroll
        for (int b = 0; b < 2; ++b)
#pragma unroll
            for (int m = 0; m < 4; ++m)
#pragma unroll
                for (int n = 0; n < 2; ++n) acc[a][b][m][n] = (f32x4){0.f, 0.f, 0.f, 0.f};
    bf16x8 At[4][2], B0[2][2], B1[2][2];
    const char* cA = (const char*)g.A + (size_t)cur.pm * tstep; const char* cB = (const char*)g.Bt + (size_t)cur.pn * tstep;
    S.a_ready(cur);
    if constexpr (SP2) {
        PG8_STAGE(PG8_SB(0, 0), cB, voffB); PG8_STAGE(PG8_SB(0, 1), cB + hstep, voffB); PG8_STAGE(PG8_SA(0, 0), cA, voffA); PG8_STAGE(PG8_SA(0, 1), cA + hstep, voffA);
        if (wr == 1) PG8_BAR;
        PG8_WAIT_V(2); PG8_BAR;
        PG8_STAGE(PG8_SB(1, 0), cB + kstep, voffB); PG8_STAGE(PG8_SA(1, 0), cA + kstep, voffA); PG8_STAGE(PG8_SB(1, 1), cB + hstep + kstep, voffB);
        PG8_WAIT_V(6); PG8_BAR;
    } else {
        PG8_STAGE(PG8_SB(0, 0), cB, voffB); PG8_STAGE(PG8_SA(0, 0), cA, voffA); PG8_STAGE(PG8_SB(0, 1), cB + hstep, voffB); PG8_STAGE(PG8_SA(0, 1), cA + hstep, voffA);
        if (wr == 1) PG8_BAR;
        PG8_WAIT_V(4); PG8_BAR;
        PG8_STAGE(PG8_SB(1, 0), cB + kstep, voffB); PG8_STAGE(PG8_SA(1, 0), cA + kstep, voffA); PG8_STAGE(PG8_SB(1, 1), cB + hstep + kstep, voffB);
        PG8_WAIT_V(6); PG8_BAR;
    }
    for (;;) {
        const bool has_next = S.next(ui + 1, nxt);
        const char* nA = has_next ? (const char*)g.A + (size_t)nxt.pm * tstep : cA; const char* nB = has_next ? (const char*)g.Bt + (size_t)nxt.pn * tstep : cB;
        for (int t = 0; t < nt; t += 2) {
            const bool last = (t == nt - 2);
            const char* a1 = cA + (size_t)(t + 1) * kstep;
            const char* a2 = last ? nA : cA + (size_t)(t + 2) * kstep; const char* b2 = last ? nB : cB + (size_t)(t + 2) * kstep;
            const char* a3 = a2 + kstep; const char* b3 = b2 + kstep;
            if (last && has_next) S.a_ready(nxt);
            if constexpr (SP2) {
            PG8_LDB(B0, 0, 0); PG8_LDB(B1, 0, 1); PG8_SCHED; PG8_LDA(At, 0, 0); PG8_STAGE(PG8_SA(1, 1), a1 + hstep, voffA);
            PG8_WAIT_V(8); PG8_WAIT_L(0); PG8_BAR; PG8_MMA(0, 0, At, B0); PG8_MMA(0, 1, At, B1); PG8_BAR; PG8_SCHED;
            PG8_LDA(At, 0, 1); PG8_STAGE(PG8_SB(0, 0), b2, voffB); PG8_STAGE(PG8_SB(0, 1), b2 + hstep, voffB); PG8_STAGE(PG8_SA(0, 0), a2, voffA);
            PG8_WAIT_V(8); PG8_WAIT_L(0); PG8_BAR; PG8_MMA(1, 0, At, B0); PG8_MMA(1, 1, At, B1); PG8_BAR; PG8_SCHED;
            PG8_LDB(B0, 1, 0); PG8_LDB(B1, 1, 1); PG8_SCHED; PG8_LDA(At, 1, 0); PG8_STAGE(PG8_SA(0, 1), a2 + hstep, voffA);
            PG8_WAIT_V(8); PG8_WAIT_L(0); PG8_BAR; PG8_MMA(0, 0, At, B0); PG8_MMA(0, 1, At, B1); PG8_BAR; PG8_SCHED;
            PG8_LDA(At, 1, 1); PG8_STAGE(PG8_SB(1, 0), b3, voffB); PG8_STAGE(PG8_SB(1, 1), b3 + hstep, voffB); PG8_STAGE(PG8_SA(1, 0), a3, voffA);
            PG8_WAIT_V(8); PG8_WAIT_L(0); PG8_BAR; PG8_MMA(1, 0, At, B0); PG8_MMA(1, 1, At, B1); PG8_BAR; PG8_SCHED;
            } else {
            PG8_LDB(B0, 0, 0); PG8_SCHED; PG8_LDA(At, 0, 0); PG8_STAGE(PG8_SA(1, 1), a1 + hstep, voffA);
            PG8_WAIT_L(8); PG8_BAR; PG8_WAIT_L(0); PG8_MMA(0, 0, At, B0); PG8_BAR; PG8_SCHED;
            PG8_LDB(B1, 0, 1); PG8_STAGE(PG8_SB(0, 0), b2, voffB);
            PG8_BAR; PG8_WAIT_L(0); PG8_MMA(0, 1, At, B1); PG8_BAR;
            PG8_LDA(At, 0, 1); PG8_STAGE(PG8_SA(0, 0), a2, voffA);
            PG8_BAR; PG8_WAIT_L(0); PG8_MMA(1, 0, At, B0); PG8_BAR; PG8_SCHED;
            PG8_STAGE(PG8_SB(0, 1), b2 + hstep, voffB);
            PG8_WAIT_V(6); PG8_BAR; PG8_MMA(1, 1, At, B1); PG8_BAR;
            PG8_LDB(B0, 1, 0); PG8_SCHED; PG8_LDA(At, 1, 0); PG8_STAGE(PG8_SA(0, 1), a2 + hstep, voffA);
            PG8_WAIT_L(8); PG8_BAR; PG8_WAIT_L(0); PG8_MMA(0, 0, At, B0); PG8_BAR; PG8_SCHED;
            PG8_LDB(B1, 1, 1); PG8_STAGE(PG8_SB(1, 0), b3, voffB);
            PG8_BAR; PG8_WAIT_L(0); PG8_MMA(0, 1, At, B1); PG8_BAR;
            PG8_LDA(At, 1, 1); PG8_STAGE(PG8_SA(1, 0), a3, voffA);
            PG8_BAR; PG8_WAIT_L(0); PG8_MMA(1, 0, At, B0); PG8_BAR; PG8_SCHED;
            PG8_STAGE(PG8_SB(1, 1), b3 + hstep, voffB);
            PG8_WAIT_V(6); PG8_BAR; PG8_MMA(1, 1, At, B1); PG8_BAR;
            }
        }
        if constexpr (ALIGN_EPI) { if (wr == 0) PG8_BAR; }
        if constexpr (!Epi::AFTER_DRAIN) { E(acc, cur, wr, wc, fr, fq); S.done(cur); }
        if (!has_next) break;
#pragma unroll
        for (int a = 0; a < 2; ++a)
#pragma unroll
            for (int b = 0; b < 2; ++b)
#pragma unroll
                for (int m = 0; m < 4; ++m)
#pragma unroll
                    for (int n = 0; n < 2; ++n) acc[a][b][m][n] = (f32x4){0.f, 0.f, 0.f, 0.f};
        cur = nxt; cA = nA; cB = nB; ++ui;
        if constexpr (ALIGN_EPI) { if (wr == 1) PG8_BAR; }
    }
    PG8_WAIT_V(0);
    if constexpr (!ALIGN_EPI) { if (wr == 0) PG8_BAR; }
    PG8_BAR;
    if constexpr (Epi::AFTER_DRAIN) { E.fused(acc, cur, wr, wc, fr, fq, lds, wid, lane); S.done(cur); }
#undef PG8_SA
#undef PG8_SB
#undef PG8_STAGE
#undef PG8_LDA
#undef PG8_LDB
#undef PG8_MMA
#undef PG8_WAIT_V
#undef PG8_WAIT_L
#undef PG8_BAR
#undef PG8_SCHED
}
}

constexpr int NWAVES = 8;
constexpr int BATCH = 8, SEQ = 2048, D = 1024, M = BATCH * SEQ;
constexpr int INW = 5832, N1P = 5888, FF = 2816, NLAYER = 2;
constexpr float NORM_EPS = 1e-6f;
constexpr size_t MiB = 1u << 20;
constexpr size_t WS_CTL = 0, CTL_ZERO_BYTES = 1 * MiB;
constexpr size_t WS_WINT = 1 * MiB;
constexpr size_t WS_ATTNOT = WS_WINT + (size_t)N1P * D * 2;
constexpr size_t WS_POOLET = WS_ATTNOT + 2 * MiB;
constexpr size_t WS_GLUT = WS_POOLET + 1 * MiB;
constexpr size_t WS_WOUTT = WS_GLUT + 2 * MiB;
constexpr size_t WS_S5T = WS_WOUTT + 2 * MiB;
constexpr size_t WS_S5P = WS_S5T + 4 * MiB;
constexpr size_t WS_S5Q = WS_S5P + 2 * MiB;
constexpr size_t WS_S5A = WS_S5Q + 2 * MiB;
constexpr size_t WS_BIAS = WS_S5A + 65536;
static_assert(WS_BIAS + 8192 <= 29 * MiB, "weights region");
constexpr size_t WS_HB = 29 * MiB;
constexpr size_t WS_DP = WS_HB, WS_ZB = WS_HB + 16 * MiB;
constexpr size_t WS_POOLU = 61 * MiB, WS_S5U = 77 * MiB;
constexpr size_t WS_MERGED = WS_POOLU;
constexpr size_t WS_FFNINT = WS_POOLU, WS_FFNOUTT = WS_POOLU + 11 * MiB;
constexpr size_t WS_Q = 93 * MiB, WS_QI = 125 * MiB, WS_KVX = 141 * MiB, WS_GATES = 149 * MiB;
constexpr size_t WS_F = WS_Q;
constexpr size_t WS_HID = 157 * MiB;
constexpr size_t WS_END = 245 * MiB;
static_assert(WS_FFNOUTT + (size_t)D * FF * 2 <= WS_Q && WS_HID + (size_t)M * FF * 2 <= WS_END && WS_F + (size_t)M * D * 4 <= WS_HID, "d_ws map");
constexpr int CW_BAR = 4096;
constexpr int RING_OFF = 0, RING_BYTES = 131072;
constexpr int LDSCTL_OFF = RING_BYTES, MISC_OFF = LDSCTL_OFF + 320;
constexpr int LDS_BYTES = 147456;
constexpr int NPHASE = 1 + 8 * NLAYER;

#define GAS __attribute__((address_space(1)))
#define LAS __attribute__((address_space(3)))
typedef unsigned short bf16;
typedef unsigned v4u __attribute__((ext_vector_type(4)));
typedef float f32x4 __attribute__((ext_vector_type(4)));
typedef short bf16x8 __attribute__((ext_vector_type(8)));
typedef GAS unsigned gu32;
typedef GAS unsigned long long gu64;
#define RLX_AGENT __ATOMIC_RELAXED, __HIP_MEMORY_SCOPE_AGENT
#define LDS_WAIT() asm volatile("s_waitcnt lgkmcnt(0)" ::: "memory")
#define VM_WAIT() asm volatile("s_waitcnt vmcnt(0)" ::: "memory")
__device__ __forceinline__ unsigned long long rt() { return __builtin_amdgcn_s_memrealtime(); }
__device__ __forceinline__ unsigned f2bf(float f) { unsigned u = __builtin_bit_cast(unsigned, f); return (u + 0x7fffu + ((u >> 16) & 1u)) >> 16; }
__device__ __forceinline__ unsigned pk2(float lo, float hi) { return f2bf(lo) | (f2bf(hi) << 16); }
#define XB_TMO      128
#define XB_XCNT(j)  (256  + 64 * (j))
#define XB_XSUB(j)  (1280 + 64 * (j))
#define XB_XGEN(j)  (2304 + 64 * (j))
#define XB_TOP      3328
#define XB_TOPGEN   3392
#define XCD_BAR_WORDS 3456
#define XB_SPIN_CAP (1u << 18)

__device__ __forceinline__ unsigned xb_ld(unsigned* p)              { return __hip_atomic_load(p, __ATOMIC_RELAXED, __HIP_MEMORY_SCOPE_AGENT); }
__device__ __forceinline__ unsigned xb_add(unsigned* p, unsigned v) { return __hip_atomic_fetch_add(p, v, __ATOMIC_RELAXED, __HIP_MEMORY_SCOPE_AGENT); }
__device__ __forceinline__ unsigned xb_xcc_id() { return (unsigned)__builtin_amdgcn_s_getreg((3 << 11) | 20) & 0xFu; }
#define XB_SPIN(cond, bar) do { unsigned _sp = 0; while (cond) { __builtin_amdgcn_s_sleep(1); \
    if ((++_sp & 255u) == 0u) { if (xb_ld(&(bar)[XB_TMO])) break; if (_sp > XB_SPIN_CAP) { atomicAdd(&(bar)[XB_TMO], 1u); break; } } } } while (0)

struct XcdBarrier {
    unsigned* bar; unsigned x;
    volatile LAS unsigned* st;
};

__device__ __forceinline__ XcdBarrier xcd_barrier_post(unsigned* bar, volatile LAS unsigned* st) {
    XcdBarrier b; b.bar = bar; b.x = xb_xcc_id(); b.st = st;
    if (threadIdx.x == 0) (void)xb_add(&bar[XB_XCNT(b.x)], 1u);
    return b;
}
__device__ __forceinline__ void xcd_barrier_complete(unsigned* bar, unsigned x, unsigned& nloc, unsigned& nx) {
    const unsigned G = gridDim.x * gridDim.y * gridDim.z;
    unsigned sum, cnt, mine, sp = 0u;
    for (;;) {
        sum = 0u; cnt = 0u; mine = 0u;
#pragma unroll
        for (unsigned j = 0; j < 16; ++j) { const unsigned c = xb_ld(&bar[XB_XCNT(j)]); sum += c; cnt += (c > 0u) ? 1u : 0u; mine = (j == x) ? c : mine; }
        if (sum == G) break;
        __builtin_amdgcn_s_sleep(1);
        if ((++sp & 255u) == 0u) { if (xb_ld(&bar[XB_TMO])) break; if (sp > XB_SPIN_CAP) { atomicAdd(&bar[XB_TMO], 1u); break; } }
    }
    nloc = mine > 0u ? mine : 1u; nx = cnt > 0u ? cnt : 1u;
}

__device__ __forceinline__ void xcd_barrier(const XcdBarrier& b) {
    asm volatile("s_waitcnt vmcnt(0)" ::: "memory");
    __syncthreads();
    if (threadIdx.x == 0) {
        unsigned* bar = b.bar;
        __builtin_amdgcn_s_waitcnt(0);
        unsigned nloc = b.st[0], nx = b.st[1];
        if (nloc == 0u) { xcd_barrier_complete(bar, b.x, nloc, nx); b.st[0] = nloc; b.st[1] = nx; }
        const unsigned old = xb_add(&bar[XB_XSUB(b.x)], 1u);
        const unsigned gen = old / nloc;
        if (old + 1u == (gen + 1u) * nloc) {
            __builtin_amdgcn_fence(__ATOMIC_RELEASE, "agent");
            asm volatile("s_waitcnt vmcnt(0)" ::: "memory");
            const unsigned og = xb_add(&bar[XB_TOP], 1u);
            const unsigned tg = og / nx;
            if (og + 1u == (tg + 1u) * nx) xb_add(&bar[XB_TOPGEN], 1u);
            else XB_SPIN(xb_ld(&bar[XB_TOPGEN]) == tg, bar);
            __builtin_amdgcn_fence(__ATOMIC_ACQUIRE, "agent");
            xb_add(&bar[XB_XGEN(b.x)], 1u);
            asm volatile("s_waitcnt vmcnt(0)" ::: "memory");
        } else {
            XB_SPIN(xb_ld(&bar[XB_XGEN(b.x)]) == gen, bar);
            __builtin_amdgcn_fence(__ATOMIC_ACQUIRE, "agent");
            asm volatile("s_waitcnt vmcnt(0)" ::: "memory");
        }
    }
    __syncthreads();
}

typedef short s16x4 __attribute__((ext_vector_type(4)));
typedef short v4i16_t __attribute__((ext_vector_type(4)));
typedef unsigned short u16x4 __attribute__((ext_vector_type(4)));
typedef unsigned v2u __attribute__((ext_vector_type(2)));
typedef float f32x2v __attribute__((ext_vector_type(2)));
#define DI __device__ __forceinline__
struct Frame {
    LAS unsigned char* lds;
    int tid, lane, wave, G;
};
DI float wave_sum(float v) {
#pragma unroll
    for (int o = 1; o < 64; o <<= 1) v += __shfl_xor(v, o);
    return v;
}
DI bf16x8 ldg16(const bf16* p) { return *(const GAS bf16x8*)p; }
DI bf16x8 ldg16o(const bf16* ub, unsigned off) { return *(const GAS bf16x8*)((const GAS unsigned char*)ub + off); }
DI v4u ldg16u(const bf16* ub, unsigned off) { return *(const GAS v4u*)((const GAS unsigned char*)ub + off); }
DI float bf2f(bf16 b) { return __uint_as_float(((unsigned)b) << 16); }
DI float bflo(unsigned w) { return __uint_as_float(w << 16); }
DI float bfhi(unsigned w) { return __uint_as_float(w & 0xffff0000u); }
#define MFMA16(a, b, c) __builtin_amdgcn_mfma_f32_16x16x32_bf16((a), (b), (c), 0, 0, 0)

struct MapId { DI int operator()(int n) const { return n; } };
struct MapWin { DI int operator()(int n) const {
    if (n < 512) return n;
    if (n < 1536) return n + 512;
    if (n < 1600) return n - 1536 + 2560;
    if (n < 1664) return n - 1600 + 2624;
    if (n < 2176) return n - 1664 + 2048;
    if (n < 2240) return n - 2176 + 2688;
    if (n < 2248) return n - 2240 + 2752;
    if (n < 2760) return n - 2248 + 512;
    return n - 2760 + 2816; } };
struct MapIl { int half; DI int operator()(int n) const { const int hi = n >= half ? 1 : 0, m = n - hi * half; return (m >> 7) * 256 + hi * 128 + (m & 127); } };
template <class Map> DI void transpose_item(const float* W, int K, int Ns, bf16* WT, LAS float* scr, int item, int lane, const Map& map) {
    const int nblk = (Ns + 31) / 32, kb = item / nblk, nb = item % nblk, k0 = 64 * kb, n0 = 32 * nb;
    const int nl = n0 + (lane & 31);
#pragma unroll 8
    for (int i = 0; i < 32; ++i) { const int kk = 2 * i + (lane >> 5); scr[kk * 33 + (lane & 31)] = nl < Ns ? W[(size_t)(k0 + kk) * Ns + nl] : 0.f; }
    LDS_WAIT(); asm volatile("" ::: "memory");
    const int c = lane & 7;
#pragma unroll
    for (int j = 0; j < 4; ++j) { const int nn = (lane >> 3) + 8 * j; const LAS float* s = scr + (8 * c) * 33 + nn;
        if (n0 + nn < Ns) { const int dr = map(n0 + nn);
            v4u o; o.x = pk2(s[0 * 33], s[1 * 33]); o.y = pk2(s[2 * 33], s[3 * 33]); o.z = pk2(s[4 * 33], s[5 * 33]); o.w = pk2(s[6 * 33], s[7 * 33]);
            *(GAS v4u*)(WT + (size_t)dr * K + k0 + 8 * c) = o; } }
    LDS_WAIT(); asm volatile("" ::: "memory");
}
struct In {
    const float *x, *n_mix_pre, *n_mix_post, *n_ffn_pre, *n_ffn_post, *w_in, *pool_mix_w, *pool_scale, *pool_out_w, *attn_out_w, *rel_bias, *lam_re, *lam_im, *log_dt,
                *b_re, *b_im, *c_re, *c_im, *s5_d, *glu_w, *w_out, *ffn_w_in, *ffn_w_out;
};
struct Args { In in; float* out; unsigned char* ws; int ph_lo, ph_hi; };
typedef const __attribute__((address_space(4))) Args* KArgs;
DI KArgs kargs() { KArgs p = (KArgs)__builtin_amdgcn_kernarg_segment_ptr(); asm volatile("" : "+s"(p)); return p; }
template <class T> DI T* opq(T* p) { asm volatile("" : "+s"(p)); return p; }
DI int opqv(int v) { asm volatile("" : "+v"(v)); return v; }

DI void convert_A(Frame& F, KArgs A, unsigned char* ws, int l) {
    LAS float* scr = (LAS float*)(F.lds + RING_OFF + F.wave * 16384);
    const int gw = blockIdx.x * NWAVES + F.wave, NGW = F.G * NWAVES;
    const int gt = blockIdx.x * (NWAVES * 64) + F.tid, NGT = F.G * NWAVES * 64;
    bf16* WINT = (bf16*)(ws + WS_WINT); bf16* ATTNOT = (bf16*)(ws + WS_ATTNOT); bf16* POOLET = (bf16*)(ws + WS_POOLET); bf16* GLUT = (bf16*)(ws + WS_GLUT); bf16* WOUTT = (bf16*)(ws + WS_WOUTT);
    constexpr int I_WIN = (D / 64) * ((INW + 31) / 32), I_SQ = (D / 64) * (D / 32), I_GLU = (512 / 64) * (2048 / 32);
    constexpr int NITEMS = I_WIN + 2 * I_SQ + I_GLU;
    for (int it = gw; it < NITEMS; it += NGW) {
        int r = it;
        if (r < I_WIN) { transpose_item(A->in.w_in + (size_t)l * D * INW, D, INW, WINT, scr, r, F.lane, MapWin{}); continue; } r -= I_WIN;
        if (r < I_SQ) { transpose_item(A->in.attn_out_w + (size_t)l * D * D, D, D, ATTNOT, scr, r, F.lane, MapId{}); continue; } r -= I_SQ;
        if (r < I_SQ) { transpose_item(A->in.w_out + (size_t)l * D * D, D, D, WOUTT, scr, r, F.lane, MapId{}); continue; } r -= I_SQ;
        transpose_item(A->in.glu_w + (size_t)l * 512 * 2048, 512, 2048, GLUT, scr, r, F.lane, MapIl{1024});
    }
    for (int i = gt; i < 56 * D / 8; i += NGT) *(GAS v4u*)(WINT + (size_t)2760 * D + (size_t)i * 8) = (v4u){0u, 0u, 0u, 0u};
    {   const float* mw = A->in.pool_mix_w + (size_t)l * 4 * 128 * 128; const float* sc = A->in.pool_scale + (size_t)l * 512; const float* pw = A->in.pool_out_w + (size_t)l * 512 * D;
        for (int idx = gt; idx < 512 * D; idx += NGT) { const int n = idx & (D - 1), gc = idx >> 10, g = gc >> 7;
            const float* mrow = mw + (size_t)gc * 128; float s = 0.f;
            for (int d = 0; d < 128; ++d) s += mrow[d] * sc[g * 128 + d] * pw[(size_t)(g * 128 + d) * D + n];
            POOLET[(size_t)n * 512 + gc] = (bf16)f2bf(s); } }
    if (blockIdx.x == 0) { float* BT = (float*)(ws + WS_BIAS);
        for (int i = F.tid; i < 128 * 16; i += NWAVES * 64) { const int d = i >> 4, h = i & 15;
            int bk = d; if (d >= 16) { bk = 16 + (int)(logf((float)d / 16.0f) / logf(8.0f) * 16.0f); bk = bk > 31 ? 31 : bk; }
            BT[i] = A->in.rel_bias[bk * 16 + h]; } }
    {   bf16* S5T = (bf16*)(ws + WS_S5T); bf16* S5P = (bf16*)(ws + WS_S5P); bf16* S5Q = (bf16*)(ws + WS_S5Q); float* S5A = (float*)(ws + WS_S5A);
        LAS float* apr = (LAS float*)(F.lds + RING_OFF);
        LAS float* api = apr + 17 * 64;
        LAS float* bbr = api + 17 * 64;
        LAS float* bbi = bbr + 64 * 16;
        LAS float* Kt = bbi + 64 * 16;
        __syncthreads();
        for (int task = blockIdx.x; task < 256; task += F.G) { const int g = task & 31, sub = task >> 5; const int lg = l * 32 + g;
            if (F.tid < 64) { const int n = F.tid;
                const float lr = A->in.lam_re[lg * 64 + n], li = A->in.lam_im[lg * 64 + n], dt = expf(A->in.log_dt[lg]);
                const float mag = expf(lr * dt), ar = mag * cosf(li * dt), ai = mag * sinf(li * dt), den = lr * lr + li * li;
                const float cr = ((ar - 1.0f) * lr + ai * li) / den, ci = (ai * lr - (ar - 1.0f) * li) / den;
                float pr = 1.f, pi = 0.f;
                for (int t = 0; t <= 16; ++t) { apr[t * 64 + n] = pr; api[t * 64 + n] = pi; const float nr = pr * ar - pi * ai, ni = pr * ai + pi * ar; pr = nr; pi = ni; }
                for (int c = 0; c < 16; ++c) { const float br = A->in.b_re[((size_t)lg * 64 + n) * 16 + c], bi = A->in.b_im[((size_t)lg * 64 + n) * 16 + c];
                    bbr[n * 16 + c] = cr * br - ci * bi; bbi[n * 16 + c] = cr * bi + ci * br; }
                if (sub == 0) { S5A[(g * 64 + n) * 2] = apr[16 * 64 + n]; S5A[(g * 64 + n) * 2 + 1] = api[16 * 64 + n]; }
            }
            __syncthreads();
            const float* Cre = A->in.c_re + (size_t)lg * 16 * 64; const float* Cim = A->in.c_im + (size_t)lg * 16 * 64;
            for (int e = F.tid; e < 4096; e += NWAVES * 64) { const int t = e >> 8, i = (e >> 4) & 15, c = e & 15; float s = 0.f;
                for (int n = 0; n < 64; ++n) { const float Cr = Cre[i * 64 + n], Ci = Cim[i * 64 + n], pr = apr[t * 64 + n], pi = api[t * 64 + n];
                    const float er = Cr * pr - Ci * pi, ei = Cr * pi + Ci * pr; s += er * bbr[n * 16 + c] - ei * bbi[n * 16 + c]; }
                Kt[e] = s; }
            __syncthreads();
            for (int e = F.tid; e < 32 * 256; e += NWAVES * 64) { const int r = sub * 32 + (e >> 8), k = e & 255, j = r >> 4, i = r & 15, s = k >> 4, c = k & 15;
                float v = (j >= s) ? Kt[((j - s) * 16 + i) * 16 + c] : 0.f; if (j == s && i == c) v += A->in.s5_d[l * 512 + g * 16 + i];
                S5T[((size_t)g * 256 + r) * 256 + k] = (bf16)f2bf(v); }
            for (int e = F.tid; e < 16 * 256; e += NWAVES * 64) { const int row = sub * 16 + (e >> 8), k = e & 255, n = row & 63, im = row >> 6, s = k >> 4, c = k & 15;
                const float pr = apr[(15 - s) * 64 + n], pi = api[(15 - s) * 64 + n], br = bbr[n * 16 + c], bi = bbi[n * 16 + c];
                const float v = im ? (pr * bi + pi * br) : (pr * br - pi * bi);
                S5P[((size_t)g * 128 + row) * 256 + k] = (bf16)f2bf(v); }
            for (int e = F.tid; e < 32 * 128; e += NWAVES * 64) { const int r = sub * 32 + (e >> 7), k = e & 127, j = r >> 4, i = r & 15, n = k & 63, im = k >> 6;
                const float Cr = Cre[i * 64 + n], Ci = Cim[i * 64 + n], pr = apr[(j + 1) * 64 + n], pi = api[(j + 1) * 64 + n];
                const float v = im ? -(Cr * pi + Ci * pr) : (Cr * pr - Ci * pi);
                S5Q[((size_t)g * 256 + r) * 128 + k] = (bf16)f2bf(v); }
            __syncthreads();
        }
    }
}
DI void convert_B(Frame& F, KArgs A, unsigned char* ws, int l) {
    LAS float* scr = (LAS float*)(F.lds + RING_OFF + F.wave * 16384);
    const int gw = blockIdx.x * NWAVES + F.wave, NGW = F.G * NWAVES;
    bf16* FFNINT = (bf16*)(ws + WS_FFNINT); bf16* FFNOUTT = (bf16*)(ws + WS_FFNOUTT);
    constexpr int I_IN = (D / 64) * (2 * FF / 32), I_OUT = (FF / 64) * (D / 32);
    for (int it = gw; it < I_IN + I_OUT; it += NGW) {
        if (it < I_IN) transpose_item(A->in.ffn_w_in + (size_t)l * D * 2 * FF, D, 2 * FF, FFNINT, scr, it, F.lane, MapIl{FF});
        else transpose_item(A->in.ffn_w_out + (size_t)l * FF * D, FF, D, FFNOUTT, scr, it - I_IN, F.lane, MapId{});
    }
}
DI void rms_rows_to_bf16(Frame& F, const float* x, const float* g, bf16* hb) {
    const int gw = blockIdx.x * NWAVES + F.wave, NGW = F.G * NWAVES;
    f32x4 gv[4];
#pragma unroll
    for (int j = 0; j < 4; ++j) gv[j] = ((const GAS f32x4*)g)[F.lane + 64 * j];
    for (int m = gw; m < M; m += NGW) {
        const GAS f32x4* xr = (const GAS f32x4*)(x + (size_t)m * D) + F.lane; f32x4 v[4]; float s = 0.f;
#pragma unroll
        for (int j = 0; j < 4; ++j) { v[j] = xr[64 * j]; s += (v[j].x * v[j].x + v[j].y * v[j].y) + (v[j].z * v[j].z + v[j].w * v[j].w); }
        const float rstd = 1.0f / sqrtf(wave_sum(s) * (1.f / D) + NORM_EPS);
        GAS v2u* o8 = (GAS v2u*)(hb + (size_t)m * D) + F.lane;
#pragma unroll
        for (int j = 0; j < 4; ++j) { v2u o; o.x = pk2(v[j].x * rstd * gv[j].x, v[j].y * rstd * gv[j].y); o.y = pk2(v[j].z * rstd * gv[j].z, v[j].w * rstd * gv[j].w); o8[64 * j] = o; }
    }
}
DI void norm_phase(Frame& F, const float* xin, float* xout, const float* f, const float* gpost, const float* gpre, bf16* hb) {
    const int gw = blockIdx.x * NWAVES + F.wave, NGW = F.G * NWAVES;
    for (int m = gw; m < M; m += NGW) {
        const GAS f32x4* fr = (const GAS f32x4*)(f + (size_t)m * D) + F.lane; const GAS f32x4* xr = (const GAS f32x4*)(xin + (size_t)m * D) + F.lane;
        f32x4 v[4], xv[4]; float s = 0.f;
#pragma unroll
        for (int j = 0; j < 4; ++j) { v[j] = fr[64 * j]; xv[j] = xr[64 * j]; s += (v[j].x * v[j].x + v[j].y * v[j].y) + (v[j].z * v[j].z + v[j].w * v[j].w); }
        const float rstd = 1.0f / sqrtf(wave_sum(s) * (1.f / D) + NORM_EPS); float s2 = 0.f;
        GAS f32x4* xo = (GAS f32x4*)(xout + (size_t)m * D) + F.lane;
#pragma unroll
        for (int j = 0; j < 4; ++j) { const f32x4 gp = ((const GAS f32x4*)gpost)[F.lane + 64 * j]; xv[j] = xv[j] + v[j] * rstd * gp; xo[64 * j] = xv[j];
            s2 += (xv[j].x * xv[j].x + xv[j].y * xv[j].y) + (xv[j].z * xv[j].z + xv[j].w * xv[j].w); }
        if (gpre) { const float rstd2 = 1.0f / sqrtf(wave_sum(s2) * (1.f / D) + NORM_EPS);
            GAS v2u* o8 = (GAS v2u*)(hb + (size_t)m * D) + F.lane;
#pragma unroll
            for (int j = 0; j < 4; ++j) { const f32x4 gq = ((const GAS f32x4*)gpre)[F.lane + 64 * j]; v2u o; o.x = pk2(xv[j].x * rstd2 * gq.x, xv[j].y * rstd2 * gq.y); o.y = pk2(xv[j].z * rstd2 * gq.z, xv[j].w * rstd2 * gq.w); o8[64 * j] = o; } }
    }
}

DI void pool_stencil(Frame& F, const bf16* POOLU, bf16* DP) {
    const int gt = blockIdx.x * (NWAVES * 64) + F.tid, NGT = F.G * NWAVES * 64;
    for (int idx = gt; idx < M * 64; idx += NGT) {
        const int t = idx >> 6, cc = idx & 63, ch0 = cc * 8, gi = cc >> 4, w = 2 << gi, pos = t & (SEQ - 1);
        const int nw = (pos + 1) < w ? (pos + 1) : w;
        float a[8], u0[8];
#pragma unroll
        for (int j = 0; j < 8; ++j) { a[j] = 0.f; u0[j] = 0.f; }
        for (int i = 0; i < nw; ++i) { const v4u v = *(const GAS v4u*)(POOLU + (size_t)(t - i) * 512 + ch0);
            const float e[8] = {bflo(v.x), bfhi(v.x), bflo(v.y), bfhi(v.y), bflo(v.z), bfhi(v.z), bflo(v.w), bfhi(v.w)};
#pragma unroll
            for (int j = 0; j < 8; ++j) { a[j] += e[j]; if (i == 0) u0[j] = e[j]; } }
        const float inv = 1.0f / (float)nw; v4u o;
        o.x = pk2(a[0] * inv - u0[0], a[1] * inv - u0[1]); o.y = pk2(a[2] * inv - u0[2], a[3] * inv - u0[3]);
        o.z = pk2(a[4] * inv - u0[4], a[5] * inv - u0[5]); o.w = pk2(a[6] * inv - u0[6], a[7] * inv - u0[7]);
        *(GAS v4u*)(DP + (size_t)t * 512 + ch0) = o;
    }
}
DI float gelu_tanh(float y) { const float u = 0.7978845608028654f * (y + 0.044715f * y * y * y); const float th = 1.0f - 2.0f * __builtin_amdgcn_rcpf(__expf(2.0f * u) + 1.0f); return 0.5f * y * (1.0f + th); }
constexpr int S5_SLD = 129, S5_XLD = 136, S5_XOFF = 69632;
DI void s5_unit(Frame& F, int b, int g, const bf16* S5U_, const bf16* S5T_, const bf16* S5P_, const bf16* S5Q_, const float* S5A_, bf16* ZB_) {
    const bf16* S5U = opq(S5U_); const bf16* S5T = opq(S5T_); const bf16* S5P = opq(S5P_); const bf16* S5Q = opq(S5Q_); const float* S5A = opq(S5A_); bf16* ZB = opq(ZB_);
    LAS float* Ssm = (LAS float*)(F.lds + RING_OFF);
    LAS bf16* XB = (LAS bf16*)(F.lds + RING_OFF + S5_XOFF);
    const int w = F.wave, lane = opqv(F.lane), fr = lane & 15, qd = lane >> 4;
    const bf16* Tg = S5T + (size_t)g * 65536; const bf16* Pg = S5P + (size_t)g * 32768; const bf16* Qg = S5Q + (size_t)g * 32768;
    const bf16* Ub = S5U + (size_t)b * SEQ * 512 + g * 16;
    f32x4 accY[2][8], accS[8];
#pragma unroll
    for (int ct = 0; ct < 8; ++ct) { accS[ct] = (f32x4){0.f, 0.f, 0.f, 0.f}; accY[0][ct] = accS[ct]; accY[1][ct] = accS[ct]; }
#pragma unroll 1
    for (int ks = 0; ks < 8; ++ks) {
        bf16x8 bfr[8];
        const int s = 2 * ks + (qd >> 1), c0 = 8 * (qd & 1);
#pragma unroll
        for (int ct = 0; ct < 8; ++ct) bfr[ct] = ldg16o(Ub + (size_t)ct * 16 * 16 * 512, (unsigned)((fr * 16 + s) * 512 + c0) * 2u);
        const bf16x8 aP = ldg16o(Pg + (size_t)(16 * w) * 256 + 32 * ks, (unsigned)(fr * 256 + 8 * qd) * 2u);
#pragma unroll
        for (int ct = 0; ct < 8; ++ct) accS[ct] = MFMA16(aP, bfr[ct], accS[ct]);
        if (ks <= w) {
            const bf16x8 aT0 = ldg16o(Tg + (size_t)(32 * w) * 256 + 32 * ks, (unsigned)(fr * 256 + 8 * qd) * 2u), aT1 = ldg16o(Tg + (size_t)(32 * w + 16) * 256 + 32 * ks, (unsigned)(fr * 256 + 8 * qd) * 2u);
#pragma unroll
            for (int ct = 0; ct < 8; ++ct) { accY[0][ct] = MFMA16(aT0, bfr[ct], accY[0][ct]); accY[1][ct] = MFMA16(aT1, bfr[ct], accY[1][ct]); }
        }
    }
#pragma unroll
    for (int ct = 0; ct < 8; ++ct)
#pragma unroll
        for (int r = 0; r < 4; ++r) Ssm[(16 * w + 4 * qd + r) * S5_SLD + 16 * ct + fr] = accS[ct][r];
    __syncthreads();
    if (F.tid < 64) { const int n = F.tid; const float ar = S5A[(g * 64 + n) * 2], ai = S5A[(g * 64 + n) * 2 + 1]; float xr = 0.f, xi = 0.f;
        for (int c = 0; c < 128; ++c) { XB[c * S5_XLD + n] = (bf16)f2bf(xr); XB[c * S5_XLD + 64 + n] = (bf16)f2bf(xi);
            const float sr = Ssm[n * S5_SLD + c], si = Ssm[(64 + n) * S5_SLD + c];
            const float nr = ar * xr - ai * xi + sr, ni = ar * xi + ai * xr + si; xr = nr; xi = ni; } }
    __syncthreads();
#pragma unroll 1
    for (int ks = 0; ks < 4; ++ks) {
        const bf16x8 aQ0 = ldg16o(Qg + (size_t)(32 * w) * 128 + 32 * ks, (unsigned)(fr * 128 + 8 * qd) * 2u), aQ1 = ldg16o(Qg + (size_t)(32 * w + 16) * 128 + 32 * ks, (unsigned)(fr * 128 + 8 * qd) * 2u);
#pragma unroll
        for (int ct = 0; ct < 8; ++ct) { const bf16x8 bx = *(const LAS bf16x8*)(XB + (16 * ct + fr) * S5_XLD + 32 * ks + 8 * qd);
            accY[0][ct] = MFMA16(aQ0, bx, accY[0][ct]); accY[1][ct] = MFMA16(aQ1, bx, accY[1][ct]); }
    }
#pragma unroll
    for (int rt = 0; rt < 2; ++rt)
#pragma unroll
        for (int ct = 0; ct < 8; ++ct) { const int tok = (16 * ct + fr) * 16 + 2 * w + rt; const f32x4 y = accY[rt][ct];
            v2u o; o.x = pk2(gelu_tanh(y[0]), gelu_tanh(y[1])); o.y = pk2(gelu_tanh(y[2]), gelu_tanh(y[3]));
            *(GAS v2u*)(ZB + (size_t)(b * SEQ + tok) * 512 + g * 16 + 4 * qd) = o; }
    __syncthreads();
}
constexpr int AT_BIAS_OFF = 0, AT_SEL_OFF = 8192, AT_V_OFF = 24576, AT_VLD = 144  ;
DI s16x4 vtr(const LAS unsigned char* p) { return __builtin_bit_cast(s16x4, __builtin_amdgcn_ds_read_tr16_b64_v4i16((LAS v4i16_t*)p)); }
#define MEMBAR() asm volatile("" ::: "memory")
DI void attn_unit(Frame& F, int b, int tile, const bf16* QI_, const bf16* KVX_, bf16* QA_, const float* BIAS_) {
    const bf16* QI = opq(QI_); const bf16* KVX = opq(KVX_); bf16* QA = opq(QA_); const float* BIAS = opq(BIAS_);
    LAS float* biasL = (LAS float*)(F.lds + RING_OFF + AT_BIAS_OFF);
    const int w = F.wave;
    LAS unsigned short* selw = (LAS unsigned short*)(F.lds + RING_OFF + AT_SEL_OFF) + w * 512;
    for (int i = F.tid; i < 2048; i += NWAVES * 64) biasL[i] = BIAS[i];
    { LAS v4u* z = (LAS v4u*)selw; z[F.lane] = (v4u){0u, 0u, 0u, 0u}; }
    __syncthreads();
    const size_t rowb = (size_t)b * SEQ;
    const int tb = tile * 16 + 2 * w;
    const int nkp = ((tb + 1) / 16 + 2) / 2;
    unsigned key[64];
    {
        const int lane = opqv(F.lane), fr = lane & 15, qd = lane >> 4, tq = tb + (qd >> 1), odd = qd & 1;
        bf16x8 aQ[2];
#pragma unroll
        for (int ks = 0; ks < 2; ++ks) aQ[ks] = ldg16(QI + (rowb + tb + (fr >> 3)) * 512 + (fr & 7) * 64 + 32 * ks + 8 * qd);
        const v2u wraw = *(const GAS v2u*)(KVX + (rowb + tq) * 256 + 192 + 4 * odd);
        const float wv[4] = {bflo(wraw.x), bfhi(wraw.x), bflo(wraw.y), bfhi(wraw.y)};
        const unsigned koff = (unsigned)(fr * 256 + 8 * qd) * 2u;
#pragma unroll 1
        for (int ch = 0; ch * 16 < nkp; ++ch) {
            unsigned tmp[16];
            const bf16* kub = KVX + (rowb + 512 * ch) * 256 + 128;
#pragma unroll
            for (int j = 0; j < 16; ++j) {
                const bf16x8 e0 = ldg16o(kub + (2 * j) * 16 * 256, koff), e1 = ldg16o(kub + (2 * j) * 16 * 256 + 32, koff);
                const bf16x8 o0 = ldg16o(kub + (2 * j + 1) * 16 * 256, koff), o1 = ldg16o(kub + (2 * j + 1) * 16 * 256 + 32, koff);
                f32x4 cE = (f32x4){0.f, 0.f, 0.f, 0.f}, cO = cE;
                cE = MFMA16(aQ[0], e0, cE); cE = MFMA16(aQ[1], e1, cE); cO = MFMA16(aQ[0], o0, cO); cO = MFMA16(aQ[1], o1, cO);
                float sE = 0.f, sO = 0.f;
#pragma unroll
                for (int r = 0; r < 4; ++r) { sE += wv[r] * fmaxf(cE[r], 0.f); sO += wv[r] * fmaxf(cO[r], 0.f); }
                sE += __shfl_xor(sE, 16); sO += __shfl_xor(sO, 16);
                float s = odd ? sO : sE; s += 0.0f;
                const unsigned bits = __float_as_uint(s); const unsigned sk = bits ^ ((unsigned)((int)bits >> 31) | 0x80000000u);
                tmp[j] = (512 * ch + 32 * j + 16 * odd + fr <= tq) ? sk : 0u;
                if ((j & 1) == 1) MEMBAR();
            }
#define KEYCASE(c) case c: _Pragma("unroll") for (int j = 0; j < 16; ++j) key[16 * c + j] = tmp[j]; break;
            switch (ch) { KEYCASE(0) KEYCASE(1) KEYCASE(2) default: _Pragma("unroll") for (int j = 0; j < 16; ++j) key[48 + j] = tmp[j]; break; }
#undef KEYCASE
        }
    }
    unsigned theta = 0u;
#pragma unroll 1
    for (int bit = 31; bit >= 0; --bit) {
        const unsigned cand = theta | (1u << bit); int cnt = 0;
#pragma unroll
        for (int ch = 0; ch < 4; ++ch) if (ch * 16 < nkp) {
#pragma unroll
            for (int j = 0; j < 16; ++j) cnt += (key[ch * 16 + j] >= cand) ? 1 : 0; }
        cnt += __shfl_xor(cnt, 1); cnt += __shfl_xor(cnt, 2); cnt += __shfl_xor(cnt, 4); cnt += __shfl_xor(cnt, 8); cnt += __shfl_xor(cnt, 16);
        if (cnt >= 256) theta = cand;
    }
    int nsel;
    {
        const int lane = opqv(F.lane), fr = lane & 15, qd = lane >> 4, odd = qd & 1;
        int cgt = 0;
#pragma unroll
        for (int ch = 0; ch < 4; ++ch) if (ch * 16 < nkp) {
#pragma unroll
            for (int j = 0; j < 16; ++j) cgt += (key[ch * 16 + j] > theta) ? 1 : 0; }
        cgt += __shfl_xor(cgt, 1); cgt += __shfl_xor(cgt, 2); cgt += __shfl_xor(cgt, 4); cgt += __shfl_xor(cgt, 8); cgt += __shfl_xor(cgt, 16);
        const int quota = (theta == 0u) ? 0 : (256 - cgt);
        int base = 0, eqseen = 0; const unsigned below = (1u << (lane & 31)) - 1u; const int sh = 32 * (qd >> 1);
        LAS unsigned short* sl = selw + (qd >> 1) * 256;
#pragma unroll 1
        for (int ch = 0; ch * 16 < nkp; ++ch) {
            unsigned tmp[16];
#define KEYCASE(c) case c: _Pragma("unroll") for (int j = 0; j < 16; ++j) tmp[j] = key[16 * c + j]; break;
            switch (ch) { KEYCASE(0) KEYCASE(1) KEYCASE(2) default: _Pragma("unroll") for (int j = 0; j < 16; ++j) tmp[j] = key[48 + j]; break; }
#undef KEYCASE
#pragma unroll
            for (int j = 0; j < 16; ++j) {
                const bool gtk = tmp[j] > theta, eqk = (tmp[j] == theta) && (theta != 0u);
                const unsigned long long be = __ballot(eqk); const unsigned e32 = (unsigned)(be >> sh); const int pe = __popc(e32 & below);
                const bool take = gtk || (eqk && (eqseen + pe) < quota);
                const unsigned long long bt = __ballot(take); const unsigned t32 = (unsigned)(bt >> sh); const int pt = __popc(t32 & below);
                if (take) sl[base + pt] = (unsigned short)(512 * ch + 32 * j + 16 * odd + fr);
                base += __popc(t32); eqseen += __popc(e32);
            }
        }
        nsel = base;
    }
#pragma unroll 1
    for (int qq = 0; qq < 2; ++qq) {
        const int lane = opqv(F.lane), fr = lane & 15, qd = lane >> 4;
        LAS unsigned char* Vs = F.lds + RING_OFF + AT_V_OFF + w * (64 * AT_VLD);
        const int t = tb + qq; const int ns = __shfl(nsel, 32 * qq);
        const LAS unsigned short* sl = selw + qq * 256;
        bf16* qrow = QA + (rowb + t) * 1024;
        bf16x8 bq[2];
#pragma unroll
        for (int ks = 0; ks < 2; ++ks) bq[ks] = ldg16(qrow + fr * 64 + 32 * ks + 8 * qd);
        f32x4 st[16];
#pragma unroll
        for (int blk = 0; blk < 16; ++blk) { const int kidx = sl[16 * blk + fr];
            const unsigned ko = (unsigned)(kidx * 256 + 8 * qd) * 2u; const bf16x8 a0 = ldg16o(KVX + rowb * 256, ko), a1 = ldg16o(KVX + rowb * 256 + 32, ko);
            f32x4 c = (f32x4){0.f, 0.f, 0.f, 0.f}; c = MFMA16(a0, bq[0], c); c = MFMA16(a1, bq[1], c); st[blk] = c;
            if ((blk & 3) == 3) MEMBAR(); }
        float mx = -3.0e38f;
#pragma unroll
        for (int blk = 0; blk < 16; ++blk) { const u16x4 k4 = *(const LAS u16x4*)(sl + 16 * blk + 4 * qd);
#pragma unroll
            for (int r = 0; r < 4; ++r) { int dist = t - (int)k4[r]; dist = dist < 0 ? 0 : (dist > 127 ? 127 : dist);
                float lg = st[blk][r] + biasL[dist * 16 + fr]; if (16 * blk + 4 * qd + r >= ns) lg = -1.0e30f; st[blk][r] = lg; mx = fmaxf(mx, lg); } }
        mx = fmaxf(mx, __shfl_xor(mx, 16)); mx = fmaxf(mx, __shfl_xor(mx, 32));
        float sum = 0.f;
#pragma unroll
        for (int blk = 0; blk < 16; ++blk)
#pragma unroll
            for (int r = 0; r < 4; ++r) { const float p = __expf(st[blk][r] - mx); st[blk][r] = p; sum += p; }
        sum += __shfl_xor(sum, 16); sum += __shfl_xor(sum, 32);
        const float inv = 1.0f / sum;
        f32x4 o[4];
#pragma unroll
        for (int nb = 0; nb < 4; ++nb) o[nb] = (f32x4){0.f, 0.f, 0.f, 0.f};
#pragma unroll
        for (int vr = 0; vr < 4; ++vr) {
            v4u vv[8];
#pragma unroll
            for (int i = 0; i < 8; ++i) { const int piece = lane + 64 * i, row = piece >> 3, pc = piece & 7; const int kidx = sl[64 * vr + row];
                vv[i] = ldg16u(KVX + rowb * 256 + 64, (unsigned)(kidx * 256 + 8 * pc) * 2u); }
#pragma unroll
            for (int i = 0; i < 8; ++i) { const int piece = lane + 64 * i, row = piece >> 3, pc = piece & 7; *(LAS v4u*)(Vs + row * AT_VLD + pc * 16) = vv[i]; }
            MEMBAR();
#pragma unroll
            for (int kk = 0; kk < 2; ++kk) {
                const f32x4 p0 = st[4 * vr + 2 * kk] * inv, p1 = st[4 * vr + 2 * kk + 1] * inv;
                const v4u pw = (v4u){pk2(p0[0], p0[1]), pk2(p0[2], p0[3]), pk2(p1[0], p1[1]), pk2(p1[2], p1[3])};
                const bf16x8 pa = __builtin_bit_cast(bf16x8, pw);
                const int q4 = fr >> 2, p4 = fr & 3;
#pragma unroll
                for (int nb = 0; nb < 4; ++nb) {
                    const s16x4 lo = vtr(Vs + (32 * kk + 4 * qd + q4) * AT_VLD + (16 * nb + 4 * p4) * 2);
                    const s16x4 hi = vtr(Vs + (32 * kk + 16 + 4 * qd + q4) * AT_VLD + (16 * nb + 4 * p4) * 2);
                    const bf16x8 bv = (bf16x8){lo[0], lo[1], lo[2], lo[3], hi[0], hi[1], hi[2], hi[3]};
                    o[nb] = MFMA16(pa, bv, o[nb]);
                }
            }
            MEMBAR();
        }
#pragma unroll
        for (int nb = 0; nb < 4; ++nb)
#pragma unroll
            for (int r = 0; r < 4; ++r) qrow[(4 * qd + r) * 64 + 16 * nb + fr] = (bf16)f2bf(o[nb][r]);
    }
    __syncthreads();
}

#ifndef PH_MASK
#define PH_MASK 0x1ff
#endif
#define PH_ON(k) (((PH_MASK) >> (k)) & 1)
#ifndef MK_SP2
#define MK_SP2 true
#endif
#ifndef MK_ALIGN
#define MK_ALIGN true
#endif
__global__ void __launch_bounds__(NWAVES * 64, 2) hybrid_fwd(Args args) {
    extern __shared__ __attribute__((aligned(16))) unsigned char lds[];
#define MKFRAME() Frame F; F.lds = (LAS unsigned char*)lds; F.tid = opqv((int)threadIdx.x); F.lane = F.tid & 63; F.wave = __builtin_amdgcn_readfirstlane(F.tid >> 6); F.G = gridDim.x
    const int lo = args.ph_lo, hi = args.ph_hi;
    {   KArgs A = kargs(); gu32* ctl = (gu32*)(A->ws + WS_CTL); MKFRAME();
        for (int u = F.tid; u < (LDS_BYTES - LDSCTL_OFF) / 4; u += NWAVES * 64) ((LAS unsigned*)(F.lds + LDSCTL_OFF))[u] = 0u;
        __syncthreads();
        volatile LAS unsigned* MISC = (volatile LAS unsigned*)(F.lds + MISC_OFF);
        (void)xcd_barrier_post((unsigned*)(ctl + CW_BAR), MISC + 8); }
#define IN(k) (lo <= (k) && (k) < hi)
#define BOTH(k) (IN(k) && IN((k) + 1))
#define GRID_BAR() do { KArgs Ab = kargs(); XcdBarrier bar; bar.bar = (unsigned*)((gu32*)(Ab->ws + WS_CTL) + CW_BAR); bar.x = xb_xcc_id(); bar.st = (volatile LAS unsigned*)((LAS unsigned char*)lds + MISC_OFF) + 8; xcd_barrier(bar); } while (0)
#define WSP(T, off) ((T*)(ws + (off)))

    if (PH_ON(0) && IN(0)) { KArgs A = kargs(); unsigned char* ws = A->ws; MKFRAME();
        convert_A(F, A, ws, 0); rms_rows_to_bf16(F, A->in.x, A->in.n_mix_pre, WSP(bf16, WS_HB)); if (BOTH(0)) GRID_BAR(); }

#pragma unroll 1
    for (int l = 0; l < NLAYER; ++l) {
        const int pb = 1 + 8 * l;
        if (PH_ON(1) && IN(pb)) { KArgs A = kargs(); unsigned char* ws = A->ws; MKFRAME();
            pg8::Gemm g{WSP(bf16, WS_HB), WSP(bf16, WS_WINT), M, N1P, D}; pg8::StaticOrder S; S.init(M, N1P, F.G, (int)blockIdx.x);
            pg8::EpiRoute E{WSP(bf16, WS_POOLU), WSP(bf16, WS_S5U), WSP(bf16, WS_Q), WSP(bf16, WS_QI), WSP(bf16, WS_KVX), WSP(bf16, WS_GATES)};
            pg8::gemm_phase<pg8::EpiRoute, pg8::StaticOrder, MK_ALIGN, MK_SP2>(F.lds + RING_OFF, g, S, E);
            if (BOTH(pb)) GRID_BAR();
        }
        if (PH_ON(2) && IN(pb + 1)) { KArgs A = kargs(); unsigned char* ws = A->ws; MKFRAME();
#ifndef NO_POOL
            pool_stencil(F, WSP(bf16, WS_POOLU), WSP(bf16, WS_DP));
#endif
#ifndef NO_S5
#pragma unroll 1
            for (int u = blockIdx.x; u < 256; u += F.G) s5_unit(F, u >> 5, u & 31, WSP(bf16, WS_S5U), WSP(bf16, WS_S5T), WSP(bf16, WS_S5P), WSP(bf16, WS_S5Q), WSP(float, WS_S5A), WSP(bf16, WS_ZB));
#endif
#ifndef NO_ATTN
#pragma unroll 1
            for (int u4 = 4 * blockIdx.x; u4 < 1024; u4 += 4 * F.G) {
#pragma unroll 1
                for (int h = 0; h < 4; ++h) { const int u = u4 >> 2, b = u >> 5, j = u & 31; const int tile = (h & 2 ? 64 : 0) + ((h & 1) ? 63 - j : j);
                    attn_unit(F, b, tile, WSP(bf16, WS_QI), WSP(bf16, WS_KVX), WSP(bf16, WS_Q), WSP(float, WS_BIAS)); } }
#endif
            if (BOTH(pb + 1)) GRID_BAR();
        }
        if (PH_ON(3) && IN(pb + 2)) {
            { KArgs A = kargs(); unsigned char* ws = A->ws; MKFRAME();
              pg8::Gemm g{WSP(bf16, WS_ZB), WSP(bf16, WS_GLUT), M, 2048, 512}; pg8::PairOrder S; S.base.init(M, D, F.G, (int)blockIdx.x);
              pg8::EpiGlu E{WSP(bf16, WS_MERGED), WSP(bf16, WS_GATES)};
              pg8::gemm_phase<pg8::EpiGlu, pg8::PairOrder, MK_ALIGN, MK_SP2>(F.lds + RING_OFF, g, S, E); }
            VM_WAIT(); __builtin_amdgcn_fence(__ATOMIC_ACQUIRE, "agent"); VM_WAIT(); __syncthreads();
            { KArgs A = kargs(); unsigned char* ws = A->ws; MKFRAME();
              pg8::Gemm g{WSP(bf16, WS_DP), WSP(bf16, WS_POOLET), M, D, 512}; pg8::StaticOrder S; S.init(M, D, F.G, (int)blockIdx.x);
              pg8::EpiAccum<0> E{WSP(bf16, WS_MERGED), WSP(bf16, WS_GATES)};
              pg8::gemm_phase<pg8::EpiAccum<0>, pg8::StaticOrder, MK_ALIGN, MK_SP2>(F.lds + RING_OFF, g, S, E); }
            VM_WAIT(); __builtin_amdgcn_fence(__ATOMIC_ACQUIRE, "agent"); VM_WAIT(); __syncthreads();
            { KArgs A = kargs(); unsigned char* ws = A->ws; MKFRAME();
              pg8::Gemm g{WSP(bf16, WS_Q), WSP(bf16, WS_ATTNOT), M, D, D}; pg8::StaticOrder S; S.init(M, D, F.G, (int)blockIdx.x);
              pg8::EpiAccum<1024> E{WSP(bf16, WS_MERGED), WSP(bf16, WS_GATES)};
              pg8::gemm_phase<pg8::EpiAccum<1024>, pg8::StaticOrder, MK_ALIGN, MK_SP2>(F.lds + RING_OFF, g, S, E); }
            if (BOTH(pb + 2)) GRID_BAR();
        }
        if (PH_ON(4) && IN(pb + 3)) { KArgs A = kargs(); unsigned char* ws = A->ws; MKFRAME();
            pg8::Gemm g{WSP(bf16, WS_MERGED), WSP(bf16, WS_WOUTT), M, D, D}; pg8::StaticOrder S; S.init(M, D, F.G, (int)blockIdx.x);
            pg8::EpiF32 E{WSP(float, WS_F), D};
            pg8::gemm_phase<pg8::EpiF32, pg8::StaticOrder, MK_ALIGN, MK_SP2>(F.lds + RING_OFF, g, S, E);
            if (BOTH(pb + 3)) GRID_BAR();
        }
        if (PH_ON(5) && IN(pb + 4)) { KArgs A = kargs(); unsigned char* ws = A->ws; MKFRAME();
            convert_B(F, A, ws, l);
            norm_phase(F, l == 0 ? A->in.x : (const float*)A->out, A->out, WSP(float, WS_F), A->in.n_mix_post + l * D, A->in.n_ffn_pre + l * D, WSP(bf16, WS_HB));
            if (BOTH(pb + 4)) GRID_BAR();
        }
        if (PH_ON(6) && IN(pb + 5)) { KArgs A = kargs(); unsigned char* ws = A->ws; MKFRAME();
            pg8::Gemm g{WSP(bf16, WS_HB), WSP(bf16, WS_FFNINT), M, 2 * FF, D}; pg8::StaticOrder S; S.init(M, 2 * FF, F.G, (int)blockIdx.x);
            pg8::EpiSwiglu E{WSP(bf16, WS_HID), FF};
            pg8::gemm_phase<pg8::EpiSwiglu, pg8::StaticOrder, MK_ALIGN, MK_SP2>(F.lds + RING_OFF, g, S, E);
            if (BOTH(pb + 5)) GRID_BAR();
        }
        if (PH_ON(7) && IN(pb + 6)) { KArgs A = kargs(); unsigned char* ws = A->ws; MKFRAME();
            pg8::Gemm g{WSP(bf16, WS_HID), WSP(bf16, WS_FFNOUTT), M, D, FF}; pg8::StaticOrder S; S.init(M, D, F.G, (int)blockIdx.x);
            pg8::EpiF32 E{WSP(float, WS_F), D};
            pg8::gemm_phase<pg8::EpiF32, pg8::StaticOrder, MK_ALIGN, MK_SP2>(F.lds + RING_OFF, g, S, E);
            if (BOTH(pb + 6)) GRID_BAR();
        }
        if (PH_ON(8) && IN(pb + 7)) { KArgs A = kargs(); unsigned char* ws = A->ws; MKFRAME();
            if (l + 1 < NLAYER) convert_A(F, A, ws, l + 1);
            norm_phase(F, (const float*)A->out, A->out, WSP(float, WS_F), A->in.n_ffn_post + l * D, (l + 1 < NLAYER) ? A->in.n_mix_pre + (l + 1) * D : (const float*)nullptr, WSP(bf16, WS_HB));
            if (BOTH(pb + 7)) GRID_BAR();
        }
    }
#undef WSP
#undef IN
#undef BOTH
#undef GRID_BAR
}

#ifndef MK_ONE_LAUNCH
#define MK_ONE_LAUNCH 1
#endif
extern "C" void kernel_launch(void* const* d_in, const int* in_sizes, int n_in, void* d_out, int out_size, void* d_ws, size_t ws_size, hipStream_t stream) {
    static int grid = 0;
    if (grid == 0) {
        if (n_in != 23 || in_sizes[0] != M * D || out_size != M * D || ws_size < WS_END) { fprintf(stderr, "kernel_launch: unexpected shapes (n_in %d, in0 %d, out %d, ws %zu); nothing launched\n", n_in, n_in > 0 ? in_sizes[0] : -1, out_size, ws_size); grid = -1; return; }
        int dev = 0, cus = 0, per_cu = 0;
        if (hipGetDevice(&dev) != hipSuccess || hipDeviceGetAttribute(&cus, hipDeviceAttributeMultiprocessorCount, dev) != hipSuccess) { grid = -1; return; }
        if (hipFuncSetAttribute((const void*)hybrid_fwd, hipFuncAttributeMaxDynamicSharedMemorySize, LDS_BYTES) != hipSuccess) { fprintf(stderr, "kernel_launch: hipFuncSetAttribute failed\n"); grid = -1; return; }
        if (hipOccupancyMaxActiveBlocksPerMultiprocessor(&per_cu, (const void*)hybrid_fwd, NWAVES * 64, LDS_BYTES) != hipSuccess || per_cu < 1) { fprintf(stderr, "kernel_launch: occupancy query says %d\n", per_cu); per_cu = 1; }
        (void)hipGetLastError();
        grid = cus;
    }
    if (grid < 0) return;
    if (hipMemsetAsync((char*)d_ws + WS_CTL, 0, CTL_ZERO_BYTES, stream) != hipSuccess) return;
    Args a{};
    const float** ip = (const float**)&a.in;
    for (int i = 0; i < 23; ++i) ip[i] = (const float*)d_in[i];
    a.out = (float*)d_out; a.ws = (unsigned char*)d_ws;
#if MK_ONE_LAUNCH
    a.ph_lo = 0; a.ph_hi = NPHASE;
    hipLaunchKernelGGL(hybrid_fwd, dim3(grid), dim3(NWAVES * 64), LDS_BYTES, stream, a);
#else
    for (int ph = 0; ph < NPHASE; ++ph) { a.ph_lo = ph; a.ph_hi = ph + 1;
        hipLaunchKernelGGL(hybrid_fwd, dim3(grid), dim3(NWAVES * 64), LDS_BYTES, stream, a); }
#endif
}
```

```cpp
#include <hip/hip_runtime.h>
#include <cstdio>
#include <cstdint>
namespace pg8 {
#define PG8_LAS __attribute__((address_space(3)))
typedef unsigned short bf16_t;
typedef short bf16x8 __attribute__((ext_vector_type(8)));
typedef float f32x4 __attribute__((ext_vector_type(4)));
typedef unsigned u32x4 __attribute__((ext_vector_type(4)));
constexpr int BM = 256, BK = 64, HALF = 128, HTB = HALF * BK * 2  , STAGE_BYTES = 8 * HTB, NXCD = 8, WGM = 8;

__host__ __device__ __forceinline__ int lds_byte(int r, int c) { const int st = (r >> 4) * 2 + (c >> 5), rr = r & 15, cc = c & 31, ob = rr * 64 + cc * 2; return st * 1024 + (ob ^ (((ob >> 9) & 1) << 5)); }
__host__ __device__ __forceinline__ void stage_rc(int b, int& R, int& C) { const int st = b / 1024, sb = b % 1024, swz = sb ^ (((sb >> 9) & 1) << 5); R = (st >> 1) * 16 + swz / 64; C = (st & 1) * 32 + (swz % 64) / 2; }
__host__ __device__ __forceinline__ int perm32(int rho) { const int n = rho >> 4, i = rho & 15; return 8 * (i >> 2) + 4 * n + (i & 3); }

struct Unit { int pm, pn; };
struct Gemm { const bf16_t* A; const bf16_t* Bt; int M, N, K; };

struct StaticOrder {
    int nM, nN, nwg, G, c;
    __host__ __device__ void init(int M, int N, int G_, int c_) { nM = M / BM; nN = N / BM; nwg = nM * nN; G = G_; c = c_; }
    __host__ __device__ bool next(int i, Unit& u) const {
        const long L = (long)i * G + c; if (L >= nwg) return false;
        int wgid = (int)L; { const int q = nwg / NXCD, r = nwg % NXCD, xcd = wgid % NXCD, off = wgid / NXCD; wgid = (xcd < r ? xcd * (q + 1) : r * (q + 1) + (xcd - r) * q) + off; }
        const int nig = WGM * nN, gid = wgid / nig, fm = gid * WGM, gsz = (nM - fm) < WGM ? (nM - fm) : WGM;
        u.pm = fm + ((wgid % nig) % gsz); u.pn = (wgid % nig) / gsz; return true;
    }
    __device__ __forceinline__ void a_ready(const Unit&) const {}
    __device__ __forceinline__ void done(const Unit&) const {}
};

__device__ __forceinline__ unsigned cvt_pk_bf16(float lo, float hi) { unsigned r; asm volatile("v_cvt_pk_bf16_f32 %0, %1, %2" : "=v"(r) : "v"(lo), "v"(hi)); return r; }
typedef float f32x2 __attribute__((ext_vector_type(2)));
__device__ __forceinline__ float sigm(float x) { return __builtin_amdgcn_rcpf(1.0f + __expf(-x)); }
__device__ __forceinline__ float bf_lo(unsigned w) { return __uint_as_float(w << 16); }
__device__ __forceinline__ float bf_hi(unsigned w) { return __uint_as_float(w & 0xffff0000u); }
__device__ __forceinline__ u32x4 pack8(const f32x4& v0, const f32x4& v1) { u32x4 w; w.x = cvt_pk_bf16(v0[0], v0[1]); w.y = cvt_pk_bf16(v0[2], v0[3]); w.z = cvt_pk_bf16(v1[0], v1[1]); w.w = cvt_pk_bf16(v1[2], v1[3]); return w; }

struct EpiF32 {
    static constexpr bool PERM = false, AFTER_DRAIN = false;
    float* C; int ldc;
    __device__ __forceinline__ void operator()(const f32x4 (&acc)[2][2][4][2], const Unit& u, int wr, int wc, int fr, int fq) const {
        const int row0 = u.pm * BM + wr * 64 + fr, col0 = u.pn * BM + wc * 32 + 4 * fq;
#pragma unroll
        for (int ai = 0; ai < 2; ++ai)
#pragma unroll
            for (int m = 0; m < 4; ++m) { float* rowp = C + (size_t)(row0 + ai * HALF + m * 16) * ldc + col0;
#pragma unroll
                for (int bj = 0; bj < 2; ++bj)
#pragma unroll
                    for (int n = 0; n < 2; ++n) *(f32x4*)(rowp + bj * HALF + n * 16) = acc[ai][bj][m][n]; }
    }
};
struct EpiRoute {
    static constexpr bool PERM = true, AFTER_DRAIN = false;
    bf16_t *poolu, *s5u, *q, *qi, *kvx, *gates;
    __device__ __forceinline__ void operator()(const f32x4 (&acc)[2][2][4][2], const Unit& u, int wr, int wc, int fr, int fq) const {
        const int row0 = u.pm * BM + wr * 64 + fr; const int pn = u.pn;
        bf16_t* base; int ld, colt, mode = 0;
        if (pn < 2) { base = poolu; ld = 512; colt = pn * 256; }
        else if (pn < 4) { base = s5u; ld = 512; colt = (pn - 2) * 256; }
        else if (pn < 8) { base = q; ld = 1024; colt = (pn - 4) * 256; mode = 2; }
        else if (pn < 10) { base = qi; ld = 512; colt = (pn - 8) * 256; }
        else if (pn == 10) { base = kvx; ld = 256; colt = 0; }
        else { base = gates; ld = 3072; colt = (pn - 11) * 256; mode = 1; }
        const int col0 = colt + wc * 32 + 8 * fq;
#pragma unroll
        for (int ai = 0; ai < 2; ++ai)
#pragma unroll
            for (int m = 0; m < 4; ++m) { bf16_t* rowp = base + (size_t)(row0 + ai * HALF + m * 16) * ld + col0;
#pragma unroll
                for (int bj = 0; bj < 2; ++bj) { f32x4 v0 = acc[ai][bj][m][0], v1 = acc[ai][bj][m][1];
                    if (mode == 1) {
#pragma unroll
                        for (int j = 0; j < 4; ++j) { v0[j] = sigm(v0[j]); v1[j] = sigm(v1[j]); } }
                    else if (mode == 2) { v0 = v0 * 0.125f; v1 = v1 * 0.125f; }
                    *(u32x4*)(rowp + bj * HALF) = pack8(v0, v1); } }
    }
};
struct EpiGlu {
    static constexpr bool PERM = true, AFTER_DRAIN = false;
    bf16_t* merged; const bf16_t* gates;
    __device__ __forceinline__ void operator()(const f32x4 (&acc)[2][2][4][2], const Unit& u, int wr, int wc, int fr, int fq) const {
        const int row0 = u.pm * BM + wr * 64 + fr, col0 = u.pn * HALF + wc * 32 + 8 * fq;
#pragma unroll
        for (int ai = 0; ai < 2; ++ai)
#pragma unroll
            for (int m = 0; m < 4; ++m) { const size_t row = (size_t)(row0 + ai * HALF + m * 16);
                const u32x4 g = *(const u32x4*)(gates + row * 3072 + 2048 + col0);
                f32x4 a0 = acc[ai][0][m][0], a1 = acc[ai][0][m][1]; const f32x4 s0 = acc[ai][1][m][0], s1 = acc[ai][1][m][1];
#pragma unroll
                for (int j = 0; j < 4; ++j) { a0[j] *= sigm(s0[j]); a1[j] *= sigm(s1[j]); }
                a0[0] *= bf_lo(g.x); a0[1] *= bf_hi(g.x); a0[2] *= bf_lo(g.y); a0[3] *= bf_hi(g.y);
                a1[0] *= bf_lo(g.z); a1[1] *= bf_hi(g.z); a1[2] *= bf_lo(g.w); a1[3] *= bf_hi(g.w);
                *(u32x4*)(merged + row * 1024 + col0) = pack8(a0, a1);
                asm volatile("" ::: "memory"); }
    }
};
template <int GOFF> struct EpiAccum {
    static constexpr bool PERM = true, AFTER_DRAIN = false;
    bf16_t* merged; const bf16_t* gates;
    __device__ __forceinline__ void operator()(const f32x4 (&acc)[2][2][4][2], const Unit& u, int wr, int wc, int fr, int fq) const {
        const int row0 = u.pm * BM + wr * 64 + fr, col0 = u.pn * BM + wc * 32 + 8 * fq;
#pragma unroll
        for (int ai = 0; ai < 2; ++ai)
#pragma unroll
            for (int m = 0; m < 4; ++m) { const size_t row = (size_t)(row0 + ai * HALF + m * 16);
#pragma unroll
                for (int bj = 0; bj < 2; ++bj) { const int c = col0 + bj * HALF;
                    const u32x4 g = *(const u32x4*)(gates + row * 3072 + GOFF + c); const u32x4 o = *(const u32x4*)(merged + row * 1024 + c);
                    f32x4 a0 = acc[ai][bj][m][0], a1 = acc[ai][bj][m][1];
                    a0[0] = a0[0] * bf_lo(g.x) + bf_lo(o.x); a0[1] = a0[1] * bf_hi(g.x) + bf_hi(o.x); a0[2] = a0[2] * bf_lo(g.y) + bf_lo(o.y); a0[3] = a0[3] * bf_hi(g.y) + bf_hi(o.y);
                    a1[0] = a1[0] * bf_lo(g.z) + bf_lo(o.z); a1[1] = a1[1] * bf_hi(g.z) + bf_hi(o.z); a1[2] = a1[2] * bf_lo(g.w) + bf_lo(o.w); a1[3] = a1[3] * bf_hi(g.w) + bf_hi(o.w);
                    *(u32x4*)(merged + row * 1024 + c) = pack8(a0, a1); }
                asm volatile("" ::: "memory"); }
    }
};
struct EpiSwiglu {
    static constexpr bool PERM = true, AFTER_DRAIN = false;
    bf16_t* hid; int ldh;
    __device__ __forceinline__ void operator()(const f32x4 (&acc)[2][2][4][2], const Unit& u, int wr, int wc, int fr, int fq) const {
        const int row0 = u.pm * BM + wr * 64 + fr, col0 = u.pn * HALF + wc * 32 + 8 * fq;
#pragma unroll
        for (int ai = 0; ai < 2; ++ai)
#pragma unroll
            for (int m = 0; m < 4; ++m) { const size_t row = (size_t)(row0 + ai * HALF + m * 16);
                f32x4 g0 = acc[ai][0][m][0], g1 = acc[ai][0][m][1]; const f32x4 u0 = acc[ai][1][m][0], u1 = acc[ai][1][m][1];
#pragma unroll
                for (int j = 0; j < 4; ++j) { g0[j] = g0[j] * sigm(g0[j]) * u0[j]; g1[j] = g1[j] * sigm(g1[j]) * u1[j]; }
                *(u32x4*)(hid + row * ldh + col0) = pack8(g0, g1); }
    }
};
struct PairOrder {
    StaticOrder base;
    __device__ bool next(int i, Unit& u) const { Unit b; if (!base.next(i >> 1, b)) return false; u.pm = b.pm; u.pn = 2 * b.pn + (i & 1); return true; }
    __device__ __forceinline__ void a_ready(const Unit&) const {}
    __device__ __forceinline__ void done(const Unit&) const {}
};

template <class Epi, class Sched, bool ALIGN_EPI = false, bool SP2 = false>
__device__ __forceinline__ void gemm_phase(PG8_LAS unsigned char* lds, const Gemm g, const Sched& S, const Epi& E) {
    int tid_ = threadIdx.x; asm volatile("" : "+v"(tid_));
    const int tid = tid_, wid = __builtin_amdgcn_readfirstlane(tid >> 6), lane = tid & 63, wr = wid >> 2, wc = wid & 3, fr = lane & 15, fq = lane >> 4;
    const int K = g.K, nt = K / BK;
    unsigned voffA[2], voffB[2];
#pragma unroll
    for (int i = 0; i < 2; ++i) { int R, C; stage_rc(tid * 16 + i * 8192, R, C); const int Rb = Epi::PERM ? ((R & ~31) + perm32(R & 31)) : R;
        voffA[i] = (unsigned)(R * K + C) * 2u; voffB[i] = (unsigned)(Rb * K + C) * 2u; }
    const size_t kstep = (size_t)(BK * 2);
    const size_t hstep = (size_t)HALF * K * 2;
    const size_t tstep = 2 * hstep;
    const unsigned ldsw = (unsigned)wid * 1024u;
    const int aoff = lds_byte(wr * 64 + fr, fq * 8), boff = lds_byte(wc * 32 + fr, fq * 8);
#define PG8_SA(b, h) (((b) * 2 + (h)) * HTB)
#define PG8_SB(b, h) ((4 + (b) * 2 + (h)) * HTB)
#define PG8_STAGE(bufoff, gbase, voff) do { _Pragma("unroll") for (int _i = 0; _i < 2; ++_i) \
        __builtin_amdgcn_global_load_lds((const unsigned*)((const char*)(gbase) + (voff)[_i]), (PG8_LAS unsigned*)(lds + (bufoff) + ldsw + _i * 8192), 16, 0, 0); } while (0)
#define PG8_LDA(dst, b, h) do { _Pragma("unroll") for (int m = 0; m < 4; ++m) _Pragma("unroll") for (int k = 0; k < 2; ++k) dst[m][k] = *(const PG8_LAS bf16x8*)(lds + PG8_SA(b, h) + aoff + m * 2048 + k * 1024); } while (0)
#define PG8_LDB(dst, b, h) do { _Pragma("unroll") for (int n = 0; n < 2; ++n) _Pragma("unroll") for (int k = 0; k < 2; ++k) dst[n][k] = *(const PG8_LAS bf16x8*)(lds + PG8_SB(b, h) + boff + n * 2048 + k * 1024); } while (0)
#define PG8_MMA(ai, bj, At, Bt) do { __builtin_amdgcn_s_setprio(1); _Pragma("unroll") for (int m = 0; m < 4; ++m) _Pragma("unroll") for (int n = 0; n < 2; ++n) _Pragma("unroll") for (int k = 0; k < 2; ++k) \
        acc[ai][bj][m][n] = __builtin_amdgcn_mfma_f32_16x16x32_bf16(Bt[n][k], At[m][k], acc[ai][bj][m][n], 0, 0, 0); __builtin_amdgcn_s_setprio(0); } while (0)
#define PG8_WAIT_V(n) asm volatile("s_waitcnt vmcnt(" #n ")" ::: "memory")
#define PG8_WAIT_L(n) asm volatile("s_waitcnt lgkmcnt(" #n ")" ::: "memory")
#define PG8_BAR __builtin_amdgcn_s_barrier()
#define PG8_SCHED __builtin_amdgcn_sched_barrier(0)
    Unit cur, nxt; int ui = 0;
    if (!S.next(0, cur)) return;
    f32x4 acc[2][2][4][2];
#pragma unroll
    for (int a = 0; a < 2; ++a)
#pragma unroll
        for (int b = 0; b < 2; ++b)
#pragma unroll
            for (int m = 0; m < 4; ++m)
#pragma unroll
                for (int n = 0; n < 2; ++n) acc[a][b][m][n] = (f32x4){0.f, 0.f, 0.f, 0.f};
    bf16x8 At[4][2], B0[2][2], B1[2][2];
    const char* cA = (const char*)g.A + (size_t)cur.pm * tstep; const char* cB = (const char*)g.Bt + (size_t)cur.pn * tstep;
    S.a_ready(cur);
    if constexpr (SP2) {
        PG8_STAGE(PG8_SB(0, 0), cB, voffB); PG8_STAGE(PG8_SB(0, 1), cB + hstep, voffB); PG8_STAGE(PG8_SA(0, 0), cA, voffA); PG8_STAGE(PG8_SA(0, 1), cA + hstep, voffA);
        if (wr == 1) PG8_BAR;
        PG8_WAIT_V(2); PG8_BAR;
        PG8_STAGE(PG8_SB(1, 0), cB + kstep, voffB); PG8_STAGE(PG8_SA(1, 0), cA + kstep, voffA); PG8_STAGE(PG8_SB(1, 1), cB + hstep + kstep, voffB);
        PG8_WAIT_V(6); PG8_BAR;
    } else {
        PG8_STAGE(PG8_SB(0, 0), cB, voffB); PG8_STAGE(PG8_SA(0, 0), cA, voffA); PG8_STAGE(PG8_SB(0, 1), cB + hstep, voffB); PG8_STAGE(PG8_SA(0, 1), cA + hstep, voffA);
        if (wr == 1) PG8_BAR;
        PG8_WAIT_V(4); PG8_BAR;
        PG8_STAGE(PG8_SB(1, 0), cB + kstep, voffB); PG8_STAGE(PG8_SA(1, 0), cA + kstep, voffA); PG8_STAGE(PG8_SB(1, 1), cB + hstep + kstep, voffB);
        PG8_WAIT_V(6); PG8_BAR;
    }
    for (;;) {
        const bool has_next = S.next(ui + 1, nxt);
        const char* nA = has_next ? (const char*)g.A + (size_t)nxt.pm * tstep : cA; const char* nB = has_next ? (const char*)g.Bt + (size_t)nxt.pn * tstep : cB;
        for (int t = 0; t < nt; t += 2) {
            const bool last = (t == nt - 2);
            const char* a1 = cA + (size_t)(t + 1) * kstep;
            const char* a2 = last ? nA : cA + (size_t)(t + 2) * kstep; const char* b2 = last ? nB : cB + (size_t)(t + 2) * kstep;
            const char* a3 = a2 + kstep; const char* b3 = b2 + kstep;
            if (last && has_next) S.a_ready(nxt);
            if constexpr (SP2) {
            PG8_LDB(B0, 0, 0); PG8_LDB(B1, 0, 1); PG8_SCHED; PG8_LDA(At, 0, 0); PG8_STAGE(PG8_SA(1, 1), a1 + hstep, voffA);
            PG8_WAIT_V(8); PG8_WAIT_L(0); PG8_BAR; PG8_MMA(0, 0, At, B0); PG8_MMA(0, 1, At, B1); PG8_BAR; PG8_SCHED;
            PG8_LDA(At, 0, 1); PG8_STAGE(PG8_SB(0, 0), b2, voffB); PG8_STAGE(PG8_SB(0, 1), b2 + hstep, voffB); PG8_STAGE(PG8_SA(0, 0), a2, voffA);
            PG8_WAIT_V(8); PG8_WAIT_L(0); PG8_BAR; PG8_MMA(1, 0, At, B0); PG8_MMA(1, 1, At, B1); PG8_BAR; PG8_SCHED;
            PG8_LDB(B0, 1, 0); PG8_LDB(B1, 1, 1); PG8_SCHED; PG8_LDA(At, 1, 0); PG8_STAGE(PG8_SA(0, 1), a2 + hstep, voffA);
            PG8_WAIT_V(8); PG8_WAIT_L(0); PG8_BAR; PG8_MMA(0, 0, At, B0); PG8_MMA(0, 1, At, B1); PG8_BAR; PG8_SCHED;
            PG8_LDA(At, 1, 1); PG8_STAGE(PG8_SB(1, 0), b3, voffB); PG8_STAGE(PG8_SB(1, 1), b3 + hstep, voffB); PG8_STAGE(PG8_SA(1, 0), a3, voffA);
            PG8_WAIT_V(8); PG8_WAIT_L(0); PG8_BAR; PG8_MMA(1, 0, At, B0); PG8_MMA(1, 1, At, B1); PG8_BAR; PG8_SCHED;
            } else {
            PG8_LDB(B0, 0, 0); PG8_SCHED; PG8_LDA(At, 0, 0); PG8_STAGE(PG8_SA(1, 1), a1 + hstep, voffA);
            PG8_WAIT_L(8); PG8_BAR; PG8_WAIT_L(0); PG8_MMA(0, 0, At, B0); PG8_BAR; PG8_SCHED;
            PG8_LDB(B1, 0, 1); PG8_STAGE(PG8_SB(0, 0), b2, voffB);
            PG8_BAR; PG8_WAIT_L(0); PG8_MMA(0, 1, At, B1); PG8_BAR;
            PG8_LDA(At, 0, 1); PG8_STAGE(PG8_SA(0, 0), a2, voffA);
            PG8_BAR; PG8_WAIT_L(0); PG8_MMA(1, 0, At, B0); PG8_BAR; PG8_SCHED;
            PG8_STAGE(PG8_SB(0, 1), b2 + hstep, voffB);
            PG8_WAIT_V(6); PG8_BAR; PG8_MMA(1, 1, At, B1); PG8_BAR;
            PG8_LDB(B0, 1, 0); PG8_SCHED; PG8_LDA(At, 1, 0); PG8_STAGE(PG8_SA(0, 1), a2 + hstep, voffA);
            PG8_WAIT_L(8); PG8_BAR; PG8_WAIT_L(0); PG8_MMA(0, 0, At, B0); PG8_BAR; PG8_SCHED;
            PG8_LDB(B1, 1, 1); PG8_STAGE(PG8_SB(1, 0), b3, voffB);
            PG8_BAR; PG8_WAIT_L(0); PG8_MMA(0, 1, At, B1); PG8_BAR;
            PG8_LDA(At, 1, 1); PG8_STAGE(PG8_SA(1, 0), a3, voffA);
            PG8_BAR; PG8_WAIT_L(0); PG8_MMA(1, 0, At, B0); PG8_BAR; PG8_SCHED;
            PG8_STAGE(PG8_SB(1, 1), b3 + hstep, voffB);
            PG8_WAIT_V(6); PG8_BAR; PG8_MMA(1, 1, At, B1); PG8_BAR;
            }
        }
        if constexpr (ALIGN_EPI) { if (wr == 0) PG8_BAR; }
        if constexpr (!Epi::AFTER_DRAIN) { E(acc, cur, wr, wc, fr, fq); S.done(cur); }
        if (!has_next) break;
#pragma unroll
        for (int a = 0; a < 2; ++a)
#pragma unroll
            for (int b = 0; b < 2; ++b)
#pragma unroll
                for (int m = 0; m < 4; ++m)
#pragma unroll
                    for (int n = 0; n < 2; ++n) acc[a][b][m][n] = (f32x4){0.f, 0.f, 0.f, 0.f};
        cur = nxt; cA = nA; cB = nB; ++ui;
        if constexpr (ALIGN_EPI) { if (wr == 1) PG8_BAR; }
    }
    PG8_WAIT_V(0);
    if constexpr (!ALIGN_EPI) { if (wr == 0) PG8_BAR; }
    PG8_BAR;
    if constexpr (Epi::AFTER_DRAIN) { E.fused(acc, cur, wr, wc, fr, fq, lds, wid, lane); S.done(cur); }
#undef PG8_SA
#undef PG8_SB
#undef PG8_STAGE
#undef PG8_LDA
#undef PG8_LDB
#undef PG8_MMA
#undef PG8_WAIT_V
#undef PG8_WAIT_L
#undef PG8_BAR
#undef PG8_SCHED
}
}

constexpr int NWAVES = 8;
constexpr int BATCH = 8, SEQ = 2048, D = 1024, M = BATCH * SEQ;
constexpr int INW = 5832, N1P = 5888, FF = 2816, NLAYER = 2;
constexpr float NORM_EPS = 1e-6f;
constexpr size_t MiB = 1u << 20;
constexpr size_t WS_CTL = 0, CTL_ZERO_BYTES = 1 * MiB;
constexpr size_t WS_WINT = 1 * MiB;
constexpr size_t WS_ATTNOT = WS_WINT + (size_t)N1P * D * 2;
constexpr size_t WS_POOLET = WS_ATTNOT + 2 * MiB;
constexpr size_t WS_GLUT = WS_POOLET + 1 * MiB;
constexpr size_t WS_WOUTT = WS_GLUT + 2 * MiB;
constexpr size_t WS_S5T = WS_WOUTT + 2 * MiB;
constexpr size_t WS_S5P = WS_S5T + 4 * MiB;
constexpr size_t WS_S5Q = WS_S5P + 2 * MiB;
constexpr size_t WS_S5A = WS_S5Q + 2 * MiB;
constexpr size_t WS_BIAS = WS_S5A + 65536;
static_assert(WS_BIAS + 8192 <= 29 * MiB, "weights region");
constexpr size_t WS_HB = 29 * MiB;
constexpr size_t WS_DP = WS_HB, WS_ZB = WS_HB + 16 * MiB;
constexpr size_t WS_POOLU = 61 * MiB, WS_S5U = 77 * MiB;
constexpr size_t WS_MERGED = WS_POOLU;
constexpr size_t WS_FFNINT = WS_POOLU, WS_FFNOUTT = WS_POOLU + 11 * MiB;
constexpr size_t WS_Q = 93 * MiB, WS_QI = 125 * MiB, WS_KVX = 141 * MiB, WS_GATES = 149 * MiB;
constexpr size_t WS_F = WS_Q;
constexpr size_t WS_HID = 157 * MiB;
constexpr size_t WS_END = 245 * MiB;
static_assert(WS_FFNOUTT + (size_t)D * FF * 2 <= WS_Q && WS_HID + (size_t)M * FF * 2 <= WS_END && WS_F + (size_t)M * D * 4 <= WS_HID, "d_ws map");
constexpr int CW_BAR = 4096;
constexpr int RING_OFF = 0, RING_BYTES = 131072;
constexpr int LDSCTL_OFF = RING_BYTES, MISC_OFF = LDSCTL_OFF + 320;
constexpr int LDS_BYTES = 147456;
constexpr int NPHASE = 1 + 8 * NLAYER;

#define GAS __attribute__((address_space(1)))
#define LAS __attribute__((address_space(3)))
typedef unsigned short bf16;
typedef unsigned v4u __attribute__((ext_vector_type(4)));
typedef float f32x4 __attribute__((ext_vector_type(4)));
typedef short bf16x8 __attribute__((ext_vector_type(8)));
typedef GAS unsigned gu32;
typedef GAS unsigned long long gu64;
#define RLX_AGENT __ATOMIC_RELAXED, __HIP_MEMORY_SCOPE_AGENT
#define LDS_WAIT() asm volatile("s_waitcnt lgkmcnt(0)" ::: "memory")
#define VM_WAIT() asm volatile("s_waitcnt vmcnt(0)" ::: "memory")
__device__ __forceinline__ unsigned long long rt() { return __builtin_amdgcn_s_memrealtime(); }
__device__ __forceinline__ unsigned f2bf(float f) { unsigned u = __builtin_bit_cast(unsigned, f); return (u + 0x7fffu + ((u >> 16) & 1u)) >> 16; }
__device__ __forceinline__ unsigned pk2(float lo, float hi) { return f2bf(lo) | (f2bf(hi) << 16); }
#define XB_TMO      128
#define XB_XCNT(j)  (256  + 64 * (j))
#define XB_XSUB(j)  (1280 + 64 * (j))
#define XB_XGEN(j)  (2304 + 64 * (j))
#define XB_TOP      3328
#define XB_TOPGEN   3392
#define XCD_BAR_WORDS 3456
#define XB_SPIN_CAP (1u << 18)

__device__ __forceinline__ unsigned xb_ld(unsigned* p)              { return __hip_atomic_load(p, __ATOMIC_RELAXED, __HIP_MEMORY_SCOPE_AGENT); }
__device__ __forceinline__ unsigned xb_add(unsigned* p, unsigned v) { return __hip_atomic_fetch_add(p, v, __ATOMIC_RELAXED, __HIP_MEMORY_SCOPE_AGENT); }
__device__ __forceinline__ unsigned xb_xcc_id() { return (unsigned)__builtin_amdgcn_s_getreg((3 << 11) | 20) & 0xFu; }
#define XB_SPIN(cond, bar) do { unsigned _sp = 0; while (cond) { __builtin_amdgcn_s_sleep(1); \
    if ((++_sp & 255u) == 0u) { if (xb_ld(&(bar)[XB_TMO])) break; if (_sp > XB_SPIN_CAP) { atomicAdd(&(bar)[XB_TMO], 1u); break; } } } } while (0)

struct XcdBarrier {
    unsigned* bar; unsigned x;
    volatile LAS unsigned* st;
};

__device__ __forceinline__ XcdBarrier xcd_barrier_post(unsigned* bar, volatile LAS unsigned* st) {
    XcdBarrier b; b.bar = bar; b.x = xb_xcc_id(); b.st = st;
    if (threadIdx.x == 0) (void)xb_add(&bar[XB_XCNT(b.x)], 1u);
    return b;
}
__device__ __forceinline__ void xcd_barrier_complete(unsigned* bar, unsigned x, unsigned& nloc, unsigned& nx) {
    const unsigned G = gridDim.x * gridDim.y * gridDim.z;
    unsigned sum, cnt, mine, sp = 0u;
    for (;;) {
        sum = 0u; cnt = 0u; mine = 0u;
#pragma unroll
        for (unsigned j = 0; j < 16; ++j) { const unsigned c = xb_ld(&bar[XB_XCNT(j)]); sum += c; cnt += (c > 0u) ? 1u : 0u; mine = (j == x) ? c : mine; }
        if (sum == G) break;
        __builtin_amdgcn_s_sleep(1);
        if ((++sp & 255u) == 0u) { if (xb_ld(&bar[XB_TMO])) break; if (sp > XB_SPIN_CAP) { atomicAdd(&bar[XB_TMO], 1u); break; } }
    }
    nloc = mine > 0u ? mine : 1u; nx = cnt > 0u ? cnt : 1u;
}

__device__ __forceinline__ void xcd_barrier(const XcdBarrier& b) {
    asm volatile("s_waitcnt vmcnt(0)" ::: "memory");
    __syncthreads();
    if (threadIdx.x == 0) {
        unsigned* bar = b.bar;
        __builtin_amdgcn_s_waitcnt(0);
        unsigned nloc = b.st[0], nx = b.st[1];
        if (nloc == 0u) { xcd_barrier_complete(bar, b.x, nloc, nx); b.st[0] = nloc; b.st[1] = nx; }
        const unsigned old = xb_add(&bar[XB_XSUB(b.x)], 1u);
        const unsigned gen = old / nloc;
        if (old + 1u == (gen + 1u) * nloc) {
            __builtin_amdgcn_fence(__ATOMIC_RELEASE, "agent");
            asm volatile("s_waitcnt vmcnt(0)" ::: "memory");
            const unsigned og = xb_add(&bar[XB_TOP], 1u);
            const unsigned tg = og / nx;
            if (og + 1u == (tg + 1u) * nx) xb_add(&bar[XB_TOPGEN], 1u);
            else XB_SPIN(xb_ld(&bar[XB_TOPGEN]) == tg, bar);
            __builtin_amdgcn_fence(__ATOMIC_ACQUIRE, "agent");
            xb_add(&bar[XB_XGEN(b.x)], 1u);
            asm volatile("s_waitcnt vmcnt(0)" ::: "memory");
        } else {
            XB_SPIN(xb_ld(&bar[XB_XGEN(b.x)]) == gen, bar);
            __builtin_amdgcn_fence(__ATOMIC_ACQUIRE, "agent");
            asm volatile("s_waitcnt vmcnt(0)" ::: "memory");
        }
    }
    __syncthreads();
}

typedef short s16x4 __attribute__((ext_vector_type(4)));
typedef short v4i16_t __attribute__((ext_vector_type(4)));
typedef unsigned short u16x4 __attribute__((ext_vector_type(4)));
typedef unsigned v2u __attribute__((ext_vector_type(2)));
typedef float f32x2v __attribute__((ext_vector_type(2)));
#define DI __device__ __forceinline__
struct Frame {
    LAS unsigned char* lds;
    int tid, lane, wave, G;
};
DI float wave_sum(float v) {
#pragma unroll
    for (int o = 1; o < 64; o <<= 1) v += __shfl_xor(v, o);
    return v;
}
DI bf16x8 ldg16(const bf16* p) { return *(const GAS bf16x8*)p; }
DI bf16x8 ldg16o(const bf16* ub, unsigned off) { return *(const GAS bf16x8*)((const GAS unsigned char*)ub + off); }
DI v4u ldg16u(const bf16* ub, unsigned off) { return *(const GAS v4u*)((const GAS unsigned char*)ub + off); }
DI float bf2f(bf16 b) { return __uint_as_float(((unsigned)b) << 16); }
DI float bflo(unsigned w) { return __uint_as_float(w << 16); }
DI float bfhi(unsigned w) { return __uint_as_float(w & 0xffff0000u); }
#define MFMA16(a, b, c) __builtin_amdgcn_mfma_f32_16x16x32_bf16((a), (b), (c), 0, 0, 0)

struct MapId { DI int operator()(int n) const { return n; } };
struct MapWin { DI int operator()(int n) const {
    if (n < 512) return n;
    if (n < 1536) return n + 512;
    if (n < 1600) return n - 1536 + 2560;
    if (n < 1664) return n - 1600 + 2624;
    if (n < 2176) return n - 1664 + 2048;
    if (n < 2240) return n - 2176 + 2688;
    if (n < 2248) return n - 2240 + 2752;
    if (n < 2760) return n - 2248 + 512;
    return n - 2760 + 2816; } };
struct MapIl { int half; DI int operator()(int n) const { const int hi = n >= half ? 1 : 0, m = n - hi * half; return (m >> 7) * 256 + hi * 128 + (m & 127); } };
template <class Map> DI void transpose_item(const float* W, int K, int Ns, bf16* WT, LAS float* scr, int item, int lane, const Map& map) {
    const int nblk = (Ns + 31) / 32, kb = item / nblk, nb = item % nblk, k0 = 64 * kb, n0 = 32 * nb;
    const int nl = n0 + (lane & 31);
#pragma unroll 8
    for (int i = 0; i < 32; ++i) { const int kk = 2 * i + (lane >> 5); scr[kk * 33 + (lane & 31)] = nl < Ns ? W[(size_t)(k0 + kk) * Ns + nl] : 0.f; }
    LDS_WAIT(); asm volatile("" ::: "memory");
    const int c = lane & 7;
#pragma unroll
    for (int j = 0; j < 4; ++j) { const int nn = (lane >> 3) + 8 * j; const LAS float* s = scr + (8 * c) * 33 + nn;
        if (n0 + nn < Ns) { const int dr = map(n0 + nn);
            v4u o; o.x = pk2(s[0 * 33], s[1 * 33]); o.y = pk2(s[2 * 33], s[3 * 33]); o.z = pk2(s[4 * 33], s[5 * 33]); o.w = pk2(s[6 * 33], s[7 * 33]);
            *(GAS v4u*)(WT + (size_t)dr * K + k0 + 8 * c) = o; } }
    LDS_WAIT(); asm volatile("" ::: "memory");
}
struct In {
    const float *x, *n_mix_pre, *n_mix_post, *n_ffn_pre, *n_ffn_post, *w_in, *pool_mix_w, *pool_scale, *pool_out_w, *attn_out_w, *rel_bias, *lam_re, *lam_im, *log_dt,
                *b_re, *b_im, *c_re, *c_im, *s5_d, *glu_w, *w_out, *ffn_w_in, *ffn_w_out;
};
struct Args { In in; float* out; unsigned char* ws; int ph_lo, ph_hi; };
typedef const __attribute__((address_space(4))) Args* KArgs;
DI KArgs kargs() { KArgs p = (KArgs)__builtin_amdgcn_kernarg_segment_ptr(); asm volatile("" : "+s"(p)); return p; }
template <class T> DI T* opq(T* p) { asm volatile("" : "+s"(p)); return p; }
DI int opqv(int v) { asm volatile("" : "+v"(v)); return v; }

DI void convert_A(Frame& F, KArgs A, unsigned char* ws, int l) {
    LAS float* scr = (LAS float*)(F.lds + RING_OFF + F.wave * 16384);
    const int gw = blockIdx.x * NWAVES + F.wave, NGW = F.G * NWAVES;
    const int gt = blockIdx.x * (NWAVES * 64) + F.tid, NGT = F.G * NWAVES * 64;
    bf16* WINT = (bf16*)(ws + WS_WINT); bf16* ATTNOT = (bf16*)(ws + WS_ATTNOT); bf16* POOLET = (bf16*)(ws + WS_POOLET); bf16* GLUT = (bf16*)(ws + WS_GLUT); bf16* WOUTT = (bf16*)(ws + WS_WOUTT);
    constexpr int I_WIN = (D / 64) * ((INW + 31) / 32), I_SQ = (D / 64) * (D / 32), I_GLU = (512 / 64) * (2048 / 32);
    constexpr int NITEMS = I_WIN + 2 * I_SQ + I_GLU;
    for (int it = gw; it < NITEMS; it += NGW) {
        int r = it;
        if (r < I_WIN) { transpose_item(A->in.w_in + (size_t)l * D * INW, D, INW, WINT, scr, r, F.lane, MapWin{}); continue; } r -= I_WIN;
        if (r < I_SQ) { transpose_item(A->in.attn_out_w + (size_t)l * D * D, D, D, ATTNOT, scr, r, F.lane, MapId{}); continue; } r -= I_SQ;
        if (r < I_SQ) { transpose_item(A->in.w_out + (size_t)l * D * D, D, D, WOUTT, scr, r, F.lane, MapId{}); continue; } r -= I_SQ;
        transpose_item(A->in.glu_w + (size_t)l * 512 * 2048, 512, 2048, GLUT, scr, r, F.lane, MapIl{1024});
    }
    for (int i = gt; i < 56 * D / 8; i += NGT) *(GAS v4u*)(WINT + (size_t)2760 * D + (size_t)i * 8) = (v4u){0u, 0u, 0u, 0u};
    {   const float* mw = A->in.pool_mix_w + (size_t)l * 4 * 128 * 128; const float* sc = A->in.pool_scale + (size_t)l * 512; const float* pw = A->in.pool_out_w + (size_t)l * 512 * D;
        for (int idx = gt; idx < 512 * D; idx += NGT) { const int n = idx & (D - 1), gc = idx >> 10, g = gc >> 7;
            const float* mrow = mw + (size_t)gc * 128; float s = 0.f;
            for (int d = 0; d < 128; ++d) s += mrow[d] * sc[g * 128 + d] * pw[(size_t)(g * 128 + d) * D + n];
            POOLET[(size_t)n * 512 + gc] = (bf16)f2bf(s); } }
    if (blockIdx.x == 0) { float* BT = (float*)(ws + WS_BIAS);
        for (int i = F.tid; i < 128 * 16; i += NWAVES * 64) { const int d = i >> 4, h = i & 15;
            int bk = d; if (d >= 16) { bk = 16 + (int)(logf((float)d / 16.0f) / logf(8.0f) * 16.0f); bk = bk > 31 ? 31 : bk; }
            BT[i] = A->in.rel_bias[bk * 16 + h]; } }
    {   bf16* S5T = (bf16*)(ws + WS_S5T); bf16* S5P = (bf16*)(ws + WS_S5P); bf16* S5Q = (bf16*)(ws + WS_S5Q); float* S5A = (float*)(ws + WS_S5A);
        LAS float* apr = (LAS float*)(F.lds + RING_OFF);
        LAS float* api = apr + 17 * 64;
        LAS float* bbr = api + 17 * 64;
        LAS float* bbi = bbr + 64 * 16;
        LAS float* Kt = bbi + 64 * 16;
        __syncthreads();
        for (int task = blockIdx.x; task < 256; task += F.G) { const int g = task & 31, sub = task >> 5; const int lg = l * 32 + g;
            if (F.tid < 64) { const int n = F.tid;
                const float lr = A->in.lam_re[lg * 64 + n], li = A->in.lam_im[lg * 64 + n], dt = expf(A->in.log_dt[lg]);
                const float mag = expf(lr * dt), ar = mag * cosf(li * dt), ai = mag * sinf(li * dt), den = lr * lr + li * li;
                const float cr = ((ar - 1.0f) * lr + ai * li) / den, ci = (ai * lr - (ar - 1.0f) * li) / den;
                float pr = 1.f, pi = 0.f;
                for (int t = 0; t <= 16; ++t) { apr[t * 64 + n] = pr; api[t * 64 + n] = pi; const float nr = pr * ar - pi * ai, ni = pr * ai + pi * ar; pr = nr; pi = ni; }
                for (int c = 0; c < 16; ++c) { const float br = A->in.b_re[((size_t)lg * 64 + n) * 16 + c], bi = A->in.b_im[((size_t)lg * 64 + n) * 16 + c];
                    bbr[n * 16 + c] = cr * br - ci * bi; bbi[n * 16 + c] = cr * bi + ci * br; }
                if (sub == 0) { S5A[(g * 64 + n) * 2] = apr[16 * 64 + n]; S5A[(g * 64 + n) * 2 + 1] = api[16 * 64 + n]; }
            }
            __syncthreads();
            const float* Cre = A->in.c_re + (size_t)lg * 16 * 64; const float* Cim = A->in.c_im + (size_t)lg * 16 * 64;
            for (int e = F.tid; e < 4096; e += NWAVES * 64) { const int t = e >> 8, i = (e >> 4) & 15, c = e & 15; float s = 0.f;
                for (int n = 0; n < 64; ++n) { const float Cr = Cre[i * 64 + n], Ci = Cim[i * 64 + n], pr = apr[t * 64 + n], pi = api[t * 64 + n];
                    const float er = Cr * pr - Ci * pi, ei = Cr * pi + Ci * pr; s += er * bbr[n * 16 + c] - ei * bbi[n * 16 + c]; }
                Kt[e] = s; }
            __syncthreads();
            for (int e = F.tid; e < 32 * 256; e += NWAVES * 64) { const int r = sub * 32 + (e >> 8), k = e & 255, j = r >> 4, i = r & 15, s = k >> 4, c = k & 15;
                float v = (j >= s) ? Kt[((j - s) * 16 + i) * 16 + c] : 0.f; if (j == s && i == c) v += A->in.s5_d[l * 512 + g * 16 + i];
                S5T[((size_t)g * 256 + r) * 256 + k] = (bf16)f2bf(v); }
            for (int e = F.tid; e < 16 * 256; e += NWAVES * 64) { const int row = sub * 16 + (e >> 8), k = e & 255, n = row & 63, im = row >> 6, s = k >> 4, c = k & 15;
                const float pr = apr[(15 - s) * 64 + n], pi = api[(15 - s) * 64 + n], br = bbr[n * 16 + c], bi = bbi[n * 16 + c];
                const float v = im ? (pr * bi + pi * br) : (pr * br - pi * bi);
                S5P[((size_t)g * 128 + row) * 256 + k] = (bf16)f2bf(v); }
            for (int e = F.tid; e < 32 * 128; e += NWAVES * 64) { const int r = sub * 32 + (e >> 7), k = e & 127, j = r >> 4, i = r & 15, n = k & 63, im = k >> 6;
                const float Cr = Cre[i * 64 + n], Ci = Cim[i * 64 + n], pr = apr[(j + 1) * 64 + n], pi = api[(j + 1) * 64 + n];
                const float v = im ? -(Cr * pi + Ci * pr) : (Cr * pr - Ci * pi);
                S5Q[((size_t)g * 256 + r) * 128 + k] = (bf16)f2bf(v); }
            __syncthreads();
        }
    }
}
DI void convert_B(Frame& F, KArgs A, unsigned char* ws, int l) {
    LAS float* scr = (LAS float*)(F.lds + RING_OFF + F.wave * 16384);
    const int gw = blockIdx.x * NWAVES + F.wave, NGW = F.G * NWAVES;
    bf16* FFNINT = (bf16*)(ws + WS_FFNINT); bf16* FFNOUTT = (bf16*)(ws + WS_FFNOUTT);
    constexpr int I_IN = (D / 64) * (2 * FF / 32), I_OUT = (FF / 64) * (D / 32);
    for (int it = gw; it < I_IN + I_OUT; it += NGW) {
        if (it < I_IN) transpose_item(A->in.ffn_w_in + (size_t)l * D * 2 * FF, D, 2 * FF, FFNINT, scr, it, F.lane, MapIl{FF});
        else transpose_item(A->in.ffn_w_out + (size_t)l * FF * D, FF, D, FFNOUTT, scr, it - I_IN, F.lane, MapId{});
    }
}
DI void rms_rows_to_bf16(Frame& F, const float* x, const float* g, bf16* hb) {
    const int gw = blockIdx.x * NWAVES + F.wave, NGW = F.G * NWAVES;
    f32x4 gv[4];
#pragma unroll
    for (int j = 0; j < 4; ++j) gv[j] = ((const GAS f32x4*)g)[F.lane + 64 * j];
    for (int m = gw; m < M; m += NGW) {
        const GAS f32x4* xr = (const GAS f32x4*)(x + (size_t)m * D) + F.lane; f32x4 v[4]; float s = 0.f;
#pragma unroll
        for (int j = 0; j < 4; ++j) { v[j] = xr[64 * j]; s += (v[j].x * v[j].x + v[j].y * v[j].y) + (v[j].z * v[j].z + v[j].w * v[j].w); }
        const float rstd = 1.0f / sqrtf(wave_sum(s) * (1.f / D) + NORM_EPS);
        GAS v2u* o8 = (GAS v2u*)(hb + (size_t)m * D) + F.lane;
#pragma unroll
        for (int j = 0; j < 4; ++j) { v2u o; o.x = pk2(v[j].x * rstd * gv[j].x, v[j].y * rstd * gv[j].y); o.y = pk2(v[j].z * rstd * gv[j].z, v[j].w * rstd * gv[j].w); o8[64 * j] = o; }
    }
}
DI void norm_phase(Frame& F, const float* xin, float* xout, const float* f, const float* gpost, const float* gpre, bf16* hb) {
    const int gw = blockIdx.x * NWAVES + F.wave, NGW = F.G * NWAVES;
    for (int m = gw; m < M; m += NGW) {
        const GAS f32x4* fr = (const GAS f32x4*)(f + (size_t)m * D) + F.lane; const GAS f32x4* xr = (const GAS f32x4*)(xin + (size_t)m * D) + F.lane;
        f32x4 v[4], xv[4]; float s = 0.f;
#pragma unroll
        for (int j = 0; j < 4; ++j) { v[j] = fr[64 * j]; xv[j] = xr[64 * j]; s += (v[j].x * v[j].x + v[j].y * v[j].y) + (v[j].z * v[j].z + v[j].w * v[j].w); }
        const float rstd = 1.0f / sqrtf(wave_sum(s) * (1.f / D) + NORM_EPS); float s2 = 0.f;
        GAS f32x4* xo = (GAS f32x4*)(xout + (size_t)m * D) + F.lane;
#pragma unroll
        for (int j = 0; j < 4; ++j) { const f32x4 gp = ((const GAS f32x4*)gpost)[F.lane + 64 * j]; xv[j] = xv[j] + v[j] * rstd * gp; xo[64 * j] = xv[j];
            s2 += (xv[j].x * xv[j].x + xv[j].y * xv[j].y) + (xv[j].z * xv[j].z + xv[j].w * xv[j].w); }
        if (gpre) { const float rstd2 = 1.0f / sqrtf(wave_sum(s2) * (1.f / D) + NORM_EPS);
            GAS v2u* o8 = (GAS v2u*)(hb + (size_t)m * D) + F.lane;
#pragma unroll
            for (int j = 0; j < 4; ++j) { const f32x4 gq = ((const GAS f32x4*)gpre)[F.lane + 64 * j]; v2u o; o.x = pk2(xv[j].x * rstd2 * gq.x, xv[j].y * rstd2 * gq.y); o.y = pk2(xv[j].z * rstd2 * gq.z, xv[j].w * rstd2 * gq.w); o8[64 * j] = o; } }
    }
}

DI void pool_stencil(Frame& F, const bf16* POOLU, bf16* DP) {
    const int gt = blockIdx.x * (NWAVES * 64) + F.tid, NGT = F.G * NWAVES * 64;
    for (int idx = gt; idx < M * 64; idx += NGT) {
        const int t = idx >> 6, cc = idx & 63, ch0 = cc * 8, gi = cc >> 4, w = 2 << gi, pos = t & (SEQ - 1);
        const int nw = (pos + 1) < w ? (pos + 1) : w;
        float a[8], u0[8];
#pragma unroll
        for (int j = 0; j < 8; ++j) { a[j] = 0.f; u0[j] = 0.f; }
        for (int i = 0; i < nw; ++i) { const v4u v = *(const GAS v4u*)(POOLU + (size_t)(t - i) * 512 + ch0);
            const float e[8] = {bflo(v.x), bfhi(v.x), bflo(v.y), bfhi(v.y), bflo(v.z), bfhi(v.z), bflo(v.w), bfhi(v.w)};
#pragma unroll
            for (int j = 0; j < 8; ++j) { a[j] += e[j]; if (i == 0) u0[j] = e[j]; } }
        const float inv = 1.0f / (float)nw; v4u o;
        o.x = pk2(a[0] * inv - u0[0], a[1] * inv - u0[1]); o.y = pk2(a[2] * inv - u0[2], a[3] * inv - u0[3]);
        o.z = pk2(a[4] * inv - u0[4], a[5] * inv - u0[5]); o.w = pk2(a[6] * inv - u0[6], a[7] * inv - u0[7]);
        *(GAS v4u*)(DP + (size_t)t * 512 + ch0) = o;
    }
}
DI float gelu_tanh(float y) { const float u = 0.7978845608028654f * (y + 0.044715f * y * y * y); const float th = 1.0f - 2.0f * __builtin_amdgcn_rcpf(__expf(2.0f * u) + 1.0f); return 0.5f * y * (1.0f + th); }
constexpr int S5_SLD = 129, S5_XLD = 136, S5_XOFF = 69632;
DI void s5_unit(Frame& F, int b, int g, const bf16* S5U_, const bf16* S5T_, const bf16* S5P_, const bf16* S5Q_, const float* S5A_, bf16* ZB_) {
    const bf16* S5U = opq(S5U_); const bf16* S5T = opq(S5T_); const bf16* S5P = opq(S5P_); const bf16* S5Q = opq(S5Q_); const float* S5A = opq(S5A_); bf16* ZB = opq(ZB_);
    LAS float* Ssm = (LAS float*)(F.lds + RING_OFF);
    LAS bf16* XB = (LAS bf16*)(F.lds + RING_OFF + S5_XOFF);
    const int w = F.wave, lane = opqv(F.lane), fr = lane & 15, qd = lane >> 4;
    const bf16* Tg = S5T + (size_t)g * 65536; const bf16* Pg = S5P + (size_t)g * 32768; const bf16* Qg = S5Q + (size_t)g * 32768;
    const bf16* Ub = S5U + (size_t)b * SEQ * 512 + g * 16;
    f32x4 accY[2][8], accS[8];
#pragma unroll
    for (int ct = 0; ct < 8; ++ct) { accS[ct] = (f32x4){0.f, 0.f, 0.f, 0.f}; accY[0][ct] = accS[ct]; accY[1][ct] = accS[ct]; }
#pragma unroll 1
    for (int ks = 0; ks < 8; ++ks) {
        bf16x8 bfr[8];
        const int s = 2 * ks + (qd >> 1), c0 = 8 * (qd & 1);
#pragma unroll
        for (int ct = 0; ct < 8; ++ct) bfr[ct] = ldg16o(Ub + (size_t)ct * 16 * 16 * 512, (unsigned)((fr * 16 + s) * 512 + c0) * 2u);
        const bf16x8 aP = ldg16o(Pg + (size_t)(16 * w) * 256 + 32 * ks, (unsigned)(fr * 256 + 8 * qd) * 2u);
#pragma unroll
        for (int ct = 0; ct < 8; ++ct) accS[ct] = MFMA16(aP, bfr[ct], accS[ct]);
        if (ks <= w) {
            const bf16x8 aT0 = ldg16o(Tg + (size_t)(32 * w) * 256 + 32 * ks, (unsigned)(fr * 256 + 8 * qd) * 2u), aT1 = ldg16o(Tg + (size_t)(32 * w + 16) * 256 + 32 * ks, (unsigned)(fr * 256 + 8 * qd) * 2u);
#pragma unroll
            for (int ct = 0; ct < 8; ++ct) { accY[0][ct] = MFMA16(aT0, bfr[ct], accY[0][ct]); accY[1][ct] = MFMA16(aT1, bfr[ct], accY[1][ct]); }
        }
    }
#pragma unroll
    for (int ct = 0; ct < 8; ++ct)
#pragma unroll
        for (int r = 0; r < 4; ++r) Ssm[(16 * w + 4 * qd + r) * S5_SLD + 16 * ct + fr] = accS[ct][r];
    __syncthreads();
    if (F.tid < 64) { const int n = F.tid; const float ar = S5A[(g * 64 + n) * 2], ai = S5A[(g * 64 + n) * 2 + 1]; float xr = 0.f, xi = 0.f;
        for (int c = 0; c < 128; ++c) { XB[c * S5_XLD + n] = (bf16)f2bf(xr); XB[c * S5_XLD + 64 + n] = (bf16)f2bf(xi);
            const float sr = Ssm[n * S5_SLD + c], si = Ssm[(64 + n) * S5_SLD + c];
            const float nr = ar * xr - ai * xi + sr, ni = ar * xi + ai * xr + si; xr = nr; xi = ni; } }
    __syncthreads();
#pragma unroll 1
    for (int ks = 0; ks < 4; ++ks) {
        const bf16x8 aQ0 = ldg16o(Qg + (size_t)(32 * w) * 128 + 32 * ks, (unsigned)(fr * 128 + 8 * qd) * 2u), aQ1 = ldg16o(Qg + (size_t)(32 * w + 16) * 128 + 32 * ks, (unsigned)(fr * 128 + 8 * qd) * 2u);
#pragma unroll
        for (int ct = 0; ct < 8; ++ct) { const bf16x8 bx = *(const LAS bf16x8*)(XB + (16 * ct + fr) * S5_XLD + 32 * ks + 8 * qd);
            accY[0][ct] = MFMA16(aQ0, bx, accY[0][ct]); accY[1][ct] = MFMA16(aQ1, bx, accY[1][ct]); }
    }
#pragma unroll
    for (int rt = 0; rt < 2; ++rt)
#pragma unroll
        for (int ct = 0; ct < 8; ++ct) { const int tok = (16 * ct + fr) * 16 + 2 * w + rt; const f32x4 y = accY[rt][ct];
            v2u o; o.x = pk2(gelu_tanh(y[0]), gelu_tanh(y[1])); o.y = pk2(gelu_tanh(y[2]), gelu_tanh(y[3]));
            *(GAS v2u*)(ZB + (size_t)(b * SEQ + tok) * 512 + g * 16 + 4 * qd) = o; }
    __syncthreads();
}
constexpr int AT_BIAS_OFF = 0, AT_SEL_OFF = 8192, AT_V_OFF = 24576, AT_VLD = 144  ;
DI s16x4 vtr(const LAS unsigned char* p) { return __builtin_bit_cast(s16x4, __builtin_amdgcn_ds_read_tr16_b64_v4i16((LAS v4i16_t*)p)); }
#define MEMBAR() asm volatile("" ::: "memory")
DI int row16_sum(int x) {
    x += __builtin_amdgcn_update_dpp(0, x, 0xB1, 0xF, 0xF, true);
    x += __builtin_amdgcn_update_dpp(0, x, 0x4E, 0xF, 0xF, true);
    x += __builtin_amdgcn_update_dpp(0, x, 0x141, 0xF, 0xF, true);
    x += __builtin_amdgcn_update_dpp(0, x, 0x140, 0xF, 0xF, true);
    return x; }
DI int xor16_i(int x) { return __builtin_amdgcn_ds_swizzle(x, 0x401F); }
DI float xor16_f(float x) { return __int_as_float(__builtin_amdgcn_ds_swizzle(__float_as_int(x), 0x401F)); }
DI int half32_sum(int x) { x = row16_sum(x); return x + xor16_i(x); }
DI void attn_unit(Frame& F, int b, int tile, const bf16* QI_, const bf16* KVX_, bf16* QA_, const float* BIAS_) {
    const bf16* QI = opq(QI_); const bf16* KVX = opq(KVX_); bf16* QA = opq(QA_); const float* BIAS = opq(BIAS_);
    LAS float* biasL = (LAS float*)(F.lds + RING_OFF + AT_BIAS_OFF);
    const int w = F.wave;
    LAS unsigned short* selw = (LAS unsigned short*)(F.lds + RING_OFF + AT_SEL_OFF) + w * 512;
    for (int i = F.tid; i < 2048; i += NWAVES * 64) biasL[i] = BIAS[i];
    { LAS v4u* z = (LAS v4u*)selw; z[F.lane] = (v4u){0u, 0u, 0u, 0u}; }
    __syncthreads();
    const size_t rowb = (size_t)b * SEQ;
    const int tb = tile * 16 + 2 * w;
    const int nkp = ((tb + 1) / 16 + 2) / 2;
    unsigned key[64];
    {
        const int lane = opqv(F.lane), fr = lane & 15, qd = lane >> 4, tq = tb + (qd >> 1), odd = qd & 1;
        bf16x8 aQ[2];
#pragma unroll
        for (int ks = 0; ks < 2; ++ks) aQ[ks] = ldg16(QI + (rowb + tb + (fr >> 3)) * 512 + (fr & 7) * 64 + 32 * ks + 8 * qd);
        const v2u wraw = *(const GAS v2u*)(KVX + (rowb + tq) * 256 + 192 + 4 * odd);
        const float wv[4] = {bflo(wraw.x), bfhi(wraw.x), bflo(wraw.y), bfhi(wraw.y)};
        const unsigned koff = (unsigned)(fr * 256 + 8 * qd) * 2u;
#pragma unroll 1
        for (int ch = 0; ch * 16 < nkp; ++ch) {
            unsigned tmp[16];
            const bf16* kub = KVX + (rowb + 512 * ch) * 256 + 128;
#pragma unroll
            for (int j = 0; j < 16; ++j) {
                const bf16x8 e0 = ldg16o(kub + (2 * j) * 16 * 256, koff), e1 = ldg16o(kub + (2 * j) * 16 * 256 + 32, koff);
                const bf16x8 o0 = ldg16o(kub + (2 * j + 1) * 16 * 256, koff), o1 = ldg16o(kub + (2 * j + 1) * 16 * 256 + 32, koff);
                f32x4 cE = (f32x4){0.f, 0.f, 0.f, 0.f}, cO = cE;
                cE = MFMA16(aQ[0], e0, cE); cE = MFMA16(aQ[1], e1, cE); cO = MFMA16(aQ[0], o0, cO); cO = MFMA16(aQ[1], o1, cO);
                float sE = 0.f, sO = 0.f;
#pragma unroll
                for (int r = 0; r < 4; ++r) { sE += wv[r] * fmaxf(cE[r], 0.f); sO += wv[r] * fmaxf(cO[r], 0.f); }
                sE += xor16_f(sE); sO += xor16_f(sO);
                float s = odd ? sO : sE; s += 0.0f;
                const unsigned bits = __float_as_uint(s); const unsigned sk = bits ^ ((unsigned)((int)bits >> 31) | 0x80000000u);
                tmp[j] = (512 * ch + 32 * j + 16 * odd + fr <= tq) ? sk : 0u;
                if ((j & 3) == 3) MEMBAR();
            }
#define KEYCASE(c) case c: _Pragma("unroll") for (int j = 0; j < 16; ++j) key[16 * c + j] = tmp[j]; break;
            switch (ch) { KEYCASE(0) KEYCASE(1) KEYCASE(2) default: _Pragma("unroll") for (int j = 0; j < 16; ++j) key[48 + j] = tmp[j]; break; }
#undef KEYCASE
        }
    }
    unsigned theta = 0u; bool fin = false;
#pragma unroll 1
    for (int bit = 31; bit >= 0; --bit) {
        const unsigned cand = theta | (1u << bit); int cnt = 0;
#pragma unroll
        for (int ch = 0; ch < 4; ++ch) if (ch * 16 < nkp) {
#pragma unroll
            for (int j = 0; j < 16; ++j) cnt += (key[ch * 16 + j] >= cand) ? 1 : 0; }
        cnt = half32_sum(cnt);
        if (!fin && cnt >= 256) theta = cand;
        fin = fin || (cnt == 256);
        if (__all(fin)) break;
    }
    int nsel;
    {
        const int lane = opqv(F.lane), fr = lane & 15, qd = lane >> 4, odd = qd & 1;
        int cgt = 0;
#pragma unroll
        for (int ch = 0; ch < 4; ++ch) if (ch * 16 < nkp) {
#pragma unroll
            for (int j = 0; j < 16; ++j) cgt += (key[ch * 16 + j] > theta) ? 1 : 0; }
        cgt = half32_sum(cgt);
        const int quota = (theta == 0u) ? 0 : (256 - cgt);
        int base = 0, eqseen = 0; const unsigned below = (1u << (lane & 31)) - 1u; const int sh = 32 * (qd >> 1);
        LAS unsigned short* sl = selw + (qd >> 1) * 256;
#pragma unroll 1
        for (int ch = 0; ch * 16 < nkp; ++ch) {
            unsigned tmp[16];
#define KEYCASE(c) case c: _Pragma("unroll") for (int j = 0; j < 16; ++j) tmp[j] = key[16 * c + j]; break;
            switch (ch) { KEYCASE(0) KEYCASE(1) KEYCASE(2) default: _Pragma("unroll") for (int j = 0; j < 16; ++j) tmp[j] = key[48 + j]; break; }
#undef KEYCASE
#pragma unroll
            for (int j = 0; j < 16; ++j) {
                const bool gtk = tmp[j] > theta, eqk = (tmp[j] == theta) && (theta != 0u);
                const unsigned long long be = __ballot(eqk); const unsigned e32 = (unsigned)(be >> sh); const int pe = __popc(e32 & below);
                const bool take = gtk || (eqk && (eqseen + pe) < quota);
                const unsigned long long bt = __ballot(take); const unsigned t32 = (unsigned)(bt >> sh); const int pt = __popc(t32 & below);
                if (take) sl[base + pt] = (unsigned short)(512 * ch + 32 * j + 16 * odd + fr);
                base += __popc(t32); eqseen += __popc(e32);
            }
        }
        nsel = base;
    }
#pragma unroll 1
    for (int qq = 0; qq < 2; ++qq) {
        const int lane = opqv(F.lane), fr = lane & 15, qd = lane >> 4;
        LAS unsigned char* Vs = F.lds + RING_OFF + AT_V_OFF + w * (64 * AT_VLD);
        const int t = tb + qq; const int ns = __shfl(nsel, 32 * qq);
        const LAS unsigned short* sl = selw + qq * 256;
        bf16* qrow = QA + (rowb + t) * 1024;
        bf16x8 bq[2];
#pragma unroll
        for (int ks = 0; ks < 2; ++ks) bq[ks] = ldg16(qrow + fr * 64 + 32 * ks + 8 * qd);
        f32x4 st[16];
#pragma unroll
        for (int blk = 0; blk < 16; ++blk) { const int kidx = sl[16 * blk + fr];
            const unsigned ko = (unsigned)(kidx * 256 + 8 * qd) * 2u; const bf16x8 a0 = ldg16o(KVX + rowb * 256, ko), a1 = ldg16o(KVX + rowb * 256 + 32, ko);
            f32x4 c = (f32x4){0.f, 0.f, 0.f, 0.f}; c = MFMA16(a0, bq[0], c); c = MFMA16(a1, bq[1], c); st[blk] = c;
            if ((blk & 7) == 7) MEMBAR(); }
        float mx = -3.0e38f;
#pragma unroll
        for (int blk = 0; blk < 16; ++blk) { const u16x4 k4 = *(const LAS u16x4*)(sl + 16 * blk + 4 * qd);
#pragma unroll
            for (int r = 0; r < 4; ++r) { int dist = t - (int)k4[r]; dist = dist < 0 ? 0 : (dist > 127 ? 127 : dist);
                float lg = st[blk][r] + biasL[dist * 16 + fr]; if (16 * blk + 4 * qd + r >= ns) lg = -1.0e30f; st[blk][r] = lg; mx = fmaxf(mx, lg); } }
        mx = fmaxf(mx, __shfl_xor(mx, 16)); mx = fmaxf(mx, __shfl_xor(mx, 32));
        float sum = 0.f;
#pragma unroll
        for (int blk = 0; blk < 16; ++blk)
#pragma unroll
            for (int r = 0; r < 4; ++r) { const float p = __expf(st[blk][r] - mx); st[blk][r] = p; sum += p; }
        sum += __shfl_xor(sum, 16); sum += __shfl_xor(sum, 32);
        const float inv = 1.0f / sum;
        f32x4 o[4];
#pragma unroll
        for (int nb = 0; nb < 4; ++nb) o[nb] = (f32x4){0.f, 0.f, 0.f, 0.f};
        v4u vv[8];
#pragma unroll
        for (int i = 0; i < 8; ++i) { const int piece = lane + 64 * i, row = piece >> 3, pc = piece & 7; const int kidx = sl[row];
            vv[i] = ldg16u(KVX + rowb * 256 + 64, (unsigned)(kidx * 256 + 8 * pc) * 2u); }
#pragma unroll
        for (int vr = 0; vr < 4; ++vr) {
#pragma unroll
            for (int i = 0; i < 8; ++i) { const int piece = lane + 64 * i, row = piece >> 3, pc = piece & 7; *(LAS v4u*)(Vs + row * AT_VLD + pc * 16) = vv[i]; }
            if (vr < 3) {
#pragma unroll
                for (int i = 0; i < 8; ++i) { const int piece = lane + 64 * i, row = piece >> 3, pc = piece & 7; const int kidx = sl[64 * (vr + 1) + row];
                    vv[i] = ldg16u(KVX + rowb * 256 + 64, (unsigned)(kidx * 256 + 8 * pc) * 2u); } }
#pragma unroll
            for (int kk = 0; kk < 2; ++kk) {
                const f32x4 p0 = st[4 * vr + 2 * kk] * inv, p1 = st[4 * vr + 2 * kk + 1] * inv;
                const v4u pw = (v4u){pk2(p0[0], p0[1]), pk2(p0[2], p0[3]), pk2(p1[0], p1[1]), pk2(p1[2], p1[3])};
                const bf16x8 pa = __builtin_bit_cast(bf16x8, pw);
                const int q4 = fr >> 2, p4 = fr & 3;
#pragma unroll
                for (int nb = 0; nb < 4; ++nb) {
                    const s16x4 lo = vtr(Vs + (32 * kk + 4 * qd + q4) * AT_VLD + (16 * nb + 4 * p4) * 2);
                    const s16x4 hi = vtr(Vs + (32 * kk + 16 + 4 * qd + q4) * AT_VLD + (16 * nb + 4 * p4) * 2);
                    const bf16x8 bv = (bf16x8){lo[0], lo[1], lo[2], lo[3], hi[0], hi[1], hi[2], hi[3]};
                    o[nb] = MFMA16(pa, bv, o[nb]);
                }
            }
        }
#pragma unroll
        for (int nb = 0; nb < 4; ++nb)
#pragma unroll
            for (int r = 0; r < 4; ++r) qrow[(4 * qd + r) * 64 + 16 * nb + fr] = (bf16)f2bf(o[nb][r]);
    }
    __syncthreads();
}

#ifndef PH_MASK
#define PH_MASK 0x1ff
#endif
#define PH_ON(k) (((PH_MASK) >> (k)) & 1)
#ifndef PH_DUP
#define PH_DUP 0
#endif
#define NREP(k) ((((PH_DUP) >> (k)) & 1) ? 2 : 1)
#ifndef MK_SP2
#define MK_SP2 true
#endif
#ifndef MK_ALIGN
#define MK_ALIGN true
#endif
__global__ void __launch_bounds__(NWAVES * 64, 2) hybrid_fwd(Args args) {
    extern __shared__ __attribute__((aligned(16))) unsigned char lds[];
#define MKFRAME() Frame F; F.lds = (LAS unsigned char*)lds; F.tid = opqv((int)threadIdx.x); F.lane = F.tid & 63; F.wave = __builtin_amdgcn_readfirstlane(F.tid >> 6); F.G = gridDim.x
    const int lo = args.ph_lo, hi = args.ph_hi;
    {   KArgs A = kargs(); gu32* ctl = (gu32*)(A->ws + WS_CTL); MKFRAME();
        for (int u = F.tid; u < (LDS_BYTES - LDSCTL_OFF) / 4; u += NWAVES * 64) ((LAS unsigned*)(F.lds + LDSCTL_OFF))[u] = 0u;
        __syncthreads();
        volatile LAS unsigned* MISC = (volatile LAS unsigned*)(F.lds + MISC_OFF);
        (void)xcd_barrier_post((unsigned*)(ctl + CW_BAR), MISC + 8); }
#define IN(k) (lo <= (k) && (k) < hi)
#define BOTH(k) (IN(k) && IN((k) + 1))
#define GRID_BAR() do { KArgs Ab = kargs(); XcdBarrier bar; bar.bar = (unsigned*)((gu32*)(Ab->ws + WS_CTL) + CW_BAR); bar.x = xb_xcc_id(); bar.st = (volatile LAS unsigned*)((LAS unsigned char*)lds + MISC_OFF) + 8; xcd_barrier(bar); } while (0)
#define WSP(T, off) ((T*)(ws + (off)))

    if (PH_ON(0) && IN(0)) { KArgs A = kargs(); unsigned char* ws = A->ws; MKFRAME();
        _Pragma("unroll 1") for (int rep = 0; rep < NREP(11); ++rep) convert_A(F, A, ws, 0);
        rms_rows_to_bf16(F, A->in.x, A->in.n_mix_pre, WSP(bf16, WS_HB)); if (BOTH(0)) GRID_BAR(); }

#pragma unroll 1
    for (int l = 0; l < NLAYER; ++l) {
        const int pb = 1 + 8 * l;
        if (PH_ON(1) && IN(pb)) { KArgs A = kargs(); unsigned char* ws = A->ws; MKFRAME();
            pg8::Gemm g{WSP(bf16, WS_HB), WSP(bf16, WS_WINT), M, N1P, D}; pg8::StaticOrder S; S.init(M, N1P, F.G, (int)blockIdx.x);
            pg8::EpiRoute E{WSP(bf16, WS_POOLU), WSP(bf16, WS_S5U), WSP(bf16, WS_Q), WSP(bf16, WS_QI), WSP(bf16, WS_KVX), WSP(bf16, WS_GATES)};
            _Pragma("unroll 1") for (int rep = 0; rep < NREP(1); ++rep)
            pg8::gemm_phase<pg8::EpiRoute, pg8::StaticOrder, MK_ALIGN, MK_SP2>(F.lds + RING_OFF, g, S, E);
            if (BOTH(pb)) GRID_BAR();
        }
        if (PH_ON(2) && IN(pb + 1)) { KArgs A = kargs(); unsigned char* ws = A->ws; MKFRAME();
#ifndef NO_POOL
            _Pragma("unroll 1") for (int rep = 0; rep < NREP(9); ++rep)
            pool_stencil(F, WSP(bf16, WS_POOLU), WSP(bf16, WS_DP));
#endif
#ifndef NO_S5
            _Pragma("unroll 1") for (int rep = 0; rep < NREP(10); ++rep)
#pragma unroll 1
            for (int u = blockIdx.x; u < 256; u += F.G) s5_unit(F, u >> 5, u & 31, WSP(bf16, WS_S5U), WSP(bf16, WS_S5T), WSP(bf16, WS_S5P), WSP(bf16, WS_S5Q), WSP(float, WS_S5A), WSP(bf16, WS_ZB));
#endif
#ifndef NO_ATTN
#pragma unroll 1
            for (int u4 = 4 * blockIdx.x; u4 < 1024; u4 += 4 * F.G) {
#pragma unroll 1
                for (int h = 0; h < 4; ++h) { const int u = u4 >> 2, b = u >> 5, j = u & 31; const int tile = (h & 2 ? 64 : 0) + ((h & 1) ? 63 - j : j);
                    attn_unit(F, b, tile, WSP(bf16, WS_QI), WSP(bf16, WS_KVX), WSP(bf16, WS_Q), WSP(float, WS_BIAS)); } }
#endif
            if (BOTH(pb + 1)) GRID_BAR();
        }
        if (PH_ON(3) && IN(pb + 2)) {
          _Pragma("unroll 1") for (int rep = 0; rep < NREP(3); ++rep) {
            if (rep) { VM_WAIT(); __builtin_amdgcn_fence(__ATOMIC_ACQUIRE, "agent"); VM_WAIT(); __syncthreads(); }
            { KArgs A = kargs(); unsigned char* ws = A->ws; MKFRAME();
              pg8::Gemm g{WSP(bf16, WS_ZB), WSP(bf16, WS_GLUT), M, 2048, 512}; pg8::PairOrder S; S.base.init(M, D, F.G, (int)blockIdx.x);
              pg8::EpiGlu E{WSP(bf16, WS_MERGED), WSP(bf16, WS_GATES)};
              pg8::gemm_phase<pg8::EpiGlu, pg8::PairOrder, MK_ALIGN, MK_SP2>(F.lds + RING_OFF, g, S, E); }
            VM_WAIT(); __builtin_amdgcn_fence(__ATOMIC_ACQUIRE, "agent"); VM_WAIT(); __syncthreads();
            { KArgs A = kargs(); unsigned char* ws = A->ws; MKFRAME();
              pg8::Gemm g{WSP(bf16, WS_DP), WSP(bf16, WS_POOLET), M, D, 512}; pg8::StaticOrder S; S.init(M, D, F.G, (int)blockIdx.x);
              pg8::EpiAccum<0> E{WSP(bf16, WS_MERGED), WSP(bf16, WS_GATES)};
              pg8::gemm_phase<pg8::EpiAccum<0>, pg8::StaticOrder, MK_ALIGN, MK_SP2>(F.lds + RING_OFF, g, S, E); }
            VM_WAIT(); __builtin_amdgcn_fence(__ATOMIC_ACQUIRE, "agent"); VM_WAIT(); __syncthreads();
            { KArgs A = kargs(); unsigned char* ws = A->ws; MKFRAME();
              pg8::Gemm g{WSP(bf16, WS_Q), WSP(bf16, WS_ATTNOT), M, D, D}; pg8::StaticOrder S; S.init(M, D, F.G, (int)blockIdx.x);
              pg8::EpiAccum<1024> E{WSP(bf16, WS_MERGED), WSP(bf16, WS_GATES)};
              pg8::gemm_phase<pg8::EpiAccum<1024>, pg8::StaticOrder, MK_ALIGN, MK_SP2>(F.lds + RING_OFF, g, S, E); }
          }
            if (BOTH(pb + 2)) GRID_BAR();
        }
        if (PH_ON(4) && IN(pb + 3)) { KArgs A = kargs(); unsigned char* ws = A->ws; MKFRAME();
            pg8::Gemm g{WSP(bf16, WS_MERGED), WSP(bf16, WS_WOUTT), M, D, D}; pg8::StaticOrder S; S.init(M, D, F.G, (int)blockIdx.x);
            pg8::EpiF32 E{WSP(float, WS_F), D};
            _Pragma("unroll 1") for (int rep = 0; rep < NREP(4); ++rep)
            pg8::gemm_phase<pg8::EpiF32, pg8::StaticOrder, MK_ALIGN, MK_SP2>(F.lds + RING_OFF, g, S, E);
            if (BOTH(pb + 3)) GRID_BAR();
        }
        if (PH_ON(5) && IN(pb + 4)) { KArgs A = kargs(); unsigned char* ws = A->ws; MKFRAME();
            _Pragma("unroll 1") for (int rep = 0; rep < NREP(12); ++rep) convert_B(F, A, ws, l);
            norm_phase(F, l == 0 ? A->in.x : (const float*)A->out, A->out, WSP(float, WS_F), A->in.n_mix_post + l * D, A->in.n_ffn_pre + l * D, WSP(bf16, WS_HB));
            if (BOTH(pb + 4)) GRID_BAR();
        }
        if (PH_ON(6) && IN(pb + 5)) { KArgs A = kargs(); unsigned char* ws = A->ws; MKFRAME();
            pg8::Gemm g{WSP(bf16, WS_HB), WSP(bf16, WS_FFNINT), M, 2 * FF, D}; pg8::StaticOrder S; S.init(M, 2 * FF, F.G, (int)blockIdx.x);
            pg8::EpiSwiglu E{WSP(bf16, WS_HID), FF};
            _Pragma("unroll 1") for (int rep = 0; rep < NREP(6); ++rep)
            pg8::gemm_phase<pg8::EpiSwiglu, pg8::StaticOrder, MK_ALIGN, MK_SP2>(F.lds + RING_OFF, g, S, E);
            if (BOTH(pb + 5)) GRID_BAR();
        }
        if (PH_ON(7) && IN(pb + 6)) { KArgs A = kargs(); unsigned char* ws = A->ws; MKFRAME();
            pg8::Gemm g{WSP(bf16, WS_HID), WSP(bf16, WS_FFNOUTT), M, D, FF}; pg8::StaticOrder S; S.init(M, D, F.G, (int)blockIdx.x);
            pg8::EpiF32 E{WSP(float, WS_F), D};
            _Pragma("unroll 1") for (int rep = 0; rep < NREP(7); ++rep)
            pg8::gemm_phase<pg8::EpiF32, pg8::StaticOrder, MK_ALIGN, MK_SP2>(F.lds + RING_OFF, g, S, E);
            if (BOTH(pb + 6)) GRID_BAR();
        }
        if (PH_ON(8) && IN(pb + 7)) { KArgs A = kargs(); unsigned char* ws = A->ws; MKFRAME();
            if (l + 1 < NLAYER) { _Pragma("unroll 1") for (int rep = 0; rep < NREP(11); ++rep) convert_A(F, A, ws, l + 1); }
            norm_phase(F, (const float*)A->out, A->out, WSP(float, WS_F), A->in.n_ffn_post + l * D, (l + 1 < NLAYER) ? A->in.n_mix_pre + (l + 1) * D : (const float*)nullptr, WSP(bf16, WS_HB));
            if (BOTH(pb + 7)) GRID_BAR();
        }
    }
#undef WSP
#undef IN
#undef BOTH
#undef GRID_BAR
}

#ifndef MK_ONE_LAUNCH
#define MK_ONE_LAUNCH 1
#endif
extern "C" void kernel_launch(void* const* d_in, const int* in_sizes, int n_in, void* d_out, int out_size, void* d_ws, size_t ws_size, hipStream_t stream) {
    static int grid = 0;
    if (grid == 0) {
        if (n_in != 23 || in_sizes[0] != M * D || out_size != M * D || ws_size < WS_END) { fprintf(stderr, "kernel_launch: unexpected shapes (n_in %d, in0 %d, out %d, ws %zu); nothing launched\n", n_in, n_in > 0 ? in_sizes[0] : -1, out_size, ws_size); grid = -1; return; }
        int dev = 0, cus = 0, per_cu = 0;
        if (hipGetDevice(&dev) != hipSuccess || hipDeviceGetAttribute(&cus, hipDeviceAttributeMultiprocessorCount, dev) != hipSuccess) { grid = -1; return; }
        if (hipFuncSetAttribute((const void*)hybrid_fwd, hipFuncAttributeMaxDynamicSharedMemorySize, LDS_BYTES) != hipSuccess) { fprintf(stderr, "kernel_launch: hipFuncSetAttribute failed\n"); grid = -1; return; }
        if (hipOccupancyMaxActiveBlocksPerMultiprocessor(&per_cu, (const void*)hybrid_fwd, NWAVES * 64, LDS_BYTES) != hipSuccess || per_cu < 1) { fprintf(stderr, "kernel_launch: occupancy query says %d\n", per_cu); per_cu = 1; }
        (void)hipGetLastError();
        grid = cus;
    }
    if (grid < 0) return;
    if (hipMemsetAsync((char*)d_ws + WS_CTL, 0, CTL_ZERO_BYTES, stream) != hipSuccess) return;
    Args a{};
    const float** ip = (const float**)&a.in;
    for (int i = 0; i < 23; ++i) ip[i] = (const float*)d_in[i];
    a.out = (float*)d_out; a.ws = (unsigned char*)d_ws;
#if MK_ONE_LAUNCH
    a.ph_lo = 0; a.ph_hi = NPHASE;
    hipLaunchKernelGGL(hybrid_fwd, dim3(grid), dim3(NWAVES * 64), LDS_BYTES, stream, a);
#else
    for (int ph = 0; ph < NPHASE; ++ph) { a.ph_lo = ph; a.ph_hi = ph + 1;
        hipLaunchKernelGGL(hybrid_fwd, dim3(grid), dim3(NWAVES * 64), LDS_BYTES, stream, a); }
#endif
}
```

```cpp
#include <hip/hip_runtime.h>
#include <cstdio>
#include <cstdint>
namespace pg8 {
#define PG8_LAS __attribute__((address_space(3)))
typedef unsigned short bf16_t;
typedef short bf16x8 __attribute__((ext_vector_type(8)));
typedef float f32x4 __attribute__((ext_vector_type(4)));
typedef unsigned u32x4 __attribute__((ext_vector_type(4)));
constexpr int BM = 256, BK = 64, HALF = 128, HTB = HALF * BK * 2  , STAGE_BYTES = 8 * HTB, NXCD = 8, WGM = 8;

__host__ __device__ __forceinline__ int lds_byte(int r, int c) { const int st = (r >> 4) * 2 + (c >> 5), rr = r & 15, cc = c & 31, ob = rr * 64 + cc * 2; return st * 1024 + (ob ^ (((ob >> 9) & 1) << 5)); }
__host__ __device__ __forceinline__ void stage_rc(int b, int& R, int& C) { const int st = b / 1024, sb = b % 1024, swz = sb ^ (((sb >> 9) & 1) << 5); R = (st >> 1) * 16 + swz / 64; C = (st & 1) * 32 + (swz % 64) / 2; }
__host__ __device__ __forceinline__ int perm32(int rho) { const int n = rho >> 4, i = rho & 15; return 8 * (i >> 2) + 4 * n + (i & 3); }

struct Unit { int pm, pn; };
struct Gemm { const bf16_t* A; const bf16_t* Bt; int M, N, K; };

struct StaticOrder {
    int nM, nN, nwg, G, c;
    __host__ __device__ void init(int M, int N, int G_, int c_) { nM = M / BM; nN = N / BM; nwg = nM * nN; G = G_; c = c_; }
    __host__ __device__ bool next(int i, Unit& u) const {
        const long L = (long)i * G + c; if (L >= nwg) return false;
        int wgid = (int)L; { const int q = nwg / NXCD, r = nwg % NXCD, xcd = wgid % NXCD, off = wgid / NXCD; wgid = (xcd < r ? xcd * (q + 1) : r * (q + 1) + (xcd - r) * q) + off; }
        const int nig = WGM * nN, gid = wgid / nig, fm = gid * WGM, gsz = (nM - fm) < WGM ? (nM - fm) : WGM;
        u.pm = fm + ((wgid % nig) % gsz); u.pn = (wgid % nig) / gsz; return true;
    }
    __device__ __forceinline__ void a_ready(const Unit&) const {}
    __device__ __forceinline__ void done(const Unit&) const {}
};

__device__ __forceinline__ unsigned cvt_pk_bf16(float lo, float hi) { unsigned r; asm volatile("v_cvt_pk_bf16_f32 %0, %1, %2" : "=v"(r) : "v"(lo), "v"(hi)); return r; }
typedef float f32x2 __attribute__((ext_vector_type(2)));
__device__ __forceinline__ float sigm(float x) { return __builtin_amdgcn_rcpf(1.0f + __expf(-x)); }
__device__ __forceinline__ float bf_lo(unsigned w) { return __uint_as_float(w << 16); }
__device__ __forceinline__ float bf_hi(unsigned w) { return __uint_as_float(w & 0xffff0000u); }
__device__ __forceinline__ u32x4 pack8(const f32x4& v0, const f32x4& v1) { u32x4 w; w.x = cvt_pk_bf16(v0[0], v0[1]); w.y = cvt_pk_bf16(v0[2], v0[3]); w.z = cvt_pk_bf16(v1[0], v1[1]); w.w = cvt_pk_bf16(v1[2], v1[3]); return w; }

struct EpiF32 {
    static constexpr bool PERM = false, AFTER_DRAIN = false;
    float* C; int ldc;
    __device__ __forceinline__ void operator()(const f32x4 (&acc)[2][2][4][2], const Unit& u, int wr, int wc, int fr, int fq) const {
        const int row0 = u.pm * BM + wr * 64 + fr, col0 = u.pn * BM + wc * 32 + 4 * fq;
#pragma unroll
        for (int ai = 0; ai < 2; ++ai)
#pragma unroll
            for (int m = 0; m < 4; ++m) { float* rowp = C + (size_t)(row0 + ai * HALF + m * 16) * ldc + col0;
#pragma unroll
                for (int bj = 0; bj < 2; ++bj)
#pragma unroll
                    for (int n = 0; n < 2; ++n) *(f32x4*)(rowp + bj * HALF + n * 16) = acc[ai][bj][m][n]; }
    }
};
struct EpiRoute {
    static constexpr bool PERM = true, AFTER_DRAIN = false;
    bf16_t *poolu, *s5u, *q, *qi, *kvx, *gates;
    __device__ __forceinline__ void operator()(const f32x4 (&acc)[2][2][4][2], const Unit& u, int wr, int wc, int fr, int fq) const {
        const int row0 = u.pm * BM + wr * 64 + fr; const int pn = u.pn;
        bf16_t* base; int ld, colt, mode = 0;
        if (pn < 2) { base = poolu; ld = 512; colt = pn * 256; }
        else if (pn < 4) { base = s5u; ld = 512; colt = (pn - 2) * 256; }
        else if (pn < 8) { base = q; ld = 1024; colt = (pn - 4) * 256; mode = 2; }
        else if (pn < 10) { base = qi; ld = 512; colt = (pn - 8) * 256; }
        else if (pn == 10) { base = kvx; ld = 256; colt = 0; }
        else { base = gates; ld = 3072; colt = (pn - 11) * 256; mode = 1; }
        const int col0 = colt + wc * 32 + 8 * fq;
#pragma unroll
        for (int ai = 0; ai < 2; ++ai)
#pragma unroll
            for (int m = 0; m < 4; ++m) { bf16_t* rowp = base + (size_t)(row0 + ai * HALF + m * 16) * ld + col0;
#pragma unroll
                for (int bj = 0; bj < 2; ++bj) { f32x4 v0 = acc[ai][bj][m][0], v1 = acc[ai][bj][m][1];
                    if (mode == 1) {
#pragma unroll
                        for (int j = 0; j < 4; ++j) { v0[j] = sigm(v0[j]); v1[j] = sigm(v1[j]); } }
                    else if (mode == 2) { v0 = v0 * 0.125f; v1 = v1 * 0.125f; }
                    *(u32x4*)(rowp + bj * HALF) = pack8(v0, v1); } }
    }
};
struct EpiGlu {
    static constexpr bool PERM = true, AFTER_DRAIN = false;
    bf16_t* merged; const bf16_t* gates;
    __device__ __forceinline__ void operator()(const f32x4 (&acc)[2][2][4][2], const Unit& u, int wr, int wc, int fr, int fq) const {
        const int row0 = u.pm * BM + wr * 64 + fr, col0 = u.pn * HALF + wc * 32 + 8 * fq;
#pragma unroll
        for (int ai = 0; ai < 2; ++ai)
#pragma unroll
            for (int m = 0; m < 4; ++m) { const size_t row = (size_t)(row0 + ai * HALF + m * 16);
                const u32x4 g = *(const u32x4*)(gates + row * 3072 + 2048 + col0);
                f32x4 a0 = acc[ai][0][m][0], a1 = acc[ai][0][m][1]; const f32x4 s0 = acc[ai][1][m][0], s1 = acc[ai][1][m][1];
#pragma unroll
                for (int j = 0; j < 4; ++j) { a0[j] *= sigm(s0[j]); a1[j] *= sigm(s1[j]); }
                a0[0] *= bf_lo(g.x); a0[1] *= bf_hi(g.x); a0[2] *= bf_lo(g.y); a0[3] *= bf_hi(g.y);
                a1[0] *= bf_lo(g.z); a1[1] *= bf_hi(g.z); a1[2] *= bf_lo(g.w); a1[3] *= bf_hi(g.w);
                *(u32x4*)(merged + row * 1024 + col0) = pack8(a0, a1);
                asm volatile("" ::: "memory"); }
    }
};
template <int GOFF> struct EpiAccum {
    static constexpr bool PERM = true, AFTER_DRAIN = false;
    bf16_t* merged; const bf16_t* gates;
    __device__ __forceinline__ void operator()(const f32x4 (&acc)[2][2][4][2], const Unit& u, int wr, int wc, int fr, int fq) const {
        const int row0 = u.pm * BM + wr * 64 + fr, col0 = u.pn * BM + wc * 32 + 8 * fq;
#pragma unroll
        for (int ai = 0; ai < 2; ++ai)
#pragma unroll
            for (int m = 0; m < 4; ++m) { const size_t row = (size_t)(row0 + ai * HALF + m * 16);
#pragma unroll
                for (int bj = 0; bj < 2; ++bj) { const int c = col0 + bj * HALF;
                    const u32x4 g = *(const u32x4*)(gates + row * 3072 + GOFF + c); const u32x4 o = *(const u32x4*)(merged + row * 1024 + c);
                    f32x4 a0 = acc[ai][bj][m][0], a1 = acc[ai][bj][m][1];
                    a0[0] = a0[0] * bf_lo(g.x) + bf_lo(o.x); a0[1] = a0[1] * bf_hi(g.x) + bf_hi(o.x); a0[2] = a0[2] * bf_lo(g.y) + bf_lo(o.y); a0[3] = a0[3] * bf_hi(g.y) + bf_hi(o.y);
                    a1[0] = a1[0] * bf_lo(g.z) + bf_lo(o.z); a1[1] = a1[1] * bf_hi(g.z) + bf_hi(o.z); a1[2] = a1[2] * bf_lo(g.w) + bf_lo(o.w); a1[3] = a1[3] * bf_hi(g.w) + bf_hi(o.w);
                    *(u32x4*)(merged + row * 1024 + c) = pack8(a0, a1); }
                asm volatile("" ::: "memory"); }
    }
};
struct EpiSwiglu {
    static constexpr bool PERM = true, AFTER_DRAIN = false;
    bf16_t* hid; int ldh;
    __device__ __forceinline__ void operator()(const f32x4 (&acc)[2][2][4][2], const Unit& u, int wr, int wc, int fr, int fq) const {
        const int row0 = u.pm * BM + wr * 64 + fr, col0 = u.pn * HALF + wc * 32 + 8 * fq;
#pragma unroll
        for (int ai = 0; ai < 2; ++ai)
#pragma unroll
            for (int m = 0; m < 4; ++m) { const size_t row = (size_t)(row0 + ai * HALF + m * 16);
                f32x4 g0 = acc[ai][0][m][0], g1 = acc[ai][0][m][1]; const f32x4 u0 = acc[ai][1][m][0], u1 = acc[ai][1][m][1];
#pragma unroll
                for (int j = 0; j < 4; ++j) { g0[j] = g0[j] * sigm(g0[j]) * u0[j]; g1[j] = g1[j] * sigm(g1[j]) * u1[j]; }
                *(u32x4*)(hid + row * ldh + col0) = pack8(g0, g1); }
    }
};
struct PairOrder {
    StaticOrder base;
    __device__ bool next(int i, Unit& u) const { Unit b; if (!base.next(i >> 1, b)) return false; u.pm = b.pm; u.pn = 2 * b.pn + (i & 1); return true; }
    __device__ __forceinline__ void a_ready(const Unit&) const {}
    __device__ __forceinline__ void done(const Unit&) const {}
};

template <class Epi, class Sched, bool ALIGN_EPI = false, bool SP2 = false>
__device__ __forceinline__ void gemm_phase(PG8_LAS unsigned char* lds, const Gemm g, const Sched& S, const Epi& E) {
    int tid_ = threadIdx.x; asm volatile("" : "+v"(tid_));
    const int tid = tid_, wid = __builtin_amdgcn_readfirstlane(tid >> 6), lane = tid & 63, wr = wid >> 2, wc = wid & 3, fr = lane & 15, fq = lane >> 4;
    const int K = g.K, nt = K / BK;
    unsigned voffA[2], voffB[2];
#pragma unroll
    for (int i = 0; i < 2; ++i) { int R, C; stage_rc(tid * 16 + i * 8192, R, C); const int Rb = Epi::PERM ? ((R & ~31) + perm32(R & 31)) : R;
        voffA[i] = (unsigned)(R * K + C) * 2u; voffB[i] = (unsigned)(Rb * K + C) * 2u; }
    const size_t kstep = (size_t)(BK * 2);
    const size_t hstep = (size_t)HALF * K * 2;
    const size_t tstep = 2 * hstep;
    const unsigned ldsw = (unsigned)wid * 1024u;
    const int aoff = lds_byte(wr * 64 + fr, fq * 8), boff = lds_byte(wc * 32 + fr, fq * 8);
#define PG8_SA(b, h) (((b) * 2 + (h)) * HTB)
#define PG8_SB(b, h) ((4 + (b) * 2 + (h)) * HTB)
#define PG8_STAGE(bufoff, gbase, voff) do { _Pragma("unroll") for (int _i = 0; _i < 2; ++_i) \
        __builtin_amdgcn_global_load_lds((const unsigned*)((const char*)(gbase) + (voff)[_i]), (PG8_LAS unsigned*)(lds + (bufoff) + ldsw + _i * 8192), 16, 0, 0); } while (0)
#define PG8_LDA(dst, b, h) do { _Pragma("unroll") for (int m = 0; m < 4; ++m) _Pragma("unroll") for (int k = 0; k < 2; ++k) dst[m][k] = *(const PG8_LAS bf16x8*)(lds + PG8_SA(b, h) + aoff + m * 2048 + k * 1024); } while (0)
#define PG8_LDB(dst, b, h) do { _Pragma("unroll") for (int n = 0; n < 2; ++n) _Pragma("unroll") for (int k = 0; k < 2; ++k) dst[n][k] = *(const PG8_LAS bf16x8*)(lds + PG8_SB(b, h) + boff + n * 2048 + k * 1024); } while (0)
#define PG8_MMA(ai, bj, At, Bt) do { __builtin_amdgcn_s_setprio(1); _Pragma("unroll") for (int m = 0; m < 4; ++m) _Pragma("unroll") for (int n = 0; n < 2; ++n) _Pragma("unroll") for (int k = 0; k < 2; ++k) \
        acc[ai][bj][m][n] = __builtin_amdgcn_mfma_f32_16x16x32_bf16(Bt[n][k], At[m][k], acc[ai][bj][m][n], 0, 0, 0); __builtin_amdgcn_s_setprio(0); } while (0)
#define PG8_WAIT_V(n) asm volatile("s_waitcnt vmcnt(" #n ")" ::: "memory")
#define PG8_WAIT_L(n) asm volatile("s_waitcnt lgkmcnt(" #n ")" ::: "memory")
#define PG8_BAR __builtin_amdgcn_s_barrier()
#define PG8_SCHED __builtin_amdgcn_sched_barrier(0)
    Unit cur, nxt; int ui = 0;
    if (!S.next(0, cur)) return;
    f32x4 acc[2][2][4][2];
#pragma unroll
    for (int a = 0; a < 2; ++a)
#pragma unroll
        for (int b = 0; b < 2; ++b)
#pragma unroll
            for (int m = 0; m < 4; ++m)
#pragma unroll
                for (int n = 0; n < 2; ++n) acc[a][b][m][n] = (f32x4){0.f, 0.f, 0.f, 0.f};
    bf16x8 At[4][2], B0[2][2], B1[2][2];
    const char* cA = (const char*)g.A + (size_t)cur.pm * tstep; const char* cB = (const char*)g.Bt + (size_t)cur.pn * tstep;
    S.a_ready(cur);
    if constexpr (SP2) {
        PG8_STAGE(PG8_SB(0, 0), cB, voffB); PG8_STAGE(PG8_SB(0, 1), cB + hstep, voffB); PG8_STAGE(PG8_SA(0, 0), cA, voffA); PG8_STAGE(PG8_SA(0, 1), cA + hstep, voffA);
        if (wr == 1) PG8_BAR;
        PG8_WAIT_V(2); PG8_BAR;
        PG8_STAGE(PG8_SB(1, 0), cB + kstep, voffB); PG8_STAGE(PG8_SA(1, 0), cA + kstep, voffA); PG8_STAGE(PG8_SB(1, 1), cB + hstep + kstep, voffB);
        PG8_WAIT_V(6); PG8_BAR;
    } else {
        PG8_STAGE(PG8_SB(0, 0), cB, voffB); PG8_STAGE(PG8_SA(0, 0), cA, voffA); PG8_STAGE(PG8_SB(0, 1), cB + hstep, voffB); PG8_STAGE(PG8_SA(0, 1), cA + hstep, voffA);
        if (wr == 1) PG8_BAR;
        PG8_WAIT_V(4); PG8_BAR;
        PG8_STAGE(PG8_SB(1, 0), cB + kstep, voffB); PG8_STAGE(PG8_SA(1, 0), cA + kstep, voffA); PG8_STAGE(PG8_SB(1, 1), cB + hstep + kstep, voffB);
        PG8_WAIT_V(6); PG8_BAR;
    }
    for (;;) {
        const bool has_next = S.next(ui + 1, nxt);
        const char* nA = has_next ? (const char*)g.A + (size_t)nxt.pm * tstep : cA; const char* nB = has_next ? (const char*)g.Bt + (size_t)nxt.pn * tstep : cB;
        for (int t = 0; t < nt; t += 2) {
            const bool last = (t == nt - 2);
            const char* a1 = cA + (size_t)(t + 1) * kstep;
            const char* a2 = last ? nA : cA + (size_t)(t + 2) * kstep; const char* b2 = last ? nB : cB + (size_t)(t + 2) * kstep;
            const char* a3 = a2 + kstep; const char* b3 = b2 + kstep;
            if (last && has_next) S.a_ready(nxt);
            if constexpr (SP2) {
            PG8_LDB(B0, 0, 0); PG8_LDB(B1, 0, 1); PG8_SCHED; PG8_LDA(At, 0, 0); PG8_STAGE(PG8_SA(1, 1), a1 + hstep, voffA);
            PG8_WAIT_V(8); PG8_WAIT_L(0); PG8_BAR; PG8_MMA(0, 0, At, B0); PG8_MMA(0, 1, At, B1); PG8_BAR; PG8_SCHED;
            PG8_LDA(At, 0, 1); PG8_STAGE(PG8_SB(0, 0), b2, voffB); PG8_STAGE(PG8_SB(0, 1), b2 + hstep, voffB); PG8_STAGE(PG8_SA(0, 0), a2, voffA);
            PG8_WAIT_V(8); PG8_WAIT_L(0); PG8_BAR; PG8_MMA(1, 0, At, B0); PG8_MMA(1, 1, At, B1); PG8_BAR; PG8_SCHED;
            PG8_LDB(B0, 1, 0); PG8_LDB(B1, 1, 1); PG8_SCHED; PG8_LDA(At, 1, 0); PG8_STAGE(PG8_SA(0, 1), a2 + hstep, voffA);
            PG8_WAIT_V(8); PG8_WAIT_L(0); PG8_BAR; PG8_MMA(0, 0, At, B0); PG8_MMA(0, 1, At, B1); PG8_BAR; PG8_SCHED;
            PG8_LDA(At, 1, 1); PG8_STAGE(PG8_SB(1, 0), b3, voffB); PG8_STAGE(PG8_SB(1, 1), b3 + hstep, voffB); PG8_STAGE(PG8_SA(1, 0), a3, voffA);
            PG8_WAIT_V(8); PG8_WAIT_L(0); PG8_BAR; PG8_MMA(1, 0, At, B0); PG8_MMA(1, 1, At, B1); PG8_BAR; PG8_SCHED;
            } else {
            PG8_LDB(B0, 0, 0); PG8_SCHED; PG8_LDA(At, 0, 0); PG8_STAGE(PG8_SA(1, 1), a1 + hstep, voffA);
            PG8_WAIT_L(8); PG8_BAR; PG8_WAIT_L(0); PG8_MMA(0, 0, At, B0); PG8_BAR; PG8_SCHED;
            PG8_LDB(B1, 0, 1); PG8_STAGE(PG8_SB(0, 0), b2, voffB);
            PG8_BAR; PG8_WAIT_L(0); PG8_MMA(0, 1, At, B1); PG8_BAR;
            PG8_LDA(At, 0, 1); PG8_STAGE(PG8_SA(0, 0), a2, voffA);
            PG8_BAR; PG8_WAIT_L(0); PG8_MMA(1, 0, At, B0); PG8_BAR; PG8_SCHED;
            PG8_STAGE(PG8_SB(0, 1), b2 + hstep, voffB);
            PG8_WAIT_V(6); PG8_BAR; PG8_MMA(1, 1, At, B1); PG8_BAR;
            PG8_LDB(B0, 1, 0); PG8_SCHED; PG8_LDA(At, 1, 0); PG8_STAGE(PG8_SA(0, 1), a2 + hstep, voffA);
            PG8_WAIT_L(8); PG8_BAR; PG8_WAIT_L(0); PG8_MMA(0, 0, At, B0); PG8_BAR; PG8_SCHED;
            PG8_LDB(B1, 1, 1); PG8_STAGE(PG8_SB(1, 0), b3, voffB);
            PG8_BAR; PG8_WAIT_L(0); PG8_MMA(0, 1, At, B1); PG8_BAR;
            PG8_LDA(At, 1, 1); PG8_STAGE(PG8_SA(1, 0), a3, voffA);
            PG8_BAR; PG8_WAIT_L(0); PG8_MMA(1, 0, At, B0); PG8_BAR; PG8_SCHED;
            PG8_STAGE(PG8_SB(1, 1), b3 + hstep, voffB);
            PG8_WAIT_V(6); PG8_BAR; PG8_MMA(1, 1, At, B1); PG8_BAR;
            }
        }
        if constexpr (ALIGN_EPI) { if (wr == 0) PG8_BAR; }
        if constexpr (!Epi::AFTER_DRAIN) { E(acc, cur, wr, wc, fr, fq); S.done(cur); }
        if (!has_next) break;
#pragma unroll
        for (int a = 0; a < 2; ++a)
#pragma unroll
            for (int b = 0; b < 2; ++b)
#pragma unroll
                for (int m = 0; m < 4; ++m)
#pragma unroll
                    for (int n = 0; n < 2; ++n) acc[a][b][m][n] = (f32x4){0.f, 0.f, 0.f, 0.f};
        cur = nxt; cA = nA; cB = nB; ++ui;
        if constexpr (ALIGN_EPI) { if (wr == 1) PG8_BAR; }
    }
    PG8_WAIT_V(0);
    if constexpr (!ALIGN_EPI) { if (wr == 0) PG8_BAR; }
    PG8_BAR;
    if constexpr (Epi::AFTER_DRAIN) { E.fused(acc, cur, wr, wc, fr, fq, lds, wid, lane); S.done(cur); }
#undef PG8_SA
#undef PG8_SB
#undef PG8_STAGE
#undef PG8_LDA
#undef PG8_LDB
#undef PG8_MMA
#undef PG8_WAIT_V
#undef PG8_WAIT_L
#undef PG8_BAR
#undef PG8_SCHED
}
}

constexpr int NWAVES = 8;
constexpr int BATCH = 8, SEQ = 2048, D = 1024, M = BATCH * SEQ;
constexpr int INW = 5832, N1P = 5888, FF = 2816, NLAYER = 2;
constexpr float NORM_EPS = 1e-6f;
constexpr size_t MiB = 1u << 20;
constexpr size_t WS_CTL = 0, CTL_ZERO_BYTES = 1 * MiB;
constexpr size_t WS_WINT = 1 * MiB;
constexpr size_t WS_ATTNOT = WS_WINT + (size_t)N1P * D * 2;
constexpr size_t WS_POOLET = WS_ATTNOT + 2 * MiB;
constexpr size_t WS_GLUT = WS_POOLET + 1 * MiB;
constexpr size_t WS_WOUTT = WS_GLUT + 2 * MiB;
constexpr size_t WS_S5T = WS_WOUTT + 2 * MiB;
constexpr size_t WS_S5P = WS_S5T + 4 * MiB;
constexpr size_t WS_S5Q = WS_S5P + 2 * MiB;
constexpr size_t WS_S5A = WS_S5Q + 2 * MiB;
constexpr size_t WS_BIAS = WS_S5A + 65536;
static_assert(WS_BIAS + 8192 <= 29 * MiB, "weights region");
constexpr size_t WS_HB = 29 * MiB;
constexpr size_t WS_DP = WS_HB, WS_ZB = WS_HB + 16 * MiB;
constexpr size_t WS_POOLU = 61 * MiB, WS_S5U = 77 * MiB;
constexpr size_t WS_MERGED = WS_POOLU;
constexpr size_t WS_FFNINT = WS_POOLU, WS_FFNOUTT = WS_POOLU + 11 * MiB;
constexpr size_t WS_Q = 93 * MiB, WS_QI = 125 * MiB, WS_KVX = 141 * MiB, WS_GATES = 149 * MiB;
constexpr size_t WS_F = WS_Q;
constexpr size_t WS_HID = 157 * MiB;
constexpr size_t WS_END = 245 * MiB;
static_assert(WS_FFNOUTT + (size_t)D * FF * 2 <= WS_Q && WS_HID + (size_t)M * FF * 2 <= WS_END && WS_F + (size_t)M * D * 4 <= WS_HID, "d_ws map");
constexpr int CW_BAR = 4096;
constexpr int RING_OFF = 0, RING_BYTES = 131072;
constexpr int LDSCTL_OFF = RING_BYTES, MISC_OFF = LDSCTL_OFF + 320;
constexpr int LDS_BYTES = 147456;
constexpr int NPHASE = 1 + 8 * NLAYER;

#define GAS __attribute__((address_space(1)))
#define LAS __attribute__((address_space(3)))
typedef unsigned short bf16;
typedef unsigned v4u __attribute__((ext_vector_type(4)));
typedef float f32x4 __attribute__((ext_vector_type(4)));
typedef short bf16x8 __attribute__((ext_vector_type(8)));
typedef GAS unsigned gu32;
typedef GAS unsigned long long gu64;
#define RLX_AGENT __ATOMIC_RELAXED, __HIP_MEMORY_SCOPE_AGENT
#define LDS_WAIT() asm volatile("s_waitcnt lgkmcnt(0)" ::: "memory")
#define VM_WAIT() asm volatile("s_waitcnt vmcnt(0)" ::: "memory")
__device__ __forceinline__ unsigned long long rt() { return __builtin_amdgcn_s_memrealtime(); }
__device__ __forceinline__ unsigned f2bf(float f) { unsigned u = __builtin_bit_cast(unsigned, f); return (u + 0x7fffu + ((u >> 16) & 1u)) >> 16; }
__device__ __forceinline__ unsigned pk2(float lo, float hi) { return f2bf(lo) | (f2bf(hi) << 16); }
#define XB_TMO      128
#define XB_XCNT(j)  (256  + 64 * (j))
#define XB_XSUB(j)  (1280 + 64 * (j))
#define XB_XGEN(j)  (2304 + 64 * (j))
#define XB_TOP      3328
#define XB_TOPGEN   3392
#define XCD_BAR_WORDS 3456
#define XB_SPIN_CAP (1u << 18)

__device__ __forceinline__ unsigned xb_ld(unsigned* p)              { return __hip_atomic_load(p, __ATOMIC_RELAXED, __HIP_MEMORY_SCOPE_AGENT); }
__device__ __forceinline__ unsigned xb_add(unsigned* p, unsigned v) { return __hip_atomic_fetch_add(p, v, __ATOMIC_RELAXED, __HIP_MEMORY_SCOPE_AGENT); }
__device__ __forceinline__ unsigned xb_xcc_id() { return (unsigned)__builtin_amdgcn_s_getreg((3 << 11) | 20) & 0xFu; }
#define XB_SPIN(cond, bar) do { unsigned _sp = 0; while (cond) { __builtin_amdgcn_s_sleep(1); \
    if ((++_sp & 255u) == 0u) { if (xb_ld(&(bar)[XB_TMO])) break; if (_sp > XB_SPIN_CAP) { atomicAdd(&(bar)[XB_TMO], 1u); break; } } } } while (0)

struct XcdBarrier {
    unsigned* bar; unsigned x;
    volatile LAS unsigned* st;
};

__device__ __forceinline__ XcdBarrier xcd_barrier_post(unsigned* bar, volatile LAS unsigned* st) {
    XcdBarrier b; b.bar = bar; b.x = xb_xcc_id(); b.st = st;
    if (threadIdx.x == 0) (void)xb_add(&bar[XB_XCNT(b.x)], 1u);
    return b;
}
__device__ __forceinline__ void xcd_barrier_complete(unsigned* bar, unsigned x, unsigned& nloc, unsigned& nx) {
    const unsigned G = gridDim.x * gridDim.y * gridDim.z;
    unsigned sum, cnt, mine, sp = 0u;
    for (;;) {
        sum = 0u; cnt = 0u; mine = 0u;
#pragma unroll
        for (unsigned j = 0; j < 16; ++j) { const unsigned c = xb_ld(&bar[XB_XCNT(j)]); sum += c; cnt += (c > 0u) ? 1u : 0u; mine = (j == x) ? c : mine; }
        if (sum == G) break;
        __builtin_amdgcn_s_sleep(1);
        if ((++sp & 255u) == 0u) { if (xb_ld(&bar[XB_TMO])) break; if (sp > XB_SPIN_CAP) { atomicAdd(&bar[XB_TMO], 1u); break; } }
    }
    nloc = mine > 0u ? mine : 1u; nx = cnt > 0u ? cnt : 1u;
}

__device__ __forceinline__ void xcd_barrier(const XcdBarrier& b) {
    asm volatile("s_waitcnt vmcnt(0)" ::: "memory");
    __syncthreads();
    if (threadIdx.x == 0) {
        unsigned* bar = b.bar;
        __builtin_amdgcn_s_waitcnt(0);
        unsigned nloc = b.st[0], nx = b.st[1];
        if (nloc == 0u) { xcd_barrier_complete(bar, b.x, nloc, nx); b.st[0] = nloc; b.st[1] = nx; }
        const unsigned old = xb_add(&bar[XB_XSUB(b.x)], 1u);
        const unsigned gen = old / nloc;
        if (old + 1u == (gen + 1u) * nloc) {
            __builtin_amdgcn_fence(__ATOMIC_RELEASE, "agent");
            asm volatile("s_waitcnt vmcnt(0)" ::: "memory");
            const unsigned og = xb_add(&bar[XB_TOP], 1u);
            const unsigned tg = og / nx;
            if (og + 1u == (tg + 1u) * nx) xb_add(&bar[XB_TOPGEN], 1u);
            else XB_SPIN(xb_ld(&bar[XB_TOPGEN]) == tg, bar);
            __builtin_amdgcn_fence(__ATOMIC_ACQUIRE, "agent");
            xb_add(&bar[XB_XGEN(b.x)], 1u);
            asm volatile("s_waitcnt vmcnt(0)" ::: "memory");
        } else {
            XB_SPIN(xb_ld(&bar[XB_XGEN(b.x)]) == gen, bar);
            __builtin_amdgcn_fence(__ATOMIC_ACQUIRE, "agent");
            asm volatile("s_waitcnt vmcnt(0)" ::: "memory");
        }
    }
    __syncthreads();
}

typedef short s16x4 __attribute__((ext_vector_type(4)));
typedef short v4i16_t __attribute__((ext_vector_type(4)));
typedef unsigned short u16x4 __attribute__((ext_vector_type(4)));
typedef unsigned v2u __attribute__((ext_vector_type(2)));
typedef float f32x2v __attribute__((ext_vector_type(2)));
#define DI __device__ __forceinline__
struct Frame {
    LAS unsigned char* lds;
    int tid, lane, wave, G;
};
DI float wave_sum(float v) {
#pragma unroll
    for (int o = 1; o < 64; o <<= 1) v += __shfl_xor(v, o);
    return v;
}
DI bf16x8 ldg16(const bf16* p) { return *(const GAS bf16x8*)p; }
DI bf16x8 ldg16o(const bf16* ub, unsigned off) { return *(const GAS bf16x8*)((const GAS unsigned char*)ub + off); }
DI v4u ldg16u(const bf16* ub, unsigned off) { return *(const GAS v4u*)((const GAS unsigned char*)ub + off); }
DI float bf2f(bf16 b) { return __uint_as_float(((unsigned)b) << 16); }
DI float bflo(unsigned w) { return __uint_as_float(w << 16); }
DI float bfhi(unsigned w) { return __uint_as_float(w & 0xffff0000u); }
#define MFMA16(a, b, c) __builtin_amdgcn_mfma_f32_16x16x32_bf16((a), (b), (c), 0, 0, 0)

struct MapId { DI int operator()(int n) const { return n; } };
struct MapWin { DI int operator()(int n) const {
    if (n < 512) return n;
    if (n < 1536) return n + 512;
    if (n < 1600) return n - 1536 + 2560;
    if (n < 1664) return n - 1600 + 2624;
    if (n < 2176) return n - 1664 + 2048;
    if (n < 2240) return n - 2176 + 2688;
    if (n < 2248) return n - 2240 + 2752;
    if (n < 2760) return n - 2248 + 512;
    return n - 2760 + 2816; } };
struct MapIl { int half; DI int operator()(int n) const { const int hi = n >= half ? 1 : 0, m = n - hi * half; return (m >> 7) * 256 + hi * 128 + (m & 127); } };
template <class Map> DI void transpose_item(const float* W, int K, int Ns, bf16* WT, LAS float* scr, int item, int lane, const Map& map) {
    const int nblk = (Ns + 31) / 32, kb = item / nblk, nb = item % nblk, k0 = 64 * kb, n0 = 32 * nb;
    const int nl = n0 + (lane & 31);
#pragma unroll 8
    for (int i = 0; i < 32; ++i) { const int kk = 2 * i + (lane >> 5); scr[kk * 33 + (lane & 31)] = nl < Ns ? W[(size_t)(k0 + kk) * Ns + nl] : 0.f; }
    LDS_WAIT(); asm volatile("" ::: "memory");
    const int c = lane & 7;
#pragma unroll
    for (int j = 0; j < 4; ++j) { const int nn = (lane >> 3) + 8 * j; const LAS float* s = scr + (8 * c) * 33 + nn;
        if (n0 + nn < Ns) { const int dr = map(n0 + nn);
            v4u o; o.x = pk2(s[0 * 33], s[1 * 33]); o.y = pk2(s[2 * 33], s[3 * 33]); o.z = pk2(s[4 * 33], s[5 * 33]); o.w = pk2(s[6 * 33], s[7 * 33]);
            *(GAS v4u*)(WT + (size_t)dr * K + k0 + 8 * c) = o; } }
    LDS_WAIT(); asm volatile("" ::: "memory");
}
struct In {
    const float *x, *n_mix_pre, *n_mix_post, *n_ffn_pre, *n_ffn_post, *w_in, *pool_mix_w, *pool_scale, *pool_out_w, *attn_out_w, *rel_bias, *lam_re, *lam_im, *log_dt,
                *b_re, *b_im, *c_re, *c_im, *s5_d, *glu_w, *w_out, *ffn_w_in, *ffn_w_out;
};
struct Args { In in; float* out; unsigned char* ws; int ph_lo, ph_hi; };
typedef const __attribute__((address_space(4))) Args* KArgs;
DI KArgs kargs() { KArgs p = (KArgs)__builtin_amdgcn_kernarg_segment_ptr(); asm volatile("" : "+s"(p)); return p; }
template <class T> DI T* opq(T* p) { asm volatile("" : "+s"(p)); return p; }
DI int opqv(int v) { asm volatile("" : "+v"(v)); return v; }

DI void convert_A(Frame& F, KArgs A, unsigned char* ws, int l) {
    LAS float* scr = (LAS float*)(F.lds + RING_OFF + F.wave * 16384);
    const int gw = blockIdx.x * NWAVES + F.wave, NGW = F.G * NWAVES;
    const int gt = blockIdx.x * (NWAVES * 64) + F.tid, NGT = F.G * NWAVES * 64;
    bf16* WINT = (bf16*)(ws + WS_WINT); bf16* ATTNOT = (bf16*)(ws + WS_ATTNOT); bf16* POOLET = (bf16*)(ws + WS_POOLET); bf16* GLUT = (bf16*)(ws + WS_GLUT); bf16* WOUTT = (bf16*)(ws + WS_WOUTT);
    constexpr int I_WIN = (D / 64) * ((INW + 31) / 32), I_SQ = (D / 64) * (D / 32), I_GLU = (512 / 64) * (2048 / 32);
    constexpr int NITEMS = I_WIN + 2 * I_SQ + I_GLU;
    for (int it = gw; it < NITEMS; it += NGW) {
        int r = it;
        if (r < I_WIN) { transpose_item(A->in.w_in + (size_t)l * D * INW, D, INW, WINT, scr, r, F.lane, MapWin{}); continue; } r -= I_WIN;
        if (r < I_SQ) { transpose_item(A->in.attn_out_w + (size_t)l * D * D, D, D, ATTNOT, scr, r, F.lane, MapId{}); continue; } r -= I_SQ;
        if (r < I_SQ) { transpose_item(A->in.w_out + (size_t)l * D * D, D, D, WOUTT, scr, r, F.lane, MapId{}); continue; } r -= I_SQ;
        transpose_item(A->in.glu_w + (size_t)l * 512 * 2048, 512, 2048, GLUT, scr, r, F.lane, MapIl{1024});
    }
    for (int i = gt; i < 56 * D / 8; i += NGT) *(GAS v4u*)(WINT + (size_t)2760 * D + (size_t)i * 8) = (v4u){0u, 0u, 0u, 0u};
    {   const float* mw = A->in.pool_mix_w + (size_t)l * 4 * 128 * 128; const float* sc = A->in.pool_scale + (size_t)l * 512; const float* pw = A->in.pool_out_w + (size_t)l * 512 * D;
        for (int idx = gt; idx < 512 * D; idx += NGT) { const int n = idx & (D - 1), gc = idx >> 10, g = gc >> 7;
            const float* mrow = mw + (size_t)gc * 128; float s = 0.f;
            for (int d = 0; d < 128; ++d) s += mrow[d] * sc[g * 128 + d] * pw[(size_t)(g * 128 + d) * D + n];
            POOLET[(size_t)n * 512 + gc] = (bf16)f2bf(s); } }
    if (blockIdx.x == 0) { float* BT = (float*)(ws + WS_BIAS);
        for (int i = F.tid; i < 128 * 16; i += NWAVES * 64) { const int d = i >> 4, h = i & 15;
            int bk = d; if (d >= 16) { bk = 16 + (int)(logf((float)d / 16.0f) / logf(8.0f) * 16.0f); bk = bk > 31 ? 31 : bk; }
            BT[i] = A->in.rel_bias[bk * 16 + h]; } }
    {   bf16* S5T = (bf16*)(ws + WS_S5T); bf16* S5P = (bf16*)(ws + WS_S5P); bf16* S5Q = (bf16*)(ws + WS_S5Q); float* S5A = (float*)(ws + WS_S5A);
        LAS float* apr = (LAS float*)(F.lds + RING_OFF);
        LAS float* api = apr + 17 * 64;
        LAS float* bbr = api + 17 * 64;
        LAS float* bbi = bbr + 64 * 16;
        LAS float* Kt = bbi + 64 * 16;
        __syncthreads();
        for (int task = blockIdx.x; task < 256; task += F.G) { const int g = task & 31, sub = task >> 5; const int lg = l * 32 + g;
            if (F.tid < 64) { const int n = F.tid;
                const float lr = A->in.lam_re[lg * 64 + n], li = A->in.lam_im[lg * 64 + n], dt = expf(A->in.log_dt[lg]);
                const float mag = expf(lr * dt), ar = mag * cosf(li * dt), ai = mag * sinf(li * dt), den = lr * lr + li * li;
                const float cr = ((ar - 1.0f) * lr + ai * li) / den, ci = (ai * lr - (ar - 1.0f) * li) / den;
                float pr = 1.f, pi = 0.f;
                for (int t = 0; t <= 16; ++t) { apr[t * 64 + n] = pr; api[t * 64 + n] = pi; const float nr = pr * ar - pi * ai, ni = pr * ai + pi * ar; pr = nr; pi = ni; }
                for (int c = 0; c < 16; ++c) { const float br = A->in.b_re[((size_t)lg * 64 + n) * 16 + c], bi = A->in.b_im[((size_t)lg * 64 + n) * 16 + c];
                    bbr[n * 16 + c] = cr * br - ci * bi; bbi[n * 16 + c] = cr * bi + ci * br; }
                if (sub == 0) { S5A[(g * 64 + n) * 2] = apr[16 * 64 + n]; S5A[(g * 64 + n) * 2 + 1] = api[16 * 64 + n]; }
            }
            __syncthreads();
            const float* Cre = A->in.c_re + (size_t)lg * 16 * 64; const float* Cim = A->in.c_im + (size_t)lg * 16 * 64;
            for (int e = F.tid; e < 4096; e += NWAVES * 64) { const int t = e >> 8, i = (e >> 4) & 15, c = e & 15; float s = 0.f;
                for (int n = 0; n < 64; ++n) { const float Cr = Cre[i * 64 + n], Ci = Cim[i * 64 + n], pr = apr[t * 64 + n], pi = api[t * 64 + n];
                    const float er = Cr * pr - Ci * pi, ei = Cr * pi + Ci * pr; s += er * bbr[n * 16 + c] - ei * bbi[n * 16 + c]; }
                Kt[e] = s; }
            __syncthreads();
            for (int e = F.tid; e < 32 * 256; e += NWAVES * 64) { const int r = sub * 32 + (e >> 8), k = e & 255, j = r >> 4, i = r & 15, s = k >> 4, c = k & 15;
                float v = (j >= s) ? Kt[((j - s) * 16 + i) * 16 + c] : 0.f; if (j == s && i == c) v += A->in.s5_d[l * 512 + g * 16 + i];
                S5T[((size_t)g * 256 + r) * 256 + k] = (bf16)f2bf(v); }
            for (int e = F.tid; e < 16 * 256; e += NWAVES * 64) { const int row = sub * 16 + (e >> 8), k = e & 255, n = row & 63, im = row >> 6, s = k >> 4, c = k & 15;
                const float pr = apr[(15 - s) * 64 + n], pi = api[(15 - s) * 64 + n], br = bbr[n * 16 + c], bi = bbi[n * 16 + c];
                const float v = im ? (pr * bi + pi * br) : (pr * br - pi * bi);
                S5P[((size_t)g * 128 + row) * 256 + k] = (bf16)f2bf(v); }
            for (int e = F.tid; e < 32 * 128; e += NWAVES * 64) { const int r = sub * 32 + (e >> 7), k = e & 127, j = r >> 4, i = r & 15, n = k & 63, im = k >> 6;
                const float Cr = Cre[i * 64 + n], Ci = Cim[i * 64 + n], pr = apr[(j + 1) * 64 + n], pi = api[(j + 1) * 64 + n];
                const float v = im ? -(Cr * pi + Ci * pr) : (Cr * pr - Ci * pi);
                S5Q[((size_t)g * 256 + r) * 128 + k] = (bf16)f2bf(v); }
            __syncthreads();
        }
    }
}
DI void convert_B(Frame& F, KArgs A, unsigned char* ws, int l) {
    LAS float* scr = (LAS float*)(F.lds + RING_OFF + F.wave * 16384);
    const int gw = blockIdx.x * NWAVES + F.wave, NGW = F.G * NWAVES;
    bf16* FFNINT = (bf16*)(ws + WS_FFNINT); bf16* FFNOUTT = (bf16*)(ws + WS_FFNOUTT);
    constexpr int I_IN = (D / 64) * (2 * FF / 32), I_OUT = (FF / 64) * (D / 32);
    for (int it = gw; it < I_IN + I_OUT; it += NGW) {
        if (it < I_IN) transpose_item(A->in.ffn_w_in + (size_t)l * D * 2 * FF, D, 2 * FF, FFNINT, scr, it, F.lane, MapIl{FF});
        else transpose_item(A->in.ffn_w_out + (size_t)l * FF * D, FF, D, FFNOUTT, scr, it - I_IN, F.lane, MapId{});
    }
}
DI void rms_rows_to_bf16(Frame& F, const float* x, const float* g, bf16* hb) {
    const int gw = blockIdx.x * NWAVES + F.wave, NGW = F.G * NWAVES;
    f32x4 gv[4];
#pragma unroll
    for (int j = 0; j < 4; ++j) gv[j] = ((const GAS f32x4*)g)[F.lane + 64 * j];
    for (int m = gw; m < M; m += NGW) {
        const GAS f32x4* xr = (const GAS f32x4*)(x + (size_t)m * D) + F.lane; f32x4 v[4]; float s = 0.f;
#pragma unroll
        for (int j = 0; j < 4; ++j) { v[j] = xr[64 * j]; s += (v[j].x * v[j].x + v[j].y * v[j].y) + (v[j].z * v[j].z + v[j].w * v[j].w); }
        const float rstd = 1.0f / sqrtf(wave_sum(s) * (1.f / D) + NORM_EPS);
        GAS v2u* o8 = (GAS v2u*)(hb + (size_t)m * D) + F.lane;
#pragma unroll
        for (int j = 0; j < 4; ++j) { v2u o; o.x = pk2(v[j].x * rstd * gv[j].x, v[j].y * rstd * gv[j].y); o.y = pk2(v[j].z * rstd * gv[j].z, v[j].w * rstd * gv[j].w); o8[64 * j] = o; }
    }
}
DI void norm_phase(Frame& F, const float* xin, float* xout, const float* f, const float* gpost, const float* gpre, bf16* hb) {
    const int gw = blockIdx.x * NWAVES + F.wave, NGW = F.G * NWAVES;
    for (int m = gw; m < M; m += NGW) {
        const GAS f32x4* fr = (const GAS f32x4*)(f + (size_t)m * D) + F.lane; const GAS f32x4* xr = (const GAS f32x4*)(xin + (size_t)m * D) + F.lane;
        f32x4 v[4], xv[4]; float s = 0.f;
#pragma unroll
        for (int j = 0; j < 4; ++j) { v[j] = fr[64 * j]; xv[j] = xr[64 * j]; s += (v[j].x * v[j].x + v[j].y * v[j].y) + (v[j].z * v[j].z + v[j].w * v[j].w); }
        const float rstd = 1.0f / sqrtf(wave_sum(s) * (1.f / D) + NORM_EPS); float s2 = 0.f;
        GAS f32x4* xo = (GAS f32x4*)(xout + (size_t)m * D) + F.lane;
#pragma unroll
        for (int j = 0; j < 4; ++j) { const f32x4 gp = ((const GAS f32x4*)gpost)[F.lane + 64 * j]; xv[j] = xv[j] + v[j] * rstd * gp; xo[64 * j] = xv[j];
            s2 += (xv[j].x * xv[j].x + xv[j].y * xv[j].y) + (xv[j].z * xv[j].z + xv[j].w * xv[j].w); }
        if (gpre) { const float rstd2 = 1.0f / sqrtf(wave_sum(s2) * (1.f / D) + NORM_EPS);
            GAS v2u* o8 = (GAS v2u*)(hb + (size_t)m * D) + F.lane;
#pragma unroll
            for (int j = 0; j < 4; ++j) { const f32x4 gq = ((const GAS f32x4*)gpre)[F.lane + 64 * j]; v2u o; o.x = pk2(xv[j].x * rstd2 * gq.x, xv[j].y * rstd2 * gq.y); o.y = pk2(xv[j].z * rstd2 * gq.z, xv[j].w * rstd2 * gq.w); o8[64 * j] = o; } }
    }
}

DI void pool_stencil(Frame& F, const bf16* POOLU, bf16* DP) {
    const int gt = blockIdx.x * (NWAVES * 64) + F.tid, NGT = F.G * NWAVES * 64;
    for (int idx = gt; idx < M * 64; idx += NGT) {
        const int t = idx >> 6, cc = idx & 63, ch0 = cc * 8, gi = cc >> 4, w = 2 << gi, pos = t & (SEQ - 1);
        const int nw = (pos + 1) < w ? (pos + 1) : w;
        float a[8], u0[8];
#pragma unroll
        for (int j = 0; j < 8; ++j) { a[j] = 0.f; u0[j] = 0.f; }
        for (int i = 0; i < nw; ++i) { const v4u v = *(const GAS v4u*)(POOLU + (size_t)(t - i) * 512 + ch0);
            const float e[8] = {bflo(v.x), bfhi(v.x), bflo(v.y), bfhi(v.y), bflo(v.z), bfhi(v.z), bflo(v.w), bfhi(v.w)};
#pragma unroll
            for (int j = 0; j < 8; ++j) { a[j] += e[j]; if (i == 0) u0[j] = e[j]; } }
        const float inv = 1.0f / (float)nw; v4u o;
        o.x = pk2(a[0] * inv - u0[0], a[1] * inv - u0[1]); o.y = pk2(a[2] * inv - u0[2], a[3] * inv - u0[3]);
        o.z = pk2(a[4] * inv - u0[4], a[5] * inv - u0[5]); o.w = pk2(a[6] * inv - u0[6], a[7] * inv - u0[7]);
        *(GAS v4u*)(DP + (size_t)t * 512 + ch0) = o;
    }
}
DI float gelu_tanh(float y) { const float u = 0.7978845608028654f * (y + 0.044715f * y * y * y); const float th = 1.0f - 2.0f * __builtin_amdgcn_rcpf(__expf(2.0f * u) + 1.0f); return 0.5f * y * (1.0f + th); }
constexpr int S5_SLD = 129, S5_XLD = 136, S5_XOFF = 69632;
DI void s5_unit(Frame& F, int b, int g, const bf16* S5U_, const bf16* S5T_, const bf16* S5P_, const bf16* S5Q_, const float* S5A_, bf16* ZB_) {
    const bf16* S5U = opq(S5U_); const bf16* S5T = opq(S5T_); const bf16* S5P = opq(S5P_); const bf16* S5Q = opq(S5Q_); const float* S5A = opq(S5A_); bf16* ZB = opq(ZB_);
    LAS float* Ssm = (LAS float*)(F.lds + RING_OFF);
    LAS bf16* XB = (LAS bf16*)(F.lds + RING_OFF + S5_XOFF);
    const int w = F.wave, lane = opqv(F.lane), fr = lane & 15, qd = lane >> 4;
    const bf16* Tg = S5T + (size_t)g * 65536; const bf16* Pg = S5P + (size_t)g * 32768; const bf16* Qg = S5Q + (size_t)g * 32768;
    const bf16* Ub = S5U + (size_t)b * SEQ * 512 + g * 16;
    f32x4 accY[2][8], accS[8];
#pragma unroll
    for (int ct = 0; ct < 8; ++ct) { accS[ct] = (f32x4){0.f, 0.f, 0.f, 0.f}; accY[0][ct] = accS[ct]; accY[1][ct] = accS[ct]; }
#pragma unroll 1
    for (int ks = 0; ks < 8; ++ks) {
        bf16x8 bfr[8];
        const int s = 2 * ks + (qd >> 1), c0 = 8 * (qd & 1);
#pragma unroll
        for (int ct = 0; ct < 8; ++ct) bfr[ct] = ldg16o(Ub + (size_t)ct * 16 * 16 * 512, (unsigned)((fr * 16 + s) * 512 + c0) * 2u);
        const bf16x8 aP = ldg16o(Pg + (size_t)(16 * w) * 256 + 32 * ks, (unsigned)(fr * 256 + 8 * qd) * 2u);
#pragma unroll
        for (int ct = 0; ct < 8; ++ct) accS[ct] = MFMA16(aP, bfr[ct], accS[ct]);
        if (ks <= w) {
            const bf16x8 aT0 = ldg16o(Tg + (size_t)(32 * w) * 256 + 32 * ks, (unsigned)(fr * 256 + 8 * qd) * 2u), aT1 = ldg16o(Tg + (size_t)(32 * w + 16) * 256 + 32 * ks, (unsigned)(fr * 256 + 8 * qd) * 2u);
#pragma unroll
            for (int ct = 0; ct < 8; ++ct) { accY[0][ct] = MFMA16(aT0, bfr[ct], accY[0][ct]); accY[1][ct] = MFMA16(aT1, bfr[ct], accY[1][ct]); }
        }
    }
#pragma unroll
    for (int ct = 0; ct < 8; ++ct)
#pragma unroll
        for (int r = 0; r < 4; ++r) Ssm[(16 * w + 4 * qd + r) * S5_SLD + 16 * ct + fr] = accS[ct][r];
    __syncthreads();
    if (F.tid < 64) { const int n = F.tid; const float ar = S5A[(g * 64 + n) * 2], ai = S5A[(g * 64 + n) * 2 + 1]; float xr = 0.f, xi = 0.f;
        for (int c = 0; c < 128; ++c) { XB[c * S5_XLD + n] = (bf16)f2bf(xr); XB[c * S5_XLD + 64 + n] = (bf16)f2bf(xi);
            const float sr = Ssm[n * S5_SLD + c], si = Ssm[(64 + n) * S5_SLD + c];
            const float nr = ar * xr - ai * xi + sr, ni = ar * xi + ai * xr + si; xr = nr; xi = ni; } }
    __syncthreads();
#pragma unroll 1
    for (int ks = 0; ks < 4; ++ks) {
        const bf16x8 aQ0 = ldg16o(Qg + (size_t)(32 * w) * 128 + 32 * ks, (unsigned)(fr * 128 + 8 * qd) * 2u), aQ1 = ldg16o(Qg + (size_t)(32 * w + 16) * 128 + 32 * ks, (unsigned)(fr * 128 + 8 * qd) * 2u);
#pragma unroll
        for (int ct = 0; ct < 8; ++ct) { const bf16x8 bx = *(const LAS bf16x8*)(XB + (16 * ct + fr) * S5_XLD + 32 * ks + 8 * qd);
            accY[0][ct] = MFMA16(aQ0, bx, accY[0][ct]); accY[1][ct] = MFMA16(aQ1, bx, accY[1][ct]); }
    }
#pragma unroll
    for (int rt = 0; rt < 2; ++rt)
#pragma unroll
        for (int ct = 0; ct < 8; ++ct) { const int tok = (16 * ct + fr) * 16 + 2 * w + rt; const f32x4 y = accY[rt][ct];
            v2u o; o.x = pk2(gelu_tanh(y[0]), gelu_tanh(y[1])); o.y = pk2(gelu_tanh(y[2]), gelu_tanh(y[3]));
            *(GAS v2u*)(ZB + (size_t)(b * SEQ + tok) * 512 + g * 16 + 4 * qd) = o; }
    __syncthreads();
}
constexpr int AT_BIAS_OFF = 0, AT_SEL_OFF = 8192, AT_V_OFF = 24576, AT_VLD = 144  ;
DI s16x4 vtr(const LAS unsigned char* p) { return __builtin_bit_cast(s16x4, __builtin_amdgcn_ds_read_tr16_b64_v4i16((LAS v4i16_t*)p)); }
#define MEMBAR() asm volatile("" ::: "memory")
DI int row16_sum(int x) {
    x += __builtin_amdgcn_update_dpp(0, x, 0xB1, 0xF, 0xF, true);
    x += __builtin_amdgcn_update_dpp(0, x, 0x4E, 0xF, 0xF, true);
    x += __builtin_amdgcn_update_dpp(0, x, 0x141, 0xF, 0xF, true);
    x += __builtin_amdgcn_update_dpp(0, x, 0x140, 0xF, 0xF, true);
    return x; }
DI int xor16_i(int x) { return __builtin_amdgcn_ds_swizzle(x, 0x401F); }
DI float xor16_f(float x) { return __int_as_float(__builtin_amdgcn_ds_swizzle(__float_as_int(x), 0x401F)); }
DI int half32_sum(int x) { x = row16_sum(x); return x + xor16_i(x); }
DI void attn_unit(Frame& F, int b, int tile, const bf16* QI_, const bf16* KVX_, bf16* QA_, const float* BIAS_) {
    const bf16* QI = opq(QI_); const bf16* KVX = opq(KVX_); bf16* QA = opq(QA_); const float* BIAS = opq(BIAS_);
    LAS float* biasL = (LAS float*)(F.lds + RING_OFF + AT_BIAS_OFF);
    const int w = F.wave;
    LAS unsigned short* selw = (LAS unsigned short*)(F.lds + RING_OFF + AT_SEL_OFF) + w * 512;
    LAS unsigned char* kbuf = F.lds + RING_OFF + AT_V_OFF;
    for (int i = F.tid; i < 2048; i += NWAVES * 64) biasL[i] = BIAS[i];
    { LAS v4u* z = (LAS v4u*)selw; z[F.lane] = (v4u){0u, 0u, 0u, 0u}; }
    const size_t rowb = (size_t)b * SEQ;
    const int tb = tile * 16 + 2 * w;
    const int ntile = (tile * 16 + 15) / 256 + 1;
    const int nkp = 8 * ntile;
    unsigned key[64];
    int nsel = 0; unsigned theta = 0u;
#ifndef AT_PROBE
#define AT_PROBE 0
#endif
    _Pragma("unroll 1") for (int rep_abc = 0; rep_abc < (AT_PROBE == 1 ? 2 : 1); ++rep_abc) {
    {
        const int lane = opqv(F.lane), fr = lane & 15, qd = lane >> 4, tq = tb + (qd >> 1), odd = qd & 1;
        const int tid = opqv(F.tid);
        bf16x8 aQ[2];
#pragma unroll
        for (int ks = 0; ks < 2; ++ks) aQ[ks] = ldg16(QI + (rowb + tb + (fr >> 3)) * 512 + (fr & 7) * 64 + 32 * ks + 8 * qd);
        const v2u wraw = *(const GAS v2u*)(KVX + (rowb + tq) * 256 + 192 + 4 * odd);
        const float wv[4] = {bflo(wraw.x), bfhi(wraw.x), bflo(wraw.y), bfhi(wraw.y)};
        const unsigned goff = (unsigned)((tid >> 3) * 256 + (tid & 7) * 8) * 2u, loff = (unsigned)((tid >> 3) * 144 + (tid & 7) * 16);
        v4u stg[4];
        const bf16* gki = KVX + rowb * 256 + 128;
#pragma unroll
        for (int i = 0; i < 4; ++i) stg[i] = ldg16u(gki + (size_t)(64 * i) * 256, goff);
#pragma unroll
        for (int i = 0; i < 4; ++i) *(LAS v4u*)(kbuf + 64 * i * 144 + loff) = stg[i];
        __syncthreads();
        const unsigned roff = (unsigned)(fr * 144 + qd * 16);
#pragma unroll 1
        for (int kt = 0; kt < ntile; ++kt) {
            const bool more = kt + 1 < ntile;
            if (more) {
#pragma unroll
                for (int i = 0; i < 4; ++i) stg[i] = ldg16u(gki + (size_t)(256 * (kt + 1) + 64 * i) * 256, goff); }
            const LAS unsigned char* kb = kbuf + (kt & 1) * (256 * 144) + roff;
            unsigned tmp[8];
#pragma unroll
            for (int j = 0; j < 8; ++j) {
                const bf16x8 e0 = *(const LAS bf16x8*)(kb + (32 * j) * 144), e1 = *(const LAS bf16x8*)(kb + (32 * j) * 144 + 64);
                const bf16x8 o0 = *(const LAS bf16x8*)(kb + (32 * j + 16) * 144), o1 = *(const LAS bf16x8*)(kb + (32 * j + 16) * 144 + 64);
                f32x4 cE = (f32x4){0.f, 0.f, 0.f, 0.f}, cO = cE;
                cE = MFMA16(aQ[0], e0, cE); cE = MFMA16(aQ[1], e1, cE); cO = MFMA16(aQ[0], o0, cO); cO = MFMA16(aQ[1], o1, cO);
                float sE = 0.f, sO = 0.f;
#pragma unroll
                for (int r = 0; r < 4; ++r) { sE += wv[r] * fmaxf(cE[r], 0.f); sO += wv[r] * fmaxf(cO[r], 0.f); }
                sE += xor16_f(sE); sO += xor16_f(sO);
                float s = odd ? sO : sE; s += 0.0f;
                const unsigned bits = __float_as_uint(s); const unsigned sk = bits ^ ((unsigned)((int)bits >> 31) | 0x80000000u);
                tmp[j] = (256 * kt + 32 * j + 16 * odd + fr <= tq) ? sk : 0u;
            }
#define KEYCASE(c) case c: _Pragma("unroll") for (int j = 0; j < 8; ++j) key[8 * c + j] = tmp[j]; break;
            switch (kt) { KEYCASE(0) KEYCASE(1) KEYCASE(2) KEYCASE(3) KEYCASE(4) KEYCASE(5) KEYCASE(6) default: _Pragma("unroll") for (int j = 0; j < 8; ++j) key[56 + j] = tmp[j]; break; }
#undef KEYCASE
            if (more) {
#pragma unroll
                for (int i = 0; i < 4; ++i) *(LAS v4u*)(kbuf + ((kt + 1) & 1) * (256 * 144) + 64 * i * 144 + loff) = stg[i]; }
            __syncthreads();
        }
    }
    theta = 0u; bool fin = false;
#pragma unroll 1
    for (int bit = 31; bit >= 0; --bit) {
        const unsigned cand = theta | (1u << bit); int cnt = 0;
#pragma unroll
        for (int ch = 0; ch < 8; ++ch) if (ch * 8 < nkp) {
#pragma unroll
            for (int j = 0; j < 8; ++j) cnt += (key[ch * 8 + j] >= cand) ? 1 : 0; }
        cnt = half32_sum(cnt);
        if (!fin && cnt >= 256) theta = cand;
        fin = fin || (cnt == 256);
        if (__all(fin)) break;
    }
    {
        const int lane = opqv(F.lane), fr = lane & 15, qd = lane >> 4, odd = qd & 1;
        int cgt = 0;
#pragma unroll
        for (int ch = 0; ch < 8; ++ch) if (ch * 8 < nkp) {
#pragma unroll
            for (int j = 0; j < 8; ++j) cgt += (key[ch * 8 + j] > theta) ? 1 : 0; }
        cgt = half32_sum(cgt);
        const int quota = (theta == 0u) ? 0 : (256 - cgt);
        int base = 0, eqseen = 0; const unsigned below = (1u << (lane & 31)) - 1u; const int sh = 32 * (qd >> 1);
        LAS unsigned short* sl = selw + (qd >> 1) * 256;
#pragma unroll 1
        for (int ch = 0; ch * 8 < nkp; ++ch) {
            unsigned tmp[8];
#define KEYCASE(c) case c: _Pragma("unroll") for (int j = 0; j < 8; ++j) tmp[j] = key[8 * c + j]; break;
            switch (ch) { KEYCASE(0) KEYCASE(1) KEYCASE(2) KEYCASE(3) KEYCASE(4) KEYCASE(5) KEYCASE(6) default: _Pragma("unroll") for (int j = 0; j < 8; ++j) tmp[j] = key[56 + j]; break; }
#undef KEYCASE
#pragma unroll
            for (int j = 0; j < 8; ++j) {
                const bool gtk = tmp[j] > theta, eqk = (tmp[j] == theta) && (theta != 0u);
                const unsigned long long be = __ballot(eqk); const unsigned e32 = (unsigned)(be >> sh); const int pe = __popc(e32 & below);
                const bool take = gtk || (eqk && (eqseen + pe) < quota);
                const unsigned long long bt = __ballot(take); const unsigned t32 = (unsigned)(bt >> sh); const int pt = __popc(t32 & below);
                if (take) sl[base + pt] = (unsigned short)(256 * ch + 32 * j + 16 * odd + fr);
                base += __popc(t32); eqseen += __popc(e32);
            }
        }
        nsel = base;
    }
    }
#pragma unroll 1
    for (int qq2 = 0; qq2 < (AT_PROBE == 2 ? 4 : 2); ++qq2) { const int qq = qq2 & 1;
        const int lane = opqv(F.lane), fr = lane & 15, qd = lane >> 4;
        LAS unsigned char* Vs = F.lds + RING_OFF + AT_V_OFF + w * (64 * AT_VLD);
        const int t = tb + qq; const int ns = __shfl(nsel, 32 * qq);
        const LAS unsigned short* sl = selw + qq * 256;
        bf16* qrow = QA + (rowb + t) * 1024; bf16* orow = (qq2 < 2) ? qrow : (bf16*)((unsigned char*)QA + (WS_END - WS_Q)) + (size_t)(t & 2047) * 1024;
        bf16x8 bq[2];
#pragma unroll
        for (int ks = 0; ks < 2; ++ks) bq[ks] = ldg16(qrow + fr * 64 + 32 * ks + 8 * qd);
        f32x4 st[16];
#pragma unroll
        for (int blk = 0; blk < 16; ++blk) { const int kidx = sl[16 * blk + fr];
            const unsigned ko = (unsigned)(kidx * 256 + 8 * qd) * 2u; const bf16x8 a0 = ldg16o(KVX + rowb * 256, ko), a1 = ldg16o(KVX + rowb * 256 + 32, ko);
            f32x4 c = (f32x4){0.f, 0.f, 0.f, 0.f}; c = MFMA16(a0, bq[0], c); c = MFMA16(a1, bq[1], c); st[blk] = c;
            if ((blk & 7) == 7) MEMBAR(); }
        float mx = -3.0e38f;
#pragma unroll
        for (int blk = 0; blk < 16; ++blk) { const u16x4 k4 = *(const LAS u16x4*)(sl + 16 * blk + 4 * qd);
#pragma unroll
            for (int r = 0; r < 4; ++r) { int dist = t - (int)k4[r]; dist = dist < 0 ? 0 : (dist > 127 ? 127 : dist);
                float lg = st[blk][r] + biasL[dist * 16 + fr]; if (16 * blk + 4 * qd + r >= ns) lg = -1.0e30f; st[blk][r] = lg; mx = fmaxf(mx, lg); } }
        mx = fmaxf(mx, __shfl_xor(mx, 16)); mx = fmaxf(mx, __shfl_xor(mx, 32));
        float sum = 0.f;
#pragma unroll
        for (int blk = 0; blk < 16; ++blk)
#pragma unroll
            for (int r = 0; r < 4; ++r) { const float p = __expf(st[blk][r] - mx); st[blk][r] = p; sum += p; }
        sum += __shfl_xor(sum, 16); sum += __shfl_xor(sum, 32);
        const float inv = 1.0f / sum;
        f32x4 o[4];
#pragma unroll
        for (int nb = 0; nb < 4; ++nb) o[nb] = (f32x4){0.f, 0.f, 0.f, 0.f};
        v4u vv[8];
#pragma unroll
        for (int i = 0; i < 8; ++i) { const int piece = lane + 64 * i, row = piece >> 3, pc = piece & 7; const int kidx = sl[row];
            vv[i] = ldg16u(KVX + rowb * 256 + 64, (unsigned)(kidx * 256 + 8 * pc) * 2u); }
#pragma unroll
        for (int vr = 0; vr < 4; ++vr) {
#pragma unroll
            for (int i = 0; i < 8; ++i) { const int piece = lane + 64 * i, row = piece >> 3, pc = piece & 7; *(LAS v4u*)(Vs + row * AT_VLD + pc * 16) = vv[i]; }
            if (vr < 3) {
#pragma unroll
                for (int i = 0; i < 8; ++i) { const int piece = lane + 64 * i, row = piece >> 3, pc = piece & 7; const int kidx = sl[64 * (vr + 1) + row];
                    vv[i] = ldg16u(KVX + rowb * 256 + 64, (unsigned)(kidx * 256 + 8 * pc) * 2u); } }
#pragma unroll
            for (int kk = 0; kk < 2; ++kk) {
                const f32x4 p0 = st[4 * vr + 2 * kk] * inv, p1 = st[4 * vr + 2 * kk + 1] * inv;
                const v4u pw = (v4u){pk2(p0[0], p0[1]), pk2(p0[2], p0[3]), pk2(p1[0], p1[1]), pk2(p1[2], p1[3])};
                const bf16x8 pa = __builtin_bit_cast(bf16x8, pw);
                const int q4 = fr >> 2, p4 = fr & 3;
#pragma unroll
                for (int nb = 0; nb < 4; ++nb) {
                    const s16x4 lo = vtr(Vs + (32 * kk + 4 * qd + q4) * AT_VLD + (16 * nb + 4 * p4) * 2);
                    const s16x4 hi = vtr(Vs + (32 * kk + 16 + 4 * qd + q4) * AT_VLD + (16 * nb + 4 * p4) * 2);
                    const bf16x8 bv = (bf16x8){lo[0], lo[1], lo[2], lo[3], hi[0], hi[1], hi[2], hi[3]};
                    o[nb] = MFMA16(pa, bv, o[nb]);
                }
            }
        }
#pragma unroll
        for (int nb = 0; nb < 4; ++nb)
#pragma unroll
            for (int r = 0; r < 4; ++r) orow[(4 * qd + r) * 64 + 16 * nb + fr] = (bf16)f2bf(o[nb][r]);
    }
    __syncthreads();
}

#ifndef PH_MASK
#define PH_MASK 0x1ff
#endif
#define PH_ON(k) (((PH_MASK) >> (k)) & 1)
#ifndef PH_DUP
#define PH_DUP 0
#endif
#define NREP(k) ((((PH_DUP) >> (k)) & 1) ? 2 : 1)
#ifndef MK_SP2
#define MK_SP2 true
#endif
#ifndef MK_ALIGN
#define MK_ALIGN true
#endif
__global__ void __launch_bounds__(NWAVES * 64, 2) hybrid_fwd(Args args) {
    extern __shared__ __attribute__((aligned(16))) unsigned char lds[];
#define MKFRAME() Frame F; F.lds = (LAS unsigned char*)lds; F.tid = opqv((int)threadIdx.x); F.lane = F.tid & 63; F.wave = __builtin_amdgcn_readfirstlane(F.tid >> 6); F.G = gridDim.x
    const int lo = args.ph_lo, hi = args.ph_hi;
    {   KArgs A = kargs(); gu32* ctl = (gu32*)(A->ws + WS_CTL); MKFRAME();
        for (int u = F.tid; u < (LDS_BYTES - LDSCTL_OFF) / 4; u += NWAVES * 64) ((LAS unsigned*)(F.lds + LDSCTL_OFF))[u] = 0u;
        __syncthreads();
        volatile LAS unsigned* MISC = (volatile LAS unsigned*)(F.lds + MISC_OFF);
        (void)xcd_barrier_post((unsigned*)(ctl + CW_BAR), MISC + 8); }
#define IN(k) (lo <= (k) && (k) < hi)
#define BOTH(k) (IN(k) && IN((k) + 1))
#define GRID_BAR() do { KArgs Ab = kargs(); XcdBarrier bar; bar.bar = (unsigned*)((gu32*)(Ab->ws + WS_CTL) + CW_BAR); bar.x = xb_xcc_id(); bar.st = (volatile LAS unsigned*)((LAS unsigned char*)lds + MISC_OFF) + 8; xcd_barrier(bar); } while (0)
#define WSP(T, off) ((T*)(ws + (off)))

    if (PH_ON(0) && IN(0)) { KArgs A = kargs(); unsigned char* ws = A->ws; MKFRAME();
        _Pragma("unroll 1") for (int rep = 0; rep < NREP(11); ++rep) convert_A(F, A, ws, 0);
        rms_rows_to_bf16(F, A->in.x, A->in.n_mix_pre, WSP(bf16, WS_HB)); if (BOTH(0)) GRID_BAR(); }

#pragma unroll 1
    for (int l = 0; l < NLAYER; ++l) {
        const int pb = 1 + 8 * l;
        if (PH_ON(1) && IN(pb)) { KArgs A = kargs(); unsigned char* ws = A->ws; MKFRAME();
            pg8::Gemm g{WSP(bf16, WS_HB), WSP(bf16, WS_WINT), M, N1P, D}; pg8::StaticOrder S; S.init(M, N1P, F.G, (int)blockIdx.x);
            pg8::EpiRoute E{WSP(bf16, WS_POOLU), WSP(bf16, WS_S5U), WSP(bf16, WS_Q), WSP(bf16, WS_QI), WSP(bf16, WS_KVX), WSP(bf16, WS_GATES)};
            _Pragma("unroll 1") for (int rep = 0; rep < NREP(1); ++rep)
            pg8::gemm_phase<pg8::EpiRoute, pg8::StaticOrder, MK_ALIGN, MK_SP2>(F.lds + RING_OFF, g, S, E);
            if (BOTH(pb)) GRID_BAR();
        }
        if (PH_ON(2) && IN(pb + 1)) { KArgs A = kargs(); unsigned char* ws = A->ws; MKFRAME();
#ifndef NO_POOL
            _Pragma("unroll 1") for (int rep = 0; rep < NREP(9); ++rep)
            pool_stencil(F, WSP(bf16, WS_POOLU), WSP(bf16, WS_DP));
#endif
#ifndef NO_S5
            _Pragma("unroll 1") for (int rep = 0; rep < NREP(10); ++rep)
#pragma unroll 1
            for (int u = blockIdx.x; u < 256; u += F.G) s5_unit(F, u & 7, u >> 3, WSP(bf16, WS_S5U), WSP(bf16, WS_S5T), WSP(bf16, WS_S5P), WSP(bf16, WS_S5Q), WSP(float, WS_S5A), WSP(bf16, WS_ZB));
#endif
#ifndef NO_ATTN
#pragma unroll 1
            for (int u4 = 4 * blockIdx.x; u4 < 1024; u4 += 4 * F.G) {
#pragma unroll 1
                for (int h = 0; h < 4; ++h) { const int u = u4 >> 2, b = u & 7, j = u >> 3;
                    const int tile = (h & 2 ? 64 : 0) + ((h & 1) ? 63 - j : j);
                    attn_unit(F, b, tile, WSP(bf16, WS_QI), WSP(bf16, WS_KVX), WSP(bf16, WS_Q), WSP(float, WS_BIAS)); } }
#endif
            if (BOTH(pb + 1)) GRID_BAR();
        }
        if (PH_ON(3) && IN(pb + 2)) {
          _Pragma("unroll 1") for (int rep = 0; rep < NREP(3); ++rep) {
            if (rep) { VM_WAIT(); __builtin_amdgcn_fence(__ATOMIC_ACQUIRE, "agent"); VM_WAIT(); __syncthreads(); }
            { KArgs A = kargs(); unsigned char* ws = A->ws; MKFRAME();
              pg8::Gemm g{WSP(bf16, WS_ZB), WSP(bf16, WS_GLUT), M, 2048, 512}; pg8::PairOrder S; S.base.init(M, D, F.G, (int)blockIdx.x);
              pg8::EpiGlu E{WSP(bf16, WS_MERGED), WSP(bf16, WS_GATES)};
              pg8::gemm_phase<pg8::EpiGlu, pg8::PairOrder, MK_ALIGN, MK_SP2>(F.lds + RING_OFF, g, S, E); }
            VM_WAIT(); __builtin_amdgcn_fence(__ATOMIC_ACQUIRE, "agent"); VM_WAIT(); __syncthreads();
            { KArgs A = kargs(); unsigned char* ws = A->ws; MKFRAME();
              pg8::Gemm g{WSP(bf16, WS_DP), WSP(bf16, WS_POOLET), M, D, 512}; pg8::StaticOrder S; S.init(M, D, F.G, (int)blockIdx.x);
              pg8::EpiAccum<0> E{WSP(bf16, WS_MERGED), WSP(bf16, WS_GATES)};
              pg8::gemm_phase<pg8::EpiAccum<0>, pg8::StaticOrder, MK_ALIGN, MK_SP2>(F.lds + RING_OFF, g, S, E); }
            VM_WAIT(); __builtin_amdgcn_fence(__ATOMIC_ACQUIRE, "agent"); VM_WAIT(); __syncthreads();
            { KArgs A = kargs(); unsigned char* ws = A->ws; MKFRAME();
              pg8::Gemm g{WSP(bf16, WS_Q), WSP(bf16, WS_ATTNOT), M, D, D}; pg8::StaticOrder S; S.init(M, D, F.G, (int)blockIdx.x);
              pg8::EpiAccum<1024> E{WSP(bf16, WS_MERGED), WSP(bf16, WS_GATES)};
              pg8::gemm_phase<pg8::EpiAccum<1024>, pg8::StaticOrder, MK_ALIGN, MK_SP2>(F.lds + RING_OFF, g, S, E); }
          }
            if (BOTH(pb + 2)) GRID_BAR();
        }
        if (PH_ON(4) && IN(pb + 3)) { KArgs A = kargs(); unsigned char* ws = A->ws; MKFRAME();
            pg8::Gemm g{WSP(bf16, WS_MERGED), WSP(bf16, WS_WOUTT), M, D, D}; pg8::StaticOrder S; S.init(M, D, F.G, (int)blockIdx.x);
            pg8::EpiF32 E{WSP(float, WS_F), D};
            _Pragma("unroll 1") for (int rep = 0; rep < NREP(4); ++rep)
            pg8::gemm_phase<pg8::EpiF32, pg8::StaticOrder, MK_ALIGN, MK_SP2>(F.lds + RING_OFF, g, S, E);
            if (BOTH(pb + 3)) GRID_BAR();
        }
        if (PH_ON(5) && IN(pb + 4)) { KArgs A = kargs(); unsigned char* ws = A->ws; MKFRAME();
            _Pragma("unroll 1") for (int rep = 0; rep < NREP(12); ++rep) convert_B(F, A, ws, l);
            norm_phase(F, l == 0 ? A->in.x : (const float*)A->out, A->out, WSP(float, WS_F), A->in.n_mix_post + l * D, A->in.n_ffn_pre + l * D, WSP(bf16, WS_HB));
            if (BOTH(pb + 4)) GRID_BAR();
        }
        if (PH_ON(6) && IN(pb + 5)) { KArgs A = kargs(); unsigned char* ws = A->ws; MKFRAME();
            pg8::Gemm g{WSP(bf16, WS_HB), WSP(bf16, WS_FFNINT), M, 2 * FF, D}; pg8::StaticOrder S; S.init(M, 2 * FF, F.G, (int)blockIdx.x);
            pg8::EpiSwiglu E{WSP(bf16, WS_HID), FF};
            _Pragma("unroll 1") for (int rep = 0; rep < NREP(6); ++rep)
            pg8::gemm_phase<pg8::EpiSwiglu, pg8::StaticOrder, MK_ALIGN, MK_SP2>(F.lds + RING_OFF, g, S, E);
            if (BOTH(pb + 5)) GRID_BAR();
        }
        if (PH_ON(7) && IN(pb + 6)) { KArgs A = kargs(); unsigned char* ws = A->ws; MKFRAME();
            pg8::Gemm g{WSP(bf16, WS_HID), WSP(bf16, WS_FFNOUTT), M, D, FF}; pg8::StaticOrder S; S.init(M, D, F.G, (int)blockIdx.x);
            pg8::EpiF32 E{WSP(float, WS_F), D};
            _Pragma("unroll 1") for (int rep = 0; rep < NREP(7); ++rep)
            pg8::gemm_phase<pg8::EpiF32, pg8::StaticOrder, MK_ALIGN, MK_SP2>(F.lds + RING_OFF, g, S, E);
            if (BOTH(pb + 6)) GRID_BAR();
        }
        if (PH_ON(8) && IN(pb + 7)) { KArgs A = kargs(); unsigned char* ws = A->ws; MKFRAME();
            if (l + 1 < NLAYER) { _Pragma("unroll 1") for (int rep = 0; rep < NREP(11); ++rep) convert_A(F, A, ws, l + 1); }
            norm_phase(F, (const float*)A->out, A->out, WSP(float, WS_F), A->in.n_ffn_post + l * D, (l + 1 < NLAYER) ? A->in.n_mix_pre + (l + 1) * D : (const float*)nullptr, WSP(bf16, WS_HB));
            if (BOTH(pb + 7)) GRID_BAR();
        }
    }
#undef WSP
#undef IN
#undef BOTH
#undef GRID_BAR
}

#ifndef MK_ONE_LAUNCH
#define MK_ONE_LAUNCH 1
#endif
extern "C" void kernel_launch(void* const* d_in, const int* in_sizes, int n_in, void* d_out, int out_size, void* d_ws, size_t ws_size, hipStream_t stream) {
    static int grid = 0;
    if (grid == 0) {
        if (n_in != 23 || in_sizes[0] != M * D || out_size != M * D || ws_size < WS_END) { fprintf(stderr, "kernel_launch: unexpected shapes (n_in %d, in0 %d, out %d, ws %zu); nothing launched\n", n_in, n_in > 0 ? in_sizes[0] : -1, out_size, ws_size); grid = -1; return; }
        int dev = 0, cus = 0, per_cu = 0;
        if (hipGetDevice(&dev) != hipSuccess || hipDeviceGetAttribute(&cus, hipDeviceAttributeMultiprocessorCount, dev) != hipSuccess) { grid = -1; return; }
        if (hipFuncSetAttribute((const void*)hybrid_fwd, hipFuncAttributeMaxDynamicSharedMemorySize, LDS_BYTES) != hipSuccess) { fprintf(stderr, "kernel_launch: hipFuncSetAttribute failed\n"); grid = -1; return; }
        if (hipOccupancyMaxActiveBlocksPerMultiprocessor(&per_cu, (const void*)hybrid_fwd, NWAVES * 64, LDS_BYTES) != hipSuccess || per_cu < 1) { fprintf(stderr, "kernel_launch: occupancy query says %d\n", per_cu); per_cu = 1; }
        (void)hipGetLastError();
        grid = cus;
    }
    if (grid < 0) return;
    if (hipMemsetAsync((char*)d_ws + WS_CTL, 0, CTL_ZERO_BYTES, stream) != hipSuccess) return;
    Args a{};
    const float** ip = (const float**)&a.in;
    for (int i = 0; i < 23; ++i) ip[i] = (const float*)d_in[i];
    a.out = (float*)d_out; a.ws = (unsigned char*)d_ws;
#if MK_ONE_LAUNCH
    a.ph_lo = 0; a.ph_hi = NPHASE;
    hipLaunchKernelGGL(hybrid_fwd, dim3(grid), dim3(NWAVES * 64), LDS_BYTES, stream, a);
#else
    for (int ph = 0; ph < NPHASE; ++ph) { a.ph_lo = ph; a.ph_hi = ph + 1;
        hipLaunchKernelGGL(hybrid_fwd, dim3(grid), dim3(NWAVES * 64), LDS_BYTES, stream, a); }
#endif
}
```

```cpp
#include <hip/hip_runtime.h>
#include <cstdio>
#include <cstdint>
namespace pg8 {
#define PG8_LAS __attribute__((address_space(3)))
typedef unsigned short bf16_t;
typedef short bf16x8 __attribute__((ext_vector_type(8)));
typedef float f32x4 __attribute__((ext_vector_type(4)));
typedef unsigned u32x4 __attribute__((ext_vector_type(4)));
constexpr int BM = 256, BK = 64, HALF = 128, HTB = HALF * BK * 2  , STAGE_BYTES = 8 * HTB, NXCD = 8, WGM = 8;

__host__ __device__ __forceinline__ int lds_byte(int r, int c) { const int st = (r >> 4) * 2 + (c >> 5), rr = r & 15, cc = c & 31, ob = rr * 64 + cc * 2; return st * 1024 + (ob ^ (((ob >> 9) & 1) << 5)); }
__host__ __device__ __forceinline__ void stage_rc(int b, int& R, int& C) { const int st = b / 1024, sb = b % 1024, swz = sb ^ (((sb >> 9) & 1) << 5); R = (st >> 1) * 16 + swz / 64; C = (st & 1) * 32 + (swz % 64) / 2; }
__host__ __device__ __forceinline__ int perm32(int rho) { const int n = rho >> 4, i = rho & 15; return 8 * (i >> 2) + 4 * n + (i & 3); }

struct Unit { int pm, pn; };
struct Gemm { const bf16_t* A; const bf16_t* Bt; int M, N, K; };

struct StaticOrder {
    int nM, nN, nwg, G, c;
    __host__ __device__ void init(int M, int N, int G_, int c_) { nM = M / BM; nN = N / BM; nwg = nM * nN; G = G_; c = c_; }
    __host__ __device__ bool next(int i, Unit& u) const {
        const long L = (long)i * G + c; if (L >= nwg) return false;
        int wgid = (int)L; { const int q = nwg / NXCD, r = nwg % NXCD, xcd = wgid % NXCD, off = wgid / NXCD; wgid = (xcd < r ? xcd * (q + 1) : r * (q + 1) + (xcd - r) * q) + off; }
        const int nig = WGM * nN, gid = wgid / nig, fm = gid * WGM, gsz = (nM - fm) < WGM ? (nM - fm) : WGM;
        u.pm = fm + ((wgid % nig) % gsz); u.pn = (wgid % nig) / gsz; return true;
    }
    __device__ __forceinline__ void a_ready(const Unit&) const {}
    __device__ __forceinline__ void done(const Unit&) const {}
};

__device__ __forceinline__ unsigned cvt_pk_bf16(float lo, float hi) { unsigned r; asm volatile("v_cvt_pk_bf16_f32 %0, %1, %2" : "=v"(r) : "v"(lo), "v"(hi)); return r; }
typedef float f32x2 __attribute__((ext_vector_type(2)));
__device__ __forceinline__ float sigm(float x) { return __builtin_amdgcn_rcpf(1.0f + __expf(-x)); }
__device__ __forceinline__ float bf_lo(unsigned w) { return __uint_as_float(w << 16); }
__device__ __forceinline__ float bf_hi(unsigned w) { return __uint_as_float(w & 0xffff0000u); }
__device__ __forceinline__ u32x4 pack8(const f32x4& v0, const f32x4& v1) { u32x4 w; w.x = cvt_pk_bf16(v0[0], v0[1]); w.y = cvt_pk_bf16(v0[2], v0[3]); w.z = cvt_pk_bf16(v1[0], v1[1]); w.w = cvt_pk_bf16(v1[2], v1[3]); return w; }

struct EpiF32 {
    static constexpr bool PERM = false, AFTER_DRAIN = false;
    float* C; int ldc;
    __device__ __forceinline__ void operator()(const f32x4 (&acc)[2][2][4][2], const Unit& u, int wr, int wc, int fr, int fq) const {
        const int row0 = u.pm * BM + wr * 64 + fr, col0 = u.pn * BM + wc * 32 + 4 * fq;
#pragma unroll
        for (int ai = 0; ai < 2; ++ai)
#pragma unroll
            for (int m = 0; m < 4; ++m) { float* rowp = C + (size_t)(row0 + ai * HALF + m * 16) * ldc + col0;
#pragma unroll
                for (int bj = 0; bj < 2; ++bj)
#pragma unroll
                    for (int n = 0; n < 2; ++n) *(f32x4*)(rowp + bj * HALF + n * 16) = acc[ai][bj][m][n]; }
    }
};
struct EpiRoute {
    static constexpr bool PERM = true, AFTER_DRAIN = false;
    bf16_t *poolu, *s5u, *q, *qi, *kvx, *gates;
    __device__ __forceinline__ void operator()(const f32x4 (&acc)[2][2][4][2], const Unit& u, int wr, int wc, int fr, int fq) const {
        const int row0 = u.pm * BM + wr * 64 + fr; const int pn = u.pn;
        bf16_t* base; int ld, colt, mode = 0;
        if (pn < 2) { base = poolu; ld = 512; colt = pn * 256; }
        else if (pn < 4) { base = s5u; ld = 512; colt = (pn - 2) * 256; }
        else if (pn < 8) { base = q; ld = 1024; colt = (pn - 4) * 256; mode = 2; }
        else if (pn < 10) { base = qi; ld = 512; colt = (pn - 8) * 256; }
        else if (pn == 10) { base = kvx; ld = 256; colt = 0; }
        else { base = gates; ld = 3072; colt = (pn - 11) * 256; mode = 1; }
        const int col0 = colt + wc * 32 + 8 * fq;
#pragma unroll
        for (int ai = 0; ai < 2; ++ai)
#pragma unroll
            for (int m = 0; m < 4; ++m) { bf16_t* rowp = base + (size_t)(row0 + ai * HALF + m * 16) * ld + col0;
#pragma unroll
                for (int bj = 0; bj < 2; ++bj) { f32x4 v0 = acc[ai][bj][m][0], v1 = acc[ai][bj][m][1];
                    if (mode == 1) {
#pragma unroll
                        for (int j = 0; j < 4; ++j) { v0[j] = sigm(v0[j]); v1[j] = sigm(v1[j]); } }
                    else if (mode == 2) { v0 = v0 * 0.125f; v1 = v1 * 0.125f; }
                    *(u32x4*)(rowp + bj * HALF) = pack8(v0, v1); } }
    }
};
struct EpiGlu {
    static constexpr bool PERM = true, AFTER_DRAIN = false;
    bf16_t* merged; const bf16_t* gates;
    __device__ __forceinline__ void operator()(const f32x4 (&acc)[2][2][4][2], const Unit& u, int wr, int wc, int fr, int fq) const {
        const int row0 = u.pm * BM + wr * 64 + fr, col0 = u.pn * HALF + wc * 32 + 8 * fq;
#pragma unroll
        for (int ai = 0; ai < 2; ++ai)
#pragma unroll
            for (int m = 0; m < 4; ++m) { const size_t row = (size_t)(row0 + ai * HALF + m * 16);
                const u32x4 g = *(const u32x4*)(gates + row * 3072 + 2048 + col0);
                f32x4 a0 = acc[ai][0][m][0], a1 = acc[ai][0][m][1]; const f32x4 s0 = acc[ai][1][m][0], s1 = acc[ai][1][m][1];
#pragma unroll
                for (int j = 0; j < 4; ++j) { a0[j] *= sigm(s0[j]); a1[j] *= sigm(s1[j]); }
                a0[0] *= bf_lo(g.x); a0[1] *= bf_hi(g.x); a0[2] *= bf_lo(g.y); a0[3] *= bf_hi(g.y);
                a1[0] *= bf_lo(g.z); a1[1] *= bf_hi(g.z); a1[2] *= bf_lo(g.w); a1[3] *= bf_hi(g.w);
                *(u32x4*)(merged + row * 1024 + col0) = pack8(a0, a1);
                asm volatile("" ::: "memory"); }
    }
};
template <int GOFF> struct EpiAccum {
    static constexpr bool PERM = true, AFTER_DRAIN = false;
    bf16_t* merged; const bf16_t* gates;
    __device__ __forceinline__ void operator()(const f32x4 (&acc)[2][2][4][2], const Unit& u, int wr, int wc, int fr, int fq) const {
        const int row0 = u.pm * BM + wr * 64 + fr, col0 = u.pn * BM + wc * 32 + 8 * fq;
#pragma unroll
        for (int ai = 0; ai < 2; ++ai)
#pragma unroll
            for (int m = 0; m < 4; ++m) { const size_t row = (size_t)(row0 + ai * HALF + m * 16);
#pragma unroll
                for (int bj = 0; bj < 2; ++bj) { const int c = col0 + bj * HALF;
                    const u32x4 g = *(const u32x4*)(gates + row * 3072 + GOFF + c); const u32x4 o = *(const u32x4*)(merged + row * 1024 + c);
                    f32x4 a0 = acc[ai][bj][m][0], a1 = acc[ai][bj][m][1];
                    a0[0] = a0[0] * bf_lo(g.x) + bf_lo(o.x); a0[1] = a0[1] * bf_hi(g.x) + bf_hi(o.x); a0[2] = a0[2] * bf_lo(g.y) + bf_lo(o.y); a0[3] = a0[3] * bf_hi(g.y) + bf_hi(o.y);
                    a1[0] = a1[0] * bf_lo(g.z) + bf_lo(o.z); a1[1] = a1[1] * bf_hi(g.z) + bf_hi(o.z); a1[2] = a1[2] * bf_lo(g.w) + bf_lo(o.w); a1[3] = a1[3] * bf_hi(g.w) + bf_hi(o.w);
                    *(u32x4*)(merged + row * 1024 + c) = pack8(a0, a1); }
                asm volatile("" ::: "memory"); }
    }
};
struct EpiSwiglu {
    static constexpr bool PERM = true, AFTER_DRAIN = false;
    bf16_t* hid; int ldh;
    __device__ __forceinline__ void operator()(const f32x4 (&acc)[2][2][4][2], const Unit& u, int wr, int wc, int fr, int fq) const {
        const int row0 = u.pm * BM + wr * 64 + fr, col0 = u.pn * HALF + wc * 32 + 8 * fq;
#pragma unroll
        for (int ai = 0; ai < 2; ++ai)
#pragma unroll
            for (int m = 0; m < 4; ++m) { const size_t row = (size_t)(row0 + ai * HALF + m * 16);
                f32x4 g0 = acc[ai][0][m][0], g1 = acc[ai][0][m][1]; const f32x4 u0 = acc[ai][1][m][0], u1 = acc[ai][1][m][1];
#pragma unroll
                for (int j = 0; j < 4; ++j) { g0[j] = g0[j] * sigm(g0[j]) * u0[j]; g1[j] = g1[j] * sigm(g1[j]) * u1[j]; }
                *(u32x4*)(hid + row * ldh + col0) = pack8(g0, g1); }
    }
};
struct PairOrder {
    StaticOrder base;
    __device__ bool next(int i, Unit& u) const { Unit b; if (!base.next(i >> 1, b)) return false; u.pm = b.pm; u.pn = 2 * b.pn + (i & 1); return true; }
    __device__ __forceinline__ void a_ready(const Unit&) const {}
    __device__ __forceinline__ void done(const Unit&) const {}
};

template <class Epi, class Sched, bool ALIGN_EPI = false, bool SP2 = false>
__device__ __forceinline__ void gemm_phase(PG8_LAS unsigned char* lds, const Gemm g, const Sched& S, const Epi& E) {
    int tid_ = threadIdx.x; asm volatile("" : "+v"(tid_));
    const int tid = tid_, wid = __builtin_amdgcn_readfirstlane(tid >> 6), lane = tid & 63, wr = wid >> 2, wc = wid & 3, fr = lane & 15, fq = lane >> 4;
    const int K = g.K, nt = K / BK;
    unsigned voffA[2], voffB[2];
#pragma unroll
    for (int i = 0; i < 2; ++i) { int R, C; stage_rc(tid * 16 + i * 8192, R, C); const int Rb = Epi::PERM ? ((R & ~31) + perm32(R & 31)) : R;
        voffA[i] = (unsigned)(R * K + C) * 2u; voffB[i] = (unsigned)(Rb * K + C) * 2u; }
    const size_t kstep = (size_t)(BK * 2);
    const size_t hstep = (size_t)HALF * K * 2;
    const size_t tstep = 2 * hstep;
    const unsigned ldsw = (unsigned)wid * 1024u;
    const int aoff = lds_byte(wr * 64 + fr, fq * 8), boff = lds_byte(wc * 32 + fr, fq * 8);
#define PG8_SA(b, h) (((b) * 2 + (h)) * HTB)
#define PG8_SB(b, h) ((4 + (b) * 2 + (h)) * HTB)
#define PG8_STAGE(bufoff, gbase, voff) do { _Pragma("unroll") for (int _i = 0; _i < 2; ++_i) \
        __builtin_amdgcn_global_load_lds((const unsigned*)((const char*)(gbase) + (voff)[_i]), (PG8_LAS unsigned*)(lds + (bufoff) + ldsw + _i * 8192), 16, 0, 0); } while (0)
#define PG8_LDA(dst, b, h) do { _Pragma("unroll") for (int m = 0; m < 4; ++m) _Pragma("unroll") for (int k = 0; k < 2; ++k) dst[m][k] = *(const PG8_LAS bf16x8*)(lds + PG8_SA(b, h) + aoff + m * 2048 + k * 1024); } while (0)
#define PG8_LDB(dst, b, h) do { _Pragma("unroll") for (int n = 0; n < 2; ++n) _Pragma("unroll") for (int k = 0; k < 2; ++k) dst[n][k] = *(const PG8_LAS bf16x8*)(lds + PG8_SB(b, h) + boff + n * 2048 + k * 1024); } while (0)
#define PG8_MMA(ai, bj, At, Bt) do { __builtin_amdgcn_s_setprio(1); _Pragma("unroll") for (int m = 0; m < 4; ++m) _Pragma("unroll") for (int n = 0; n < 2; ++n) _Pragma("unroll") for (int k = 0; k < 2; ++k) \
        acc[ai][bj][m][n] = __builtin_amdgcn_mfma_f32_16x16x32_bf16(Bt[n][k], At[m][k], acc[ai][bj][m][n], 0, 0, 0); __builtin_amdgcn_s_setprio(0); } while (0)
#define PG8_WAIT_V(n) asm volatile("s_waitcnt vmcnt(" #n ")" ::: "memory")
#define PG8_WAIT_L(n) asm volatile("s_waitcnt lgkmcnt(" #n ")" ::: "memory")
#define PG8_BAR __builtin_amdgcn_s_barrier()
#define PG8_SCHED __builtin_amdgcn_sched_barrier(0)
    Unit cur, nxt; int ui = 0;
    if (!S.next(0, cur)) return;
    f32x4 acc[2][2][4][2];
#pragma unroll
    for (int a = 0; a < 2; ++a)
#pragma unroll
        for (int b = 0; b < 2; ++b)
#pragma unroll
            for (int m = 0; m < 4; ++m)
#pragma unroll
                for (int n = 0; n < 2; ++n) acc[a][b][m][n] = (f32x4){0.f, 0.f, 0.f, 0.f};
    bf16x8 At[4][2], B0[2][2], B1[2][2];
    const char* cA = (const char*)g.A + (size_t)cur.pm * tstep; const char* cB = (const char*)g.Bt + (size_t)cur.pn * tstep;
    S.a_ready(cur);
    if constexpr (SP2) {
        PG8_STAGE(PG8_SB(0, 0), cB, voffB); PG8_STAGE(PG8_SB(0, 1), cB + hstep, voffB); PG8_STAGE(PG8_SA(0, 0), cA, voffA); PG8_STAGE(PG8_SA(0, 1), cA + hstep, voffA);
        if (wr == 1) PG8_BAR;
        PG8_WAIT_V(2); PG8_BAR;
        PG8_STAGE(PG8_SB(1, 0), cB + kstep, voffB); PG8_STAGE(PG8_SA(1, 0), cA + kstep, voffA); PG8_STAGE(PG8_SB(1, 1), cB + hstep + kstep, voffB);
        PG8_WAIT_V(6); PG8_BAR;
    } else {
        PG8_STAGE(PG8_SB(0, 0), cB, voffB); PG8_STAGE(PG8_SA(0, 0), cA, voffA); PG8_STAGE(PG8_SB(0, 1), cB + hstep, voffB); PG8_STAGE(PG8_SA(0, 1), cA + hstep, voffA);
        if (wr == 1) PG8_BAR;
        PG8_WAIT_V(4); PG8_BAR;
        PG8_STAGE(PG8_SB(1, 0), cB + kstep, voffB); PG8_STAGE(PG8_SA(1, 0), cA + kstep, voffA); PG8_STAGE(PG8_SB(1, 1), cB + hstep + kstep, voffB);
        PG8_WAIT_V(6); PG8_BAR;
    }
    for (;;) {
        const bool has_next = S.next(ui + 1, nxt);
        const char* nA = has_next ? (const char*)g.A + (size_t)nxt.pm * tstep : cA; const char* nB = has_next ? (const char*)g.Bt + (size_t)nxt.pn * tstep : cB;
        for (int t = 0; t < nt; t += 2) {
            const bool last = (t == nt - 2);
            const char* a1 = cA + (size_t)(t + 1) * kstep;
            const char* a2 = last ? nA : cA + (size_t)(t + 2) * kstep; const char* b2 = last ? nB : cB + (size_t)(t + 2) * kstep;
            const char* a3 = a2 + kstep; const char* b3 = b2 + kstep;
            if (last && has_next) S.a_ready(nxt);
            if constexpr (SP2) {
            PG8_LDB(B0, 0, 0); PG8_LDB(B1, 0, 1); PG8_SCHED; PG8_LDA(At, 0, 0); PG8_STAGE(PG8_SA(1, 1), a1 + hstep, voffA);
            PG8_WAIT_V(8); PG8_WAIT_L(0); PG8_BAR; PG8_MMA(0, 0, At, B0); PG8_MMA(0, 1, At, B1); PG8_BAR; PG8_SCHED;
            PG8_LDA(At, 0, 1); PG8_STAGE(PG8_SB(0, 0), b2, voffB); PG8_STAGE(PG8_SB(0, 1), b2 + hstep, voffB); PG8_STAGE(PG8_SA(0, 0), a2, voffA);
            PG8_WAIT_V(8); PG8_WAIT_L(0); PG8_BAR; PG8_MMA(1, 0, At, B0); PG8_MMA(1, 1, At, B1); PG8_BAR; PG8_SCHED;
            PG8_LDB(B0, 1, 0); PG8_LDB(B1, 1, 1); PG8_SCHED; PG8_LDA(At, 1, 0); PG8_STAGE(PG8_SA(0, 1), a2 + hstep, voffA);
            PG8_WAIT_V(8); PG8_WAIT_L(0); PG8_BAR; PG8_MMA(0, 0, At, B0); PG8_MMA(0, 1, At, B1); PG8_BAR; PG8_SCHED;
            PG8_LDA(At, 1, 1); PG8_STAGE(PG8_SB(1, 0), b3, voffB); PG8_STAGE(PG8_SB(1, 1), b3 + hstep, voffB); PG8_STAGE(PG8_SA(1, 0), a3, voffA);
            PG8_WAIT_V(8); PG8_WAIT_L(0); PG8_BAR; PG8_MMA(1, 0, At, B0); PG8_MMA(1, 1, At, B1); PG8_BAR; PG8_SCHED;
            } else {
            PG8_LDB(B0, 0, 0); PG8_SCHED; PG8_LDA(At, 0, 0); PG8_STAGE(PG8_SA(1, 1), a1 + hstep, voffA);
            PG8_WAIT_L(8); PG8_BAR; PG8_WAIT_L(0); PG8_MMA(0, 0, At, B0); PG8_BAR; PG8_SCHED;
            PG8_LDB(B1, 0, 1); PG8_STAGE(PG8_SB(0, 0), b2, voffB);
            PG8_BAR; PG8_WAIT_L(0); PG8_MMA(0, 1, At, B1); PG8_BAR;
            PG8_LDA(At, 0, 1); PG8_STAGE(PG8_SA(0, 0), a2, voffA);
            PG8_BAR; PG8_WAIT_L(0); PG8_MMA(1, 0, At, B0); PG8_BAR; PG8_SCHED;
            PG8_STAGE(PG8_SB(0, 1), b2 + hstep, voffB);
            PG8_WAIT_V(6); PG8_BAR; PG8_MMA(1, 1, At, B1); PG8_BAR;
            PG8_LDB(B0, 1, 0); PG8_SCHED; PG8_LDA(At, 1, 0); PG8_STAGE(PG8_SA(0, 1), a2 + hstep, voffA);
            PG8_WAIT_L(8); PG8_BAR; PG8_WAIT_L(0); PG8_MMA(0, 0, At, B0); PG8_BAR; PG8_SCHED;
            PG8_LDB(B1, 1, 1); PG8_STAGE(PG8_SB(1, 0), b3, voffB);
            PG8_BAR; PG8_WAIT_L(0); PG8_MMA(0, 1, At, B1); PG8_BAR;
            PG8_LDA(At, 1, 1); PG8_STAGE(PG8_SA(1, 0), a3, voffA);
            PG8_BAR; PG8_WAIT_L(0); PG8_MMA(1, 0, At, B0); PG8_BAR; PG8_SCHED;
            PG8_STAGE(PG8_SB(1, 1), b3 + hstep, voffB);
            PG8_WAIT_V(6); PG8_BAR; PG8_MMA(1, 1, At, B1); PG8_BAR;
            }
        }
        if constexpr (ALIGN_EPI) { if (wr == 0) PG8_BAR; }
        if constexpr (!Epi::AFTER_DRAIN) { E(acc, cur, wr, wc, fr, fq); S.done(cur); }
        if (!has_next) break;
#pragma unroll
        for (int a = 0; a < 2; ++a)
#pragma unroll
            for (int b = 0; b < 2; ++b)
#pragma unroll
                for (int m = 0; m < 4; ++m)
#pragma unroll
                    for (int n = 0; n < 2; ++n) acc[a][b][m][n] = (f32x4){0.f, 0.f, 0.f, 0.f};
        cur = nxt; cA = nA; cB = nB; ++ui;
        if constexpr (ALIGN_EPI) { if (wr == 1) PG8_BAR; }
    }
    PG8_WAIT_V(0);
    if constexpr (!ALIGN_EPI) { if (wr == 0) PG8_BAR; }
    PG8_BAR;
    if constexpr (Epi::AFTER_DRAIN) { E.fused(acc, cur, wr, wc, fr, fq, lds, wid, lane); S.done(cur); }
#undef PG8_SA
#undef PG8_SB
#undef PG8_STAGE
#undef PG8_LDA
#undef PG8_LDB
#undef PG8_MMA
#undef PG8_WAIT_V
#undef PG8_WAIT_L
#undef PG8_BAR
#undef PG8_SCHED
}
}

constexpr int NWAVES = 8;
constexpr int BATCH = 8, SEQ = 2048, D = 1024, M = BATCH * SEQ;
constexpr int INW = 5832, N1P = 5888, FF = 2816, NLAYER = 2;
constexpr float NORM_EPS = 1e-6f;
constexpr size_t MiB = 1u << 20;
constexpr size_t WS_CTL = 0, CTL_ZERO_BYTES = 1 * MiB;
constexpr size_t WS_WINT = 1 * MiB;
constexpr size_t WS_ATTNOT = WS_WINT + (size_t)N1P * D * 2;
constexpr size_t WS_POOLET = WS_ATTNOT + 2 * MiB;
constexpr size_t WS_GLUT = WS_POOLET + 1 * MiB;
constexpr size_t WS_WOUTT = WS_GLUT + 2 * MiB;
constexpr size_t WS_S5T = WS_WOUTT + 2 * MiB;
constexpr size_t WS_S5P = WS_S5T + 4 * MiB;
constexpr size_t WS_S5Q = WS_S5P + 2 * MiB;
constexpr size_t WS_S5A = WS_S5Q + 2 * MiB;
constexpr size_t WS_BIAS = WS_S5A + 65536;
static_assert(WS_BIAS + 8192 <= 29 * MiB, "weights region");
constexpr size_t WS_HB = 29 * MiB;
constexpr size_t WS_DP = WS_HB, WS_ZB = WS_HB + 16 * MiB;
constexpr size_t WS_POOLU = 61 * MiB, WS_S5U = 77 * MiB;
constexpr size_t WS_MERGED = WS_POOLU;
constexpr size_t WS_FFNINT = WS_POOLU, WS_FFNOUTT = WS_POOLU + 11 * MiB;
constexpr size_t WS_Q = 93 * MiB, WS_QI = 125 * MiB, WS_KVX = 141 * MiB, WS_GATES = 149 * MiB;
constexpr size_t WS_F = WS_Q;
constexpr size_t WS_HID = 157 * MiB;
constexpr size_t WS_END = 245 * MiB;
static_assert(WS_FFNOUTT + (size_t)D * FF * 2 <= WS_Q && WS_HID + (size_t)M * FF * 2 <= WS_END && WS_F + (size_t)M * D * 4 <= WS_HID, "d_ws map");
constexpr int CW_BAR = 4096;
constexpr int RING_OFF = 0, RING_BYTES = 131072;
constexpr int LDSCTL_OFF = RING_BYTES, MISC_OFF = LDSCTL_OFF + 320;
constexpr int LDS_BYTES = 147456;
constexpr int NPHASE = 1 + 8 * NLAYER;

#define GAS __attribute__((address_space(1)))
#define LAS __attribute__((address_space(3)))
typedef unsigned short bf16;
typedef unsigned v4u __attribute__((ext_vector_type(4)));
typedef float f32x4 __attribute__((ext_vector_type(4)));
typedef short bf16x8 __attribute__((ext_vector_type(8)));
typedef GAS unsigned gu32;
typedef GAS unsigned long long gu64;
#define RLX_AGENT __ATOMIC_RELAXED, __HIP_MEMORY_SCOPE_AGENT
#define LDS_WAIT() asm volatile("s_waitcnt lgkmcnt(0)" ::: "memory")
#define VM_WAIT() asm volatile("s_waitcnt vmcnt(0)" ::: "memory")
__device__ __forceinline__ unsigned long long rt() { return __builtin_amdgcn_s_memrealtime(); }
__device__ __forceinline__ unsigned f2bf(float f) { unsigned u = __builtin_bit_cast(unsigned, f); return (u + 0x7fffu + ((u >> 16) & 1u)) >> 16; }
__device__ __forceinline__ unsigned pk2(float lo, float hi) { return f2bf(lo) | (f2bf(hi) << 16); }
#define XB_TMO      128
#define XB_XCNT(j)  (256  + 64 * (j))
#define XB_XSUB(j)  (1280 + 64 * (j))
#define XB_XGEN(j)  (2304 + 64 * (j))
#define XB_TOP      3328
#define XB_TOPGEN   3392
#define XCD_BAR_WORDS 3456
#define XB_SPIN_CAP (1u << 18)

__device__ __forceinline__ unsigned xb_ld(unsigned* p)              { return __hip_atomic_load(p, __ATOMIC_RELAXED, __HIP_MEMORY_SCOPE_AGENT); }
__device__ __forceinline__ unsigned xb_add(unsigned* p, unsigned v) { return __hip_atomic_fetch_add(p, v, __ATOMIC_RELAXED, __HIP_MEMORY_SCOPE_AGENT); }
__device__ __forceinline__ unsigned xb_xcc_id() { return (unsigned)__builtin_amdgcn_s_getreg((3 << 11) | 20) & 0xFu; }
#define XB_SPIN(cond, bar) do { unsigned _sp = 0; while (cond) { __builtin_amdgcn_s_sleep(1); \
    if ((++_sp & 255u) == 0u) { if (xb_ld(&(bar)[XB_TMO])) break; if (_sp > XB_SPIN_CAP) { atomicAdd(&(bar)[XB_TMO], 1u); break; } } } } while (0)

struct XcdBarrier {
    unsigned* bar; unsigned x;
    volatile LAS unsigned* st;
};

__device__ __forceinline__ XcdBarrier xcd_barrier_post(unsigned* bar, volatile LAS unsigned* st) {
    XcdBarrier b; b.bar = bar; b.x = xb_xcc_id(); b.st = st;
    if (threadIdx.x == 0) (void)xb_add(&bar[XB_XCNT(b.x)], 1u);
    return b;
}
__device__ __forceinline__ void xcd_barrier_complete(unsigned* bar, unsigned x, unsigned& nloc, unsigned& nx) {
    const unsigned G = gridDim.x * gridDim.y * gridDim.z;
    unsigned sum, cnt, mine, sp = 0u;
    for (;;) {
        sum = 0u; cnt = 0u; mine = 0u;
#pragma unroll
        for (unsigned j = 0; j < 16; ++j) { const unsigned c = xb_ld(&bar[XB_XCNT(j)]); sum += c; cnt += (c > 0u) ? 1u : 0u; mine = (j == x) ? c : mine; }
        if (sum == G) break;
        __builtin_amdgcn_s_sleep(1);
        if ((++sp & 255u) == 0u) { if (xb_ld(&bar[XB_TMO])) break; if (sp > XB_SPIN_CAP) { atomicAdd(&bar[XB_TMO], 1u); break; } }
    }
    nloc = mine > 0u ? mine : 1u; nx = cnt > 0u ? cnt : 1u;
}

__device__ __forceinline__ void xcd_barrier(const XcdBarrier& b) {
    asm volatile("s_waitcnt vmcnt(0)" ::: "memory");
    __syncthreads();
    if (threadIdx.x == 0) {
        unsigned* bar = b.bar;
        __builtin_amdgcn_s_waitcnt(0);
        unsigned nloc = b.st[0], nx = b.st[1];
        if (nloc == 0u) { xcd_barrier_complete(bar, b.x, nloc, nx); b.st[0] = nloc; b.st[1] = nx; }
        const unsigned old = xb_add(&bar[XB_XSUB(b.x)], 1u);
        const unsigned gen = old / nloc;
        if (old + 1u == (gen + 1u) * nloc) {
            __builtin_amdgcn_fence(__ATOMIC_RELEASE, "agent");
            asm volatile("s_waitcnt vmcnt(0)" ::: "memory");
            const unsigned og = xb_add(&bar[XB_TOP], 1u);
            const unsigned tg = og / nx;
            if (og + 1u == (tg + 1u) * nx) xb_add(&bar[XB_TOPGEN], 1u);
            else XB_SPIN(xb_ld(&bar[XB_TOPGEN]) == tg, bar);
            __builtin_amdgcn_fence(__ATOMIC_ACQUIRE, "agent");
            xb_add(&bar[XB_XGEN(b.x)], 1u);
            asm volatile("s_waitcnt vmcnt(0)" ::: "memory");
        } else {
            XB_SPIN(xb_ld(&bar[XB_XGEN(b.x)]) == gen, bar);
            __builtin_amdgcn_fence(__ATOMIC_ACQUIRE, "agent");
            asm volatile("s_waitcnt vmcnt(0)" ::: "memory");
        }
    }
    __syncthreads();
}

typedef short s16x4 __attribute__((ext_vector_type(4)));
typedef short v4i16_t __attribute__((ext_vector_type(4)));
typedef unsigned short u16x4 __attribute__((ext_vector_type(4)));
typedef unsigned v2u __attribute__((ext_vector_type(2)));
typedef float f32x2v __attribute__((ext_vector_type(2)));
#define DI __device__ __forceinline__
struct Frame {
    LAS unsigned char* lds;
    int tid, lane, wave, G;
};
DI float wave_sum(float v) {
#pragma unroll
    for (int o = 1; o < 64; o <<= 1) v += __shfl_xor(v, o);
    return v;
}
DI bf16x8 ldg16(const bf16* p) { return *(const GAS bf16x8*)p; }
DI bf16x8 ldg16o(const bf16* ub, unsigned off) { return *(const GAS bf16x8*)((const GAS unsigned char*)ub + off); }
DI v4u ldg16u(const bf16* ub, unsigned off) { return *(const GAS v4u*)((const GAS unsigned char*)ub + off); }
DI float bf2f(bf16 b) { return __uint_as_float(((unsigned)b) << 16); }
DI float bflo(unsigned w) { return __uint_as_float(w << 16); }
DI float bfhi(unsigned w) { return __uint_as_float(w & 0xffff0000u); }
#define MFMA16(a, b, c) __builtin_amdgcn_mfma_f32_16x16x32_bf16((a), (b), (c), 0, 0, 0)

struct MapId { DI int operator()(int n) const { return n; } };
struct MapWin { DI int operator()(int n) const {
    if (n < 512) return n;
    if (n < 1536) return n + 512;
    if (n < 1600) return n - 1536 + 2560;
    if (n < 1664) return n - 1600 + 2624;
    if (n < 2176) return n - 1664 + 2048;
    if (n < 2240) return n - 2176 + 2688;
    if (n < 2248) return n - 2240 + 2752;
    if (n < 2760) return n - 2248 + 512;
    return n - 2760 + 2816; } };
struct MapIl { int half; DI int operator()(int n) const { const int hi = n >= half ? 1 : 0, m = n - hi * half; return (m >> 7) * 256 + hi * 128 + (m & 127); } };
template <class Map> DI void transpose_item(const float* W, int K, int Ns, bf16* WT, LAS float* scr, int item, int lane, const Map& map) {
    const int nblk = (Ns + 31) / 32, kb = item / nblk, nb = item % nblk, k0 = 64 * kb, n0 = 32 * nb;
    const int nc = n0 + 4 * (lane & 7);
    f32x4 v[8];
#pragma unroll
    for (int i = 0; i < 8; ++i) { const int kk = (lane >> 3) + 8 * i; v[i] = nc < Ns ? *(const GAS f32x4*)(W + (size_t)(k0 + kk) * Ns + nc) : (f32x4){0.f, 0.f, 0.f, 0.f}; }
#pragma unroll
    for (int i = 0; i < 8; ++i) { const int kk = (lane >> 3) + 8 * i; LAS float* d = scr + kk * 33 + 4 * (lane & 7); d[0] = v[i].x; d[1] = v[i].y; d[2] = v[i].z; d[3] = v[i].w; }
    LDS_WAIT(); asm volatile("" ::: "memory");
    const int c = lane & 7;
#pragma unroll
    for (int j = 0; j < 4; ++j) { const int nn = (lane >> 3) + 8 * j; const LAS float* s = scr + (8 * c) * 33 + nn;
        if (n0 + nn < Ns) { const int dr = map(n0 + nn);
            v4u o; o.x = pk2(s[0 * 33], s[1 * 33]); o.y = pk2(s[2 * 33], s[3 * 33]); o.z = pk2(s[4 * 33], s[5 * 33]); o.w = pk2(s[6 * 33], s[7 * 33]);
            *(GAS v4u*)(WT + (size_t)dr * K + k0 + 8 * c) = o; } }
    LDS_WAIT(); asm volatile("" ::: "memory");
}
struct In {
    const float *x, *n_mix_pre, *n_mix_post, *n_ffn_pre, *n_ffn_post, *w_in, *pool_mix_w, *pool_scale, *pool_out_w, *attn_out_w, *rel_bias, *lam_re, *lam_im, *log_dt,
                *b_re, *b_im, *c_re, *c_im, *s5_d, *glu_w, *w_out, *ffn_w_in, *ffn_w_out;
};
struct Args { In in; float* out; unsigned char* ws; int ph_lo, ph_hi; };
typedef const __attribute__((address_space(4))) Args* KArgs;
DI KArgs kargs() { KArgs p = (KArgs)__builtin_amdgcn_kernarg_segment_ptr(); asm volatile("" : "+s"(p)); return p; }
template <class T> DI T* opq(T* p) { asm volatile("" : "+s"(p)); return p; }
DI int opqv(int v) { asm volatile("" : "+v"(v)); return v; }

DI void convert_A(Frame& F, KArgs A, unsigned char* ws, int l) {
    LAS float* scr = (LAS float*)(F.lds + RING_OFF + F.wave * 16384);
    const int gw = blockIdx.x * NWAVES + F.wave, NGW = F.G * NWAVES;
    const int gt = blockIdx.x * (NWAVES * 64) + F.tid, NGT = F.G * NWAVES * 64;
    bf16* WINT = (bf16*)(ws + WS_WINT); bf16* ATTNOT = (bf16*)(ws + WS_ATTNOT); bf16* POOLET = (bf16*)(ws + WS_POOLET); bf16* GLUT = (bf16*)(ws + WS_GLUT); bf16* WOUTT = (bf16*)(ws + WS_WOUTT);
    constexpr int I_WIN = (D / 64) * ((INW + 31) / 32), I_SQ = (D / 64) * (D / 32), I_GLU = (512 / 64) * (2048 / 32);
    constexpr int NITEMS = I_WIN + 2 * I_SQ + I_GLU;
    for (int it = gw; it < NITEMS; it += NGW) {
        int r = it;
        if (r < I_WIN) { transpose_item(A->in.w_in + (size_t)l * D * INW, D, INW, WINT, scr, r, F.lane, MapWin{}); continue; } r -= I_WIN;
        if (r < I_SQ) { transpose_item(A->in.attn_out_w + (size_t)l * D * D, D, D, ATTNOT, scr, r, F.lane, MapId{}); continue; } r -= I_SQ;
        if (r < I_SQ) { transpose_item(A->in.w_out + (size_t)l * D * D, D, D, WOUTT, scr, r, F.lane, MapId{}); continue; } r -= I_SQ;
        transpose_item(A->in.glu_w + (size_t)l * 512 * 2048, 512, 2048, GLUT, scr, r, F.lane, MapIl{1024});
    }
    for (int i = gt; i < 56 * D / 8; i += NGT) *(GAS v4u*)(WINT + (size_t)2760 * D + (size_t)i * 8) = (v4u){0u, 0u, 0u, 0u};
    {   const float* mw = A->in.pool_mix_w + (size_t)l * 4 * 128 * 128; const float* sc = A->in.pool_scale + (size_t)l * 512; const float* pw = A->in.pool_out_w + (size_t)l * 512 * D;
        for (int idx = gt; idx < 512 * D; idx += NGT) { const int n = idx & (D - 1), gc = idx >> 10, g = gc >> 7;
            const float* mrow = mw + (size_t)gc * 128; float s = 0.f;
            _Pragma("unroll 16") for (int d = 0; d < 128; ++d) s += mrow[d] * sc[g * 128 + d] * pw[(size_t)(g * 128 + d) * D + n];
            POOLET[(size_t)n * 512 + gc] = (bf16)f2bf(s); } }
    if (blockIdx.x == 0) { float* BT = (float*)(ws + WS_BIAS);
        for (int i = F.tid; i < 128 * 16; i += NWAVES * 64) { const int d = i >> 4, h = i & 15;
            int bk = d; if (d >= 16) { bk = 16 + (int)(logf((float)d / 16.0f) / logf(8.0f) * 16.0f); bk = bk > 31 ? 31 : bk; }
            BT[i] = A->in.rel_bias[bk * 16 + h]; } }
    {   bf16* S5T = (bf16*)(ws + WS_S5T); bf16* S5P = (bf16*)(ws + WS_S5P); bf16* S5Q = (bf16*)(ws + WS_S5Q); float* S5A = (float*)(ws + WS_S5A);
        LAS float* apr = (LAS float*)(F.lds + RING_OFF);
        LAS float* api = apr + 17 * 64;
        LAS float* bbr = api + 17 * 64;
        LAS float* bbi = bbr + 64 * 16;
        LAS float* Kt = bbi + 64 * 16;
        __syncthreads();
        for (int task = blockIdx.x; task < 256; task += F.G) { const int g = task & 31, sub = task >> 5; const int lg = l * 32 + g;
            if (F.tid < 64) { const int n = F.tid;
                const float lr = A->in.lam_re[lg * 64 + n], li = A->in.lam_im[lg * 64 + n], dt = expf(A->in.log_dt[lg]);
                const float mag = expf(lr * dt), ar = mag * cosf(li * dt), ai = mag * sinf(li * dt), den = lr * lr + li * li;
                const float cr = ((ar - 1.0f) * lr + ai * li) / den, ci = (ai * lr - (ar - 1.0f) * li) / den;
                float pr = 1.f, pi = 0.f;
                for (int t = 0; t <= 16; ++t) { apr[t * 64 + n] = pr; api[t * 64 + n] = pi; const float nr = pr * ar - pi * ai, ni = pr * ai + pi * ar; pr = nr; pi = ni; }
                for (int c = 0; c < 16; ++c) { const float br = A->in.b_re[((size_t)lg * 64 + n) * 16 + c], bi = A->in.b_im[((size_t)lg * 64 + n) * 16 + c];
                    bbr[n * 16 + c] = cr * br - ci * bi; bbi[n * 16 + c] = cr * bi + ci * br; }
                if (sub == 0) { S5A[(g * 64 + n) * 2] = apr[16 * 64 + n]; S5A[(g * 64 + n) * 2 + 1] = api[16 * 64 + n]; }
            }
            __syncthreads();
            const float* Cre = A->in.c_re + (size_t)lg * 16 * 64; const float* Cim = A->in.c_im + (size_t)lg * 16 * 64;
            {
                const int t = F.tid >> 5, i = (F.tid >> 1) & 15, c0 = (F.tid & 1) * 8; float acc[8];
#pragma unroll
                for (int q = 0; q < 8; ++q) acc[q] = 0.f;
                for (int n = 0; n < 64; ++n) { const float Cr = Cre[i * 64 + n], Ci = Cim[i * 64 + n], pr = apr[t * 64 + n], pi = api[t * 64 + n];
                    const float er = Cr * pr - Ci * pi, ei = Cr * pi + Ci * pr;
                    const f32x4 b0 = *(const LAS f32x4*)(bbr + n * 16 + c0), b1 = *(const LAS f32x4*)(bbr + n * 16 + c0 + 4), d0 = *(const LAS f32x4*)(bbi + n * 16 + c0), d1 = *(const LAS f32x4*)(bbi + n * 16 + c0 + 4);
#pragma unroll
                    for (int q = 0; q < 4; ++q) { acc[q] += er * b0[q] - ei * d0[q]; acc[4 + q] += er * b1[q] - ei * d1[q]; } }
#pragma unroll
                for (int q = 0; q < 8; ++q) Kt[(t * 16 + i) * 16 + c0 + q] = acc[q]; }
            __syncthreads();
            for (int e = F.tid; e < 32 * 256; e += NWAVES * 64) { const int r = sub * 32 + (e >> 8), k = e & 255, j = r >> 4, i = r & 15, s = k >> 4, c = k & 15;
                float v = (j >= s) ? Kt[((j - s) * 16 + i) * 16 + c] : 0.f; if (j == s && i == c) v += A->in.s5_d[l * 512 + g * 16 + i];
                S5T[((size_t)g * 256 + r) * 256 + k] = (bf16)f2bf(v); }
            for (int e = F.tid; e < 16 * 256; e += NWAVES * 64) { const int row = sub * 16 + (e >> 8), k = e & 255, n = row & 63, im = row >> 6, s = k >> 4, c = k & 15;
                const float pr = apr[(15 - s) * 64 + n], pi = api[(15 - s) * 64 + n], br = bbr[n * 16 + c], bi = bbi[n * 16 + c];
                const float v = im ? (pr * bi + pi * br) : (pr * br - pi * bi);
                S5P[((size_t)g * 128 + row) * 256 + k] = (bf16)f2bf(v); }
            for (int e = F.tid; e < 32 * 128; e += NWAVES * 64) { const int r = sub * 32 + (e >> 7), k = e & 127, j = r >> 4, i = r & 15, n = k & 63, im = k >> 6;
                const float Cr = Cre[i * 64 + n], Ci = Cim[i * 64 + n], pr = apr[(j + 1) * 64 + n], pi = api[(j + 1) * 64 + n];
                const float v = im ? -(Cr * pi + Ci * pr) : (Cr * pr - Ci * pi);
                S5Q[((size_t)g * 256 + r) * 128 + k] = (bf16)f2bf(v); }
            __syncthreads();
        }
    }
}
DI void convert_B(Frame& F, KArgs A, unsigned char* ws, int l) {
    LAS float* scr = (LAS float*)(F.lds + RING_OFF + F.wave * 16384);
    const int gw = blockIdx.x * NWAVES + F.wave, NGW = F.G * NWAVES;
    bf16* FFNINT = (bf16*)(ws + WS_FFNINT); bf16* FFNOUTT = (bf16*)(ws + WS_FFNOUTT);
    constexpr int I_IN = (D / 64) * (2 * FF / 32), I_OUT = (FF / 64) * (D / 32);
    for (int it = gw; it < I_IN + I_OUT; it += NGW) {
        if (it < I_IN) transpose_item(A->in.ffn_w_in + (size_t)l * D * 2 * FF, D, 2 * FF, FFNINT, scr, it, F.lane, MapIl{FF});
        else transpose_item(A->in.ffn_w_out + (size_t)l * FF * D, FF, D, FFNOUTT, scr, it - I_IN, F.lane, MapId{});
    }
}
DI void rms_rows_to_bf16(Frame& F, const float* x, const float* g, bf16* hb) {
    const int gw = blockIdx.x * NWAVES + F.wave, NGW = F.G * NWAVES;
    f32x4 gv[4];
#pragma unroll
    for (int j = 0; j < 4; ++j) gv[j] = ((const GAS f32x4*)g)[F.lane + 64 * j];
    for (int m = gw; m < M; m += NGW) {
        const GAS f32x4* xr = (const GAS f32x4*)(x + (size_t)m * D) + F.lane; f32x4 v[4]; float s = 0.f;
#pragma unroll
        for (int j = 0; j < 4; ++j) { v[j] = xr[64 * j]; s += (v[j].x * v[j].x + v[j].y * v[j].y) + (v[j].z * v[j].z + v[j].w * v[j].w); }
        const float rstd = 1.0f / sqrtf(wave_sum(s) * (1.f / D) + NORM_EPS);
        GAS v2u* o8 = (GAS v2u*)(hb + (size_t)m * D) + F.lane;
#pragma unroll
        for (int j = 0; j < 4; ++j) { v2u o; o.x = pk2(v[j].x * rstd * gv[j].x, v[j].y * rstd * gv[j].y); o.y = pk2(v[j].z * rstd * gv[j].z, v[j].w * rstd * gv[j].w); o8[64 * j] = o; }
    }
}
DI void norm_phase(Frame& F, const float* xin, float* xout, const float* f, const float* gpost, const float* gpre, bf16* hb) {
    const int gw = blockIdx.x * NWAVES + F.wave, NGW = F.G * NWAVES;
    for (int m = gw; m < M; m += NGW) {
        const GAS f32x4* fr = (const GAS f32x4*)(f + (size_t)m * D) + F.lane; const GAS f32x4* xr = (const GAS f32x4*)(xin + (size_t)m * D) + F.lane;
        f32x4 v[4], xv[4]; float s = 0.f;
#pragma unroll
        for (int j = 0; j < 4; ++j) { v[j] = fr[64 * j]; xv[j] = xr[64 * j]; s += (v[j].x * v[j].x + v[j].y * v[j].y) + (v[j].z * v[j].z + v[j].w * v[j].w); }
        const float rstd = 1.0f / sqrtf(wave_sum(s) * (1.f / D) + NORM_EPS); float s2 = 0.f;
        GAS f32x4* xo = (GAS f32x4*)(xout + (size_t)m * D) + F.lane;
#pragma unroll
        for (int j = 0; j < 4; ++j) { const f32x4 gp = ((const GAS f32x4*)gpost)[F.lane + 64 * j]; xv[j] = xv[j] + v[j] * rstd * gp; xo[64 * j] = xv[j];
            s2 += (xv[j].x * xv[j].x + xv[j].y * xv[j].y) + (xv[j].z * xv[j].z + xv[j].w * xv[j].w); }
        if (gpre) { const float rstd2 = 1.0f / sqrtf(wave_sum(s2) * (1.f / D) + NORM_EPS);
            GAS v2u* o8 = (GAS v2u*)(hb + (size_t)m * D) + F.lane;
#pragma unroll
            for (int j = 0; j < 4; ++j) { const f32x4 gq = ((const GAS f32x4*)gpre)[F.lane + 64 * j]; v2u o; o.x = pk2(xv[j].x * rstd2 * gq.x, xv[j].y * rstd2 * gq.y); o.y = pk2(xv[j].z * rstd2 * gq.z, xv[j].w * rstd2 * gq.w); o8[64 * j] = o; } }
    }
}

DI void pool_stencil(Frame& F, const bf16* POOLU, bf16* DP) {
    const int gt = blockIdx.x * (NWAVES * 64) + F.tid, NGT = F.G * NWAVES * 64;
    for (int idx = gt; idx < M * 64; idx += NGT) {
        const int t = idx >> 6, cc = idx & 63, ch0 = cc * 8, gi = cc >> 4, w = 2 << gi, pos = t & (SEQ - 1);
        const int nw = (pos + 1) < w ? (pos + 1) : w;
        float a[8], u0[8];
#pragma unroll
        for (int j = 0; j < 8; ++j) { a[j] = 0.f; u0[j] = 0.f; }
        for (int i = 0; i < nw; ++i) { const v4u v = *(const GAS v4u*)(POOLU + (size_t)(t - i) * 512 + ch0);
            const float e[8] = {bflo(v.x), bfhi(v.x), bflo(v.y), bfhi(v.y), bflo(v.z), bfhi(v.z), bflo(v.w), bfhi(v.w)};
#pragma unroll
            for (int j = 0; j < 8; ++j) { a[j] += e[j]; if (i == 0) u0[j] = e[j]; } }
        const float inv = 1.0f / (float)nw; v4u o;
        o.x = pk2(a[0] * inv - u0[0], a[1] * inv - u0[1]); o.y = pk2(a[2] * inv - u0[2], a[3] * inv - u0[3]);
        o.z = pk2(a[4] * inv - u0[4], a[5] * inv - u0[5]); o.w = pk2(a[6] * inv - u0[6], a[7] * inv - u0[7]);
        *(GAS v4u*)(DP + (size_t)t * 512 + ch0) = o;
    }
}
DI float gelu_tanh(float y) { const float u = 0.7978845608028654f * (y + 0.044715f * y * y * y); const float th = 1.0f - 2.0f * __builtin_amdgcn_rcpf(__expf(2.0f * u) + 1.0f); return 0.5f * y * (1.0f + th); }
constexpr int S5_SLD = 129, S5_XLD = 136, S5_XOFF = 69632;
DI void s5_unit(Frame& F, int b, int g, const bf16* S5U_, const bf16* S5T_, const bf16* S5P_, const bf16* S5Q_, const float* S5A_, bf16* ZB_) {
    const bf16* S5U = opq(S5U_); const bf16* S5T = opq(S5T_); const bf16* S5P = opq(S5P_); const bf16* S5Q = opq(S5Q_); const float* S5A = opq(S5A_); bf16* ZB = opq(ZB_);
    LAS float* Ssm = (LAS float*)(F.lds + RING_OFF);
    LAS bf16* XB = (LAS bf16*)(F.lds + RING_OFF + S5_XOFF);
    const int w = F.wave, lane = opqv(F.lane), fr = lane & 15, qd = lane >> 4;
    const bf16* Tg = S5T + (size_t)g * 65536; const bf16* Pg = S5P + (size_t)g * 32768; const bf16* Qg = S5Q + (size_t)g * 32768;
    const bf16* Ub = S5U + (size_t)b * SEQ * 512 + g * 16;
    f32x4 accY[2][8], accS[8];
#pragma unroll
    for (int ct = 0; ct < 8; ++ct) { accS[ct] = (f32x4){0.f, 0.f, 0.f, 0.f}; accY[0][ct] = accS[ct]; accY[1][ct] = accS[ct]; }
#pragma unroll 1
    for (int ks = 0; ks < 8; ++ks) {
        bf16x8 bfr[8];
        const int s = 2 * ks + (qd >> 1), c0 = 8 * (qd & 1);
#pragma unroll
        for (int ct = 0; ct < 8; ++ct) bfr[ct] = ldg16o(Ub + (size_t)ct * 16 * 16 * 512, (unsigned)((fr * 16 + s) * 512 + c0) * 2u);
        const bf16x8 aP = ldg16o(Pg + (size_t)(16 * w) * 256 + 32 * ks, (unsigned)(fr * 256 + 8 * qd) * 2u);
#pragma unroll
        for (int ct = 0; ct < 8; ++ct) accS[ct] = MFMA16(aP, bfr[ct], accS[ct]);
        if (ks <= w) {
            const bf16x8 aT0 = ldg16o(Tg + (size_t)(32 * w) * 256 + 32 * ks, (unsigned)(fr * 256 + 8 * qd) * 2u), aT1 = ldg16o(Tg + (size_t)(32 * w + 16) * 256 + 32 * ks, (unsigned)(fr * 256 + 8 * qd) * 2u);
#pragma unroll
            for (int ct = 0; ct < 8; ++ct) { accY[0][ct] = MFMA16(aT0, bfr[ct], accY[0][ct]); accY[1][ct] = MFMA16(aT1, bfr[ct], accY[1][ct]); }
        }
    }
#pragma unroll
    for (int ct = 0; ct < 8; ++ct)
#pragma unroll
        for (int r = 0; r < 4; ++r) Ssm[(16 * w + 4 * qd + r) * S5_SLD + 16 * ct + fr] = accS[ct][r];
    __syncthreads();
    if (F.tid < 64) { const int n = F.tid; const float ar = S5A[(g * 64 + n) * 2], ai = S5A[(g * 64 + n) * 2 + 1]; float xr = 0.f, xi = 0.f;
        for (int c = 0; c < 128; ++c) { XB[c * S5_XLD + n] = (bf16)f2bf(xr); XB[c * S5_XLD + 64 + n] = (bf16)f2bf(xi);
            const float sr = Ssm[n * S5_SLD + c], si = Ssm[(64 + n) * S5_SLD + c];
            const float nr = ar * xr - ai * xi + sr, ni = ar * xi + ai * xr + si; xr = nr; xi = ni; } }
    __syncthreads();
#pragma unroll 1
    for (int ks = 0; ks < 4; ++ks) {
        const bf16x8 aQ0 = ldg16o(Qg + (size_t)(32 * w) * 128 + 32 * ks, (unsigned)(fr * 128 + 8 * qd) * 2u), aQ1 = ldg16o(Qg + (size_t)(32 * w + 16) * 128 + 32 * ks, (unsigned)(fr * 128 + 8 * qd) * 2u);
#pragma unroll
        for (int ct = 0; ct < 8; ++ct) { const bf16x8 bx = *(const LAS bf16x8*)(XB + (16 * ct + fr) * S5_XLD + 32 * ks + 8 * qd);
            accY[0][ct] = MFMA16(aQ0, bx, accY[0][ct]); accY[1][ct] = MFMA16(aQ1, bx, accY[1][ct]); }
    }
#pragma unroll
    for (int rt = 0; rt < 2; ++rt)
#pragma unroll
        for (int ct = 0; ct < 8; ++ct) { const int tok = (16 * ct + fr) * 16 + 2 * w + rt; const f32x4 y = accY[rt][ct];
            v2u o; o.x = pk2(gelu_tanh(y[0]), gelu_tanh(y[1])); o.y = pk2(gelu_tanh(y[2]), gelu_tanh(y[3]));
            *(GAS v2u*)(ZB + (size_t)(b * SEQ + tok) * 512 + g * 16 + 4 * qd) = o; }
    __syncthreads();
}
constexpr int AT_BIAS_OFF = 0, AT_SEL_OFF = 8192, AT_V_OFF = 24576, AT_VLD = 144  ;
DI s16x4 vtr(const LAS unsigned char* p) { return __builtin_bit_cast(s16x4, __builtin_amdgcn_ds_read_tr16_b64_v4i16((LAS v4i16_t*)p)); }
#define MEMBAR() asm volatile("" ::: "memory")
DI int row16_sum(int x) {
    x += __builtin_amdgcn_update_dpp(0, x, 0xB1, 0xF, 0xF, true);
    x += __builtin_amdgcn_update_dpp(0, x, 0x4E, 0xF, 0xF, true);
    x += __builtin_amdgcn_update_dpp(0, x, 0x141, 0xF, 0xF, true);
    x += __builtin_amdgcn_update_dpp(0, x, 0x140, 0xF, 0xF, true);
    return x; }
DI int xor16_i(int x) { return __builtin_amdgcn_ds_swizzle(x, 0x401F); }
DI float xor16_f(float x) { return __int_as_float(__builtin_amdgcn_ds_swizzle(__float_as_int(x), 0x401F)); }
DI int half32_sum(int x) { x = row16_sum(x); return x + xor16_i(x); }
DI void attn_unit(Frame& F, int b, int tile, const bf16* QI_, const bf16* KVX_, bf16* QA_, const float* BIAS_) {
    const bf16* QI = opq(QI_); const bf16* KVX = opq(KVX_); bf16* QA = opq(QA_); const float* BIAS = opq(BIAS_);
    LAS float* biasL = (LAS float*)(F.lds + RING_OFF + AT_BIAS_OFF);
    const int w = F.wave;
    LAS unsigned short* selw = (LAS unsigned short*)(F.lds + RING_OFF + AT_SEL_OFF) + w * 512;
    LAS unsigned char* kbuf = F.lds + RING_OFF + AT_V_OFF;
    for (int i = F.tid; i < 2048; i += NWAVES * 64) biasL[i] = BIAS[i];
    { LAS v4u* z = (LAS v4u*)selw; z[F.lane] = (v4u){0u, 0u, 0u, 0u}; }
    const size_t rowb = (size_t)b * SEQ;
    const int tb = tile * 16 + 2 * w;
    const int ntile = (tile * 16 + 15) / 256 + 1;
    const int nkp = 8 * ntile;
    unsigned key[64];
    int nsel = 0; unsigned theta = 0u;
#ifndef AT_PROBE
#define AT_PROBE 0
#endif
    _Pragma("unroll 1") for (int rep_abc = 0; rep_abc < (AT_PROBE == 1 ? 2 : 1); ++rep_abc) {
    {
        const int lane = opqv(F.lane), fr = lane & 15, qd = lane >> 4, tq = tb + (qd >> 1), odd = qd & 1;
        const int tid = opqv(F.tid);
        bf16x8 aQ[2];
#pragma unroll
        for (int ks = 0; ks < 2; ++ks) aQ[ks] = ldg16(QI + (rowb + tb + (fr >> 3)) * 512 + (fr & 7) * 64 + 32 * ks + 8 * qd);
        const v2u wraw = *(const GAS v2u*)(KVX + (rowb + tq) * 256 + 192 + 4 * odd);
        const float wv[4] = {bflo(wraw.x), bfhi(wraw.x), bflo(wraw.y), bfhi(wraw.y)};
        const unsigned goff = (unsigned)((tid >> 3) * 256 + (tid & 7) * 8) * 2u, loff = (unsigned)((tid >> 3) * 144 + (tid & 7) * 16);
        v4u stg[4];
        const bf16* gki = KVX + rowb * 256 + 128;
#pragma unroll
        for (int i = 0; i < 4; ++i) stg[i] = ldg16u(gki + (size_t)(64 * i) * 256, goff);
#pragma unroll
        for (int i = 0; i < 4; ++i) *(LAS v4u*)(kbuf + 64 * i * 144 + loff) = stg[i];
        __syncthreads();
        const unsigned roff = (unsigned)(fr * 144 + qd * 16);
#pragma unroll 1
        for (int kt = 0; kt < ntile; ++kt) {
            const bool more = kt + 1 < ntile;
            if (more) {
#pragma unroll
                for (int i = 0; i < 4; ++i) stg[i] = ldg16u(gki + (size_t)(256 * (kt + 1) + 64 * i) * 256, goff); }
            const LAS unsigned char* kb = kbuf + (kt & 1) * (256 * 144) + roff;
            unsigned tmp[8];
#pragma unroll
            for (int j = 0; j < 8; ++j) {
                const bf16x8 e0 = *(const LAS bf16x8*)(kb + (32 * j) * 144), e1 = *(const LAS bf16x8*)(kb + (32 * j) * 144 + 64);
                const bf16x8 o0 = *(const LAS bf16x8*)(kb + (32 * j + 16) * 144), o1 = *(const LAS bf16x8*)(kb + (32 * j + 16) * 144 + 64);
                f32x4 cE = (f32x4){0.f, 0.f, 0.f, 0.f}, cO = cE;
                cE = MFMA16(aQ[0], e0, cE); cE = MFMA16(aQ[1], e1, cE); cO = MFMA16(aQ[0], o0, cO); cO = MFMA16(aQ[1], o1, cO);
                float sE = 0.f, sO = 0.f;
#pragma unroll
                for (int r = 0; r < 4; ++r) { sE += wv[r] * fmaxf(cE[r], 0.f); sO += wv[r] * fmaxf(cO[r], 0.f); }
                sE += xor16_f(sE); sO += xor16_f(sO);
                float s = odd ? sO : sE; s += 0.0f;
                const unsigned bits = __float_as_uint(s); const unsigned sk = bits ^ ((unsigned)((int)bits >> 31) | 0x80000000u);
                tmp[j] = (256 * kt + 32 * j + 16 * odd + fr <= tq) ? sk : 0u;
            }
#define KEYCASE(c) case c: _Pragma("unroll") for (int j = 0; j < 8; ++j) key[8 * c + j] = tmp[j]; break;
            switch (kt) { KEYCASE(0) KEYCASE(1) KEYCASE(2) KEYCASE(3) KEYCASE(4) KEYCASE(5) KEYCASE(6) default: _Pragma("unroll") for (int j = 0; j < 8; ++j) key[56 + j] = tmp[j]; break; }
#undef KEYCASE
            if (more) {
#pragma unroll
                for (int i = 0; i < 4; ++i) *(LAS v4u*)(kbuf + ((kt + 1) & 1) * (256 * 144) + 64 * i * 144 + loff) = stg[i]; }
            __syncthreads();
        }
    }
    theta = 0u; bool fin = false;
#pragma unroll 1
    for (int bit = 31; bit >= 0; --bit) {
        const unsigned cand = theta | (1u << bit); int cnt = 0;
#pragma unroll
        for (int ch = 0; ch < 8; ++ch) if (ch * 8 < nkp) {
#pragma unroll
            for (int j = 0; j < 8; ++j) cnt += (key[ch * 8 + j] >= cand) ? 1 : 0; }
        cnt = half32_sum(cnt);
        if (!fin && cnt >= 256) theta = cand;
        fin = fin || (cnt == 256);
        if (__all(fin)) break;
    }
    {
        const int lane = opqv(F.lane), fr = lane & 15, qd = lane >> 4, odd = qd & 1;
        int cgt = 0;
#pragma unroll
        for (int ch = 0; ch < 8; ++ch) if (ch * 8 < nkp) {
#pragma unroll
            for (int j = 0; j < 8; ++j) cgt += (key[ch * 8 + j] > theta) ? 1 : 0; }
        cgt = half32_sum(cgt);
        const int quota = (theta == 0u) ? 0 : (256 - cgt);
        int base = 0, eqseen = 0; const unsigned below = (1u << (lane & 31)) - 1u; const int sh = 32 * (qd >> 1);
        LAS unsigned short* sl = selw + (qd >> 1) * 256;
#pragma unroll 1
        for (int ch = 0; ch * 8 < nkp; ++ch) {
            unsigned tmp[8];
#define KEYCASE(c) case c: _Pragma("unroll") for (int j = 0; j < 8; ++j) tmp[j] = key[8 * c + j]; break;
            switch (ch) { KEYCASE(0) KEYCASE(1) KEYCASE(2) KEYCASE(3) KEYCASE(4) KEYCASE(5) KEYCASE(6) default: _Pragma("unroll") for (int j = 0; j < 8; ++j) tmp[j] = key[56 + j]; break; }
#undef KEYCASE
#pragma unroll
            for (int j = 0; j < 8; ++j) {
                const bool gtk = tmp[j] > theta, eqk = (tmp[j] == theta) && (theta != 0u);
                const unsigned long long be = __ballot(eqk); const unsigned e32 = (unsigned)(be >> sh); const int pe = __popc(e32 & below);
                const bool take = gtk || (eqk && (eqseen + pe) < quota);
                const unsigned long long bt = __ballot(take); const unsigned t32 = (unsigned)(bt >> sh); const int pt = __popc(t32 & below);
                if (take) sl[base + pt] = (unsigned short)(256 * ch + 32 * j + 16 * odd + fr);
                base += __popc(t32); eqseen += __popc(e32);
            }
        }
        nsel = base;
    }
    }
#pragma unroll 1
    for (int qq2 = 0; qq2 < (AT_PROBE == 2 ? 4 : 2); ++qq2) { const int qq = qq2 & 1;
        const int lane = opqv(F.lane), fr = lane & 15, qd = lane >> 4;
        LAS unsigned char* Vs = F.lds + RING_OFF + AT_V_OFF + w * (64 * AT_VLD);
        const int t = tb + qq; const int ns = __shfl(nsel, 32 * qq);
        const LAS unsigned short* sl = selw + qq * 256;
        bf16* qrow = QA + (rowb + t) * 1024; bf16* orow = (qq2 < 2) ? qrow : (bf16*)((unsigned char*)QA + (WS_END - WS_Q)) + (size_t)(t & 2047) * 1024;
        bf16x8 bq[2];
#pragma unroll
        for (int ks = 0; ks < 2; ++ks) bq[ks] = ldg16(qrow + fr * 64 + 32 * ks + 8 * qd);
        f32x4 st[16];
#pragma unroll
        for (int blk = 0; blk < 16; ++blk) { const int kidx = sl[16 * blk + fr];
            const unsigned ko = (unsigned)(kidx * 256 + 8 * qd) * 2u; const bf16x8 a0 = ldg16o(KVX + rowb * 256, ko), a1 = ldg16o(KVX + rowb * 256 + 32, ko);
            f32x4 c = (f32x4){0.f, 0.f, 0.f, 0.f}; c = MFMA16(a0, bq[0], c); c = MFMA16(a1, bq[1], c); st[blk] = c;
            if ((blk & 7) == 7) MEMBAR(); }
        float mx = -3.0e38f;
#pragma unroll
        for (int blk = 0; blk < 16; ++blk) { const u16x4 k4 = *(const LAS u16x4*)(sl + 16 * blk + 4 * qd);
#pragma unroll
            for (int r = 0; r < 4; ++r) { int dist = t - (int)k4[r]; dist = dist < 0 ? 0 : (dist > 127 ? 127 : dist);
                float lg = st[blk][r] + biasL[dist * 16 + fr]; if (16 * blk + 4 * qd + r >= ns) lg = -1.0e30f; st[blk][r] = lg; mx = fmaxf(mx, lg); } }
        mx = fmaxf(mx, __shfl_xor(mx, 16)); mx = fmaxf(mx, __shfl_xor(mx, 32));
        float sum = 0.f;
#pragma unroll
        for (int blk = 0; blk < 16; ++blk)
#pragma unroll
            for (int r = 0; r < 4; ++r) { const float p = __expf(st[blk][r] - mx); st[blk][r] = p; sum += p; }
        sum += __shfl_xor(sum, 16); sum += __shfl_xor(sum, 32);
        const float inv = 1.0f / sum;
        f32x4 o[4];
#pragma unroll
        for (int nb = 0; nb < 4; ++nb) o[nb] = (f32x4){0.f, 0.f, 0.f, 0.f};
        v4u vv[8];
#pragma unroll
        for (int i = 0; i < 8; ++i) { const int piece = lane + 64 * i, row = piece >> 3, pc = piece & 7; const int kidx = sl[row];
            vv[i] = ldg16u(KVX + rowb * 256 + 64, (unsigned)(kidx * 256 + 8 * pc) * 2u); }
#pragma unroll
        for (int vr = 0; vr < 4; ++vr) {
#pragma unroll
            for (int i = 0; i < 8; ++i) { const int piece = lane + 64 * i, row = piece >> 3, pc = piece & 7; *(LAS v4u*)(Vs + row * AT_VLD + pc * 16) = vv[i]; }
            if (vr < 3) {
#pragma unroll
                for (int i = 0; i < 8; ++i) { const int piece = lane + 64 * i, row = piece >> 3, pc = piece & 7; const int kidx = sl[64 * (vr + 1) + row];
                    vv[i] = ldg16u(KVX + rowb * 256 + 64, (unsigned)(kidx * 256 + 8 * pc) * 2u); } }
#pragma unroll
            for (int kk = 0; kk < 2; ++kk) {
                const f32x4 p0 = st[4 * vr + 2 * kk] * inv, p1 = st[4 * vr + 2 * kk + 1] * inv;
                const v4u pw = (v4u){pk2(p0[0], p0[1]), pk2(p0[2], p0[3]), pk2(p1[0], p1[1]), pk2(p1[2], p1[3])};
                const bf16x8 pa = __builtin_bit_cast(bf16x8, pw);
                const int q4 = fr >> 2, p4 = fr & 3;
#pragma unroll
                for (int nb = 0; nb < 4; ++nb) {
                    const s16x4 lo = vtr(Vs + (32 * kk + 4 * qd + q4) * AT_VLD + (16 * nb + 4 * p4) * 2);
                    const s16x4 hi = vtr(Vs + (32 * kk + 16 + 4 * qd + q4) * AT_VLD + (16 * nb + 4 * p4) * 2);
                    const bf16x8 bv = (bf16x8){lo[0], lo[1], lo[2], lo[3], hi[0], hi[1], hi[2], hi[3]};
                    o[nb] = MFMA16(pa, bv, o[nb]);
                }
            }
        }
#pragma unroll
        for (int nb = 0; nb < 4; ++nb)
#pragma unroll
            for (int r = 0; r < 4; ++r) orow[(4 * qd + r) * 64 + 16 * nb + fr] = (bf16)f2bf(o[nb][r]);
    }
    __syncthreads();
}

#ifndef PH_MASK
#define PH_MASK 0x1ff
#endif
#define PH_ON(k) (((PH_MASK) >> (k)) & 1)
#ifndef PH_DUP
#define PH_DUP 0
#endif
#define NREP(k) ((((PH_DUP) >> (k)) & 1) ? 2 : 1)
#ifndef MK_SP2
#define MK_SP2 true
#endif
#ifndef MK_ALIGN
#define MK_ALIGN true
#endif
__global__ void __launch_bounds__(NWAVES * 64, 2) hybrid_fwd(Args args) {
    extern __shared__ __attribute__((aligned(16))) unsigned char lds[];
#define MKFRAME() Frame F; F.lds = (LAS unsigned char*)lds; F.tid = opqv((int)threadIdx.x); F.lane = F.tid & 63; F.wave = __builtin_amdgcn_readfirstlane(F.tid >> 6); F.G = gridDim.x
    const int lo = args.ph_lo, hi = args.ph_hi;
    {   KArgs A = kargs(); gu32* ctl = (gu32*)(A->ws + WS_CTL); MKFRAME();
        for (int u = F.tid; u < (LDS_BYTES - LDSCTL_OFF) / 4; u += NWAVES * 64) ((LAS unsigned*)(F.lds + LDSCTL_OFF))[u] = 0u;
        __syncthreads();
        volatile LAS unsigned* MISC = (volatile LAS unsigned*)(F.lds + MISC_OFF);
        (void)xcd_barrier_post((unsigned*)(ctl + CW_BAR), MISC + 8); }
#define IN(k) (lo <= (k) && (k) < hi)
#define BOTH(k) (IN(k) && IN((k) + 1))
#define GRID_BAR() do { KArgs Ab = kargs(); XcdBarrier bar; bar.bar = (unsigned*)((gu32*)(Ab->ws + WS_CTL) + CW_BAR); bar.x = xb_xcc_id(); bar.st = (volatile LAS unsigned*)((LAS unsigned char*)lds + MISC_OFF) + 8; xcd_barrier(bar); } while (0)
#define WSP(T, off) ((T*)(ws + (off)))

    if (PH_ON(0) && IN(0)) { KArgs A = kargs(); unsigned char* ws = A->ws; MKFRAME();
        _Pragma("unroll 1") for (int rep = 0; rep < NREP(11); ++rep) convert_A(F, A, ws, 0);
        rms_rows_to_bf16(F, A->in.x, A->in.n_mix_pre, WSP(bf16, WS_HB)); if (BOTH(0)) GRID_BAR(); }

#pragma unroll 1
    for (int l = 0; l < NLAYER; ++l) {
        const int pb = 1 + 8 * l;
        if (PH_ON(1) && IN(pb)) { KArgs A = kargs(); unsigned char* ws = A->ws; MKFRAME();
            pg8::Gemm g{WSP(bf16, WS_HB), WSP(bf16, WS_WINT), M, N1P, D}; pg8::StaticOrder S; S.init(M, N1P, F.G, (int)blockIdx.x);
            pg8::EpiRoute E{WSP(bf16, WS_POOLU), WSP(bf16, WS_S5U), WSP(bf16, WS_Q), WSP(bf16, WS_QI), WSP(bf16, WS_KVX), WSP(bf16, WS_GATES)};
            _Pragma("unroll 1") for (int rep = 0; rep < NREP(1); ++rep)
            pg8::gemm_phase<pg8::EpiRoute, pg8::StaticOrder, MK_ALIGN, MK_SP2>(F.lds + RING_OFF, g, S, E);
            if (BOTH(pb)) GRID_BAR();
        }
        if (PH_ON(2) && IN(pb + 1)) { KArgs A = kargs(); unsigned char* ws = A->ws; MKFRAME();
#ifndef NO_POOL
            _Pragma("unroll 1") for (int rep = 0; rep < NREP(9); ++rep)
            pool_stencil(F, WSP(bf16, WS_POOLU), WSP(bf16, WS_DP));
#endif
#ifndef NO_S5
            _Pragma("unroll 1") for (int rep = 0; rep < NREP(10); ++rep)
#pragma unroll 1
            for (int u = blockIdx.x; u < 256; u += F.G) s5_unit(F, u & 7, u >> 3, WSP(bf16, WS_S5U), WSP(bf16, WS_S5T), WSP(bf16, WS_S5P), WSP(bf16, WS_S5Q), WSP(float, WS_S5A), WSP(bf16, WS_ZB));
#endif
#ifndef NO_ATTN
#pragma unroll 1
            for (int u4 = 4 * blockIdx.x; u4 < 1024; u4 += 4 * F.G) {
#pragma unroll 1
                for (int h = 0; h < 4; ++h) { const int u = u4 >> 2, b = u & 7, j = u >> 3;
                    const int tile = (h & 2 ? 64 : 0) + ((h & 1) ? 63 - j : j);
                    attn_unit(F, b, tile, WSP(bf16, WS_QI), WSP(bf16, WS_KVX), WSP(bf16, WS_Q), WSP(float, WS_BIAS)); } }
#endif
            if (BOTH(pb + 1)) GRID_BAR();
        }
        if (PH_ON(3) && IN(pb + 2)) {
          _Pragma("unroll 1") for (int rep = 0; rep < NREP(3); ++rep) {
            if (rep) { VM_WAIT(); __builtin_amdgcn_fence(__ATOMIC_ACQUIRE, "agent"); VM_WAIT(); __syncthreads(); }
            { KArgs A = kargs(); unsigned char* ws = A->ws; MKFRAME();
              pg8::Gemm g{WSP(bf16, WS_ZB), WSP(bf16, WS_GLUT), M, 2048, 512}; pg8::PairOrder S; S.base.init(M, D, F.G, (int)blockIdx.x);
              pg8::EpiGlu E{WSP(bf16, WS_MERGED), WSP(bf16, WS_GATES)};
              pg8::gemm_phase<pg8::EpiGlu, pg8::PairOrder, MK_ALIGN, MK_SP2>(F.lds + RING_OFF, g, S, E); }
            VM_WAIT(); __builtin_amdgcn_fence(__ATOMIC_ACQUIRE, "agent"); VM_WAIT(); __syncthreads();
            { KArgs A = kargs(); unsigned char* ws = A->ws; MKFRAME();
              pg8::Gemm g{WSP(bf16, WS_DP), WSP(bf16, WS_POOLET), M, D, 512}; pg8::StaticOrder S; S.init(M, D, F.G, (int)blockIdx.x);
              pg8::EpiAccum<0> E{WSP(bf16, WS_MERGED), WSP(bf16, WS_GATES)};
              pg8::gemm_phase<pg8::EpiAccum<0>, pg8::StaticOrder, MK_ALIGN, MK_SP2>(F.lds + RING_OFF, g, S, E); }
            VM_WAIT(); __builtin_amdgcn_fence(__ATOMIC_ACQUIRE, "agent"); VM_WAIT(); __syncthreads();
            { KArgs A = kargs(); unsigned char* ws = A->ws; MKFRAME();
              pg8::Gemm g{WSP(bf16, WS_Q), WSP(bf16, WS_ATTNOT), M, D, D}; pg8::StaticOrder S; S.init(M, D, F.G, (int)blockIdx.x);
              pg8::EpiAccum<1024> E{WSP(bf16, WS_MERGED), WSP(bf16, WS_GATES)};
              pg8::gemm_phase<pg8::EpiAccum<1024>, pg8::StaticOrder, MK_ALIGN, MK_SP2>(F.lds + RING_OFF, g, S, E); }
          }
            if (BOTH(pb + 2)) GRID_BAR();
        }
        if (PH_ON(4) && IN(pb + 3)) { KArgs A = kargs(); unsigned char* ws = A->ws; MKFRAME();
            pg8::Gemm g{WSP(bf16, WS_MERGED), WSP(bf16, WS_WOUTT), M, D, D}; pg8::StaticOrder S; S.init(M, D, F.G, (int)blockIdx.x);
            pg8::EpiF32 E{WSP(float, WS_F), D};
            _Pragma("unroll 1") for (int rep = 0; rep < NREP(4); ++rep)
            pg8::gemm_phase<pg8::EpiF32, pg8::StaticOrder, MK_ALIGN, MK_SP2>(F.lds + RING_OFF, g, S, E);
            if (BOTH(pb + 3)) GRID_BAR();
        }
        if (PH_ON(5) && IN(pb + 4)) { KArgs A = kargs(); unsigned char* ws = A->ws; MKFRAME();
            _Pragma("unroll 1") for (int rep = 0; rep < NREP(12); ++rep) convert_B(F, A, ws, l);
            norm_phase(F, l == 0 ? A->in.x : (const float*)A->out, A->out, WSP(float, WS_F), A->in.n_mix_post + l * D, A->in.n_ffn_pre + l * D, WSP(bf16, WS_HB));
            if (BOTH(pb + 4)) GRID_BAR();
        }
        if (PH_ON(6) && IN(pb + 5)) { KArgs A = kargs(); unsigned char* ws = A->ws; MKFRAME();
            pg8::Gemm g{WSP(bf16, WS_HB), WSP(bf16, WS_FFNINT), M, 2 * FF, D}; pg8::StaticOrder S; S.init(M, 2 * FF, F.G, (int)blockIdx.x);
            pg8::EpiSwiglu E{WSP(bf16, WS_HID), FF};
            _Pragma("unroll 1") for (int rep = 0; rep < NREP(6); ++rep)
            pg8::gemm_phase<pg8::EpiSwiglu, pg8::StaticOrder, MK_ALIGN, MK_SP2>(F.lds + RING_OFF, g, S, E);
            if (BOTH(pb + 5)) GRID_BAR();
        }
        if (PH_ON(7) && IN(pb + 6)) { KArgs A = kargs(); unsigned char* ws = A->ws; MKFRAME();
            pg8::Gemm g{WSP(bf16, WS_HID), WSP(bf16, WS_FFNOUTT), M, D, FF}; pg8::StaticOrder S; S.init(M, D, F.G, (int)blockIdx.x);
            pg8::EpiF32 E{WSP(float, WS_F), D};
            _Pragma("unroll 1") for (int rep = 0; rep < NREP(7); ++rep)
            pg8::gemm_phase<pg8::EpiF32, pg8::StaticOrder, MK_ALIGN, MK_SP2>(F.lds + RING_OFF, g, S, E);
            if (BOTH(pb + 6)) GRID_BAR();
        }
        if (PH_ON(8) && IN(pb + 7)) { KArgs A = kargs(); unsigned char* ws = A->ws; MKFRAME();
            if (l + 1 < NLAYER) { _Pragma("unroll 1") for (int rep = 0; rep < NREP(11); ++rep) convert_A(F, A, ws, l + 1); }
            norm_phase(F, (const float*)A->out, A->out, WSP(float, WS_F), A->in.n_ffn_post + l * D, (l + 1 < NLAYER) ? A->in.n_mix_pre + (l + 1) * D : (const float*)nullptr, WSP(bf16, WS_HB));
            if (BOTH(pb + 7)) GRID_BAR();
        }
    }
#undef WSP
#undef IN
#undef BOTH
#undef GRID_BAR
}

#ifndef MK_ONE_LAUNCH
#define MK_ONE_LAUNCH 1
#endif
extern "C" void kernel_launch(void* const* d_in, const int* in_sizes, int n_in, void* d_out, int out_size, void* d_ws, size_t ws_size, hipStream_t stream) {
    static int grid = 0;
    if (grid == 0) {
        if (n_in != 23 || in_sizes[0] != M * D || out_size != M * D || ws_size < WS_END) { fprintf(stderr, "kernel_launch: unexpected shapes (n_in %d, in0 %d, out %d, ws %zu); nothing launched\n", n_in, n_in > 0 ? in_sizes[0] : -1, out_size, ws_size); grid = -1; return; }
        int dev = 0, cus = 0, per_cu = 0;
        if (hipGetDevice(&dev) != hipSuccess || hipDeviceGetAttribute(&cus, hipDeviceAttributeMultiprocessorCount, dev) != hipSuccess) { grid = -1; return; }
        if (hipFuncSetAttribute((const void*)hybrid_fwd, hipFuncAttributeMaxDynamicSharedMemorySize, LDS_BYTES) != hipSuccess) { fprintf(stderr, "kernel_launch: hipFuncSetAttribute failed\n"); grid = -1; return; }
        if (hipOccupancyMaxActiveBlocksPerMultiprocessor(&per_cu, (const void*)hybrid_fwd, NWAVES * 64, LDS_BYTES) != hipSuccess || per_cu < 1) { fprintf(stderr, "kernel_launch: occupancy query says %d\n", per_cu); per_cu = 1; }
        (void)hipGetLastError();
        grid = cus;
    }
    if (grid < 0) return;
    if (hipMemsetAsync((char*)d_ws + WS_CTL, 0, CTL_ZERO_BYTES, stream) != hipSuccess) return;
    Args a{};
    const float** ip = (const float**)&a.in;
    for (int i = 0; i < 23; ++i) ip[i] = (const float*)d_in[i];
    a.out = (float*)d_out; a.ws = (unsigned char*)d_ws;
#if MK_ONE_LAUNCH
    a.ph_lo = 0; a.ph_hi = NPHASE;
    hipLaunchKernelGGL(hybrid_fwd, dim3(grid), dim3(NWAVES * 64), LDS_BYTES, stream, a);
#else
    for (int ph = 0; ph < NPHASE; ++ph) { a.ph_lo = ph; a.ph_hi = ph + 1;
        hipLaunchKernelGGL(hybrid_fwd, dim3(grid), dim3(NWAVES * 64), LDS_BYTES, stream, a); }
#endif
}
```

```cpp
#include <hip/hip_runtime.h>
#include <cstdio>
#include <cstdint>
namespace pg8 {
#define PG8_LAS __attribute__((address_space(3)))
typedef unsigned short bf16_t;
typedef short bf16x8 __attribute__((ext_vector_type(8)));
typedef float f32x4 __attribute__((ext_vector_type(4)));
typedef unsigned u32x4 __attribute__((ext_vector_type(4)));
constexpr int BM = 256, BK = 64, HALF = 128, HTB = HALF * BK * 2  , STAGE_BYTES = 8 * HTB, NXCD = 8, WGM = 8;

__host__ __device__ __forceinline__ int lds_byte(int r, int c) { const int st = (r >> 4) * 2 + (c >> 5), rr = r & 15, cc = c & 31, ob = rr * 64 + cc * 2; return st * 1024 + (ob ^ (((ob >> 9) & 1) << 5)); }
__host__ __device__ __forceinline__ void stage_rc(int b, int& R, int& C) { const int st = b / 1024, sb = b % 1024, swz = sb ^ (((sb >> 9) & 1) << 5); R = (st >> 1) * 16 + swz / 64; C = (st & 1) * 32 + (swz % 64) / 2; }
__host__ __device__ __forceinline__ int perm32(int rho) { const int n = rho >> 4, i = rho & 15; return 8 * (i >> 2) + 4 * n + (i & 3); }

struct Unit { int pm, pn; };
struct Gemm { const bf16_t* A; const bf16_t* Bt; int M, N, K; };

struct StaticOrder {
    int nM, nN, nwg, G, c;
    __host__ __device__ void init(int M, int N, int G_, int c_) { nM = M / BM; nN = N / BM; nwg = nM * nN; G = G_; c = c_; }
    __host__ __device__ bool next(int i, Unit& u) const {
        const long L = (long)i * G + c; if (L >= nwg) return false;
        int wgid = (int)L; { const int q = nwg / NXCD, r = nwg % NXCD, xcd = wgid % NXCD, off = wgid / NXCD; wgid = (xcd < r ? xcd * (q + 1) : r * (q + 1) + (xcd - r) * q) + off; }
        const int nig = WGM * nN, gid = wgid / nig, fm = gid * WGM, gsz = (nM - fm) < WGM ? (nM - fm) : WGM;
        u.pm = fm + ((wgid % nig) % gsz); u.pn = (wgid % nig) / gsz; return true;
    }
    __device__ __forceinline__ void a_ready(const Unit&) const {}
    __device__ __forceinline__ void done(const Unit&) const {}
};

__device__ __forceinline__ unsigned cvt_pk_bf16(float lo, float hi) { unsigned r; asm volatile("v_cvt_pk_bf16_f32 %0, %1, %2" : "=v"(r) : "v"(lo), "v"(hi)); return r; }
typedef float f32x2 __attribute__((ext_vector_type(2)));
__device__ __forceinline__ float sigm(float x) { return __builtin_amdgcn_rcpf(1.0f + __expf(-x)); }
__device__ __forceinline__ float bf_lo(unsigned w) { return __uint_as_float(w << 16); }
__device__ __forceinline__ float bf_hi(unsigned w) { return __uint_as_float(w & 0xffff0000u); }
__device__ __forceinline__ u32x4 pack8(const f32x4& v0, const f32x4& v1) { u32x4 w; w.x = cvt_pk_bf16(v0[0], v0[1]); w.y = cvt_pk_bf16(v0[2], v0[3]); w.z = cvt_pk_bf16(v1[0], v1[1]); w.w = cvt_pk_bf16(v1[2], v1[3]); return w; }

struct EpiF32 {
    static constexpr bool PERM = false, AFTER_DRAIN = false;
    float* C; int ldc;
    __device__ __forceinline__ void operator()(const f32x4 (&acc)[2][2][4][2], const Unit& u, int wr, int wc, int fr, int fq) const {
        const int row0 = u.pm * BM + wr * 64 + fr, col0 = u.pn * BM + wc * 32 + 4 * fq;
#pragma unroll
        for (int ai = 0; ai < 2; ++ai)
#pragma unroll
            for (int m = 0; m < 4; ++m) { float* rowp = C + (size_t)(row0 + ai * HALF + m * 16) * ldc + col0;
#pragma unroll
                for (int bj = 0; bj < 2; ++bj)
#pragma unroll
                    for (int n = 0; n < 2; ++n) *(f32x4*)(rowp + bj * HALF + n * 16) = acc[ai][bj][m][n]; }
    }
};
struct EpiRoute {
    static constexpr bool PERM = true, AFTER_DRAIN = false;
    bf16_t *poolu, *s5u, *q, *qi, *kvx, *gates;
    __device__ __forceinline__ void operator()(const f32x4 (&acc)[2][2][4][2], const Unit& u, int wr, int wc, int fr, int fq) const {
        const int row0 = u.pm * BM + wr * 64 + fr; const int pn = u.pn;
        bf16_t* base; int ld, colt, mode = 0;
        if (pn < 2) { base = poolu; ld = 512; colt = pn * 256; }
        else if (pn < 4) { base = s5u; ld = 512; colt = (pn - 2) * 256; }
        else if (pn < 8) { base = q; ld = 1024; colt = (pn - 4) * 256; mode = 2; }
        else if (pn < 10) { base = qi; ld = 512; colt = (pn - 8) * 256; }
        else if (pn == 10) { base = kvx; ld = 256; colt = 0; }
        else { base = gates; ld = 3072; colt = (pn - 11) * 256; mode = 1; }
        const int col0 = colt + wc * 32 + 8 * fq;
#pragma unroll
        for (int ai = 0; ai < 2; ++ai)
#pragma unroll
            for (int m = 0; m < 4; ++m) { bf16_t* rowp = base + (size_t)(row0 + ai * HALF + m * 16) * ld + col0;
#pragma unroll
                for (int bj = 0; bj < 2; ++bj) { f32x4 v0 = acc[ai][bj][m][0], v1 = acc[ai][bj][m][1];
                    if (mode == 1) {
#pragma unroll
                        for (int j = 0; j < 4; ++j) { v0[j] = sigm(v0[j]); v1[j] = sigm(v1[j]); } }
                    else if (mode == 2) { v0 = v0 * 0.125f; v1 = v1 * 0.125f; }
                    *(u32x4*)(rowp + bj * HALF) = pack8(v0, v1); } }
    }
};
struct EpiGlu {
    static constexpr bool PERM = true, AFTER_DRAIN = false;
    bf16_t* merged; const bf16_t* gates;
    __device__ __forceinline__ void operator()(const f32x4 (&acc)[2][2][4][2], const Unit& u, int wr, int wc, int fr, int fq) const {
        const int row0 = u.pm * BM + wr * 64 + fr, col0 = u.pn * HALF + wc * 32 + 8 * fq;
#pragma unroll
        for (int ai = 0; ai < 2; ++ai)
#pragma unroll
            for (int m = 0; m < 4; ++m) { const size_t row = (size_t)(row0 + ai * HALF + m * 16);
                const u32x4 g = *(const u32x4*)(gates + row * 3072 + 2048 + col0);
                f32x4 a0 = acc[ai][0][m][0], a1 = acc[ai][0][m][1]; const f32x4 s0 = acc[ai][1][m][0], s1 = acc[ai][1][m][1];
#pragma unroll
                for (int j = 0; j < 4; ++j) { a0[j] *= sigm(s0[j]); a1[j] *= sigm(s1[j]); }
                a0[0] *= bf_lo(g.x); a0[1] *= bf_hi(g.x); a0[2] *= bf_lo(g.y); a0[3] *= bf_hi(g.y);
                a1[0] *= bf_lo(g.z); a1[1] *= bf_hi(g.z); a1[2] *= bf_lo(g.w); a1[3] *= bf_hi(g.w);
                *(u32x4*)(merged + row * 1024 + col0) = pack8(a0, a1);
                asm volatile("" ::: "memory"); }
    }
};
template <int GOFF> struct EpiAccum {
    static constexpr bool PERM = true, AFTER_DRAIN = false;
    bf16_t* merged; const bf16_t* gates;
    __device__ __forceinline__ void operator()(const f32x4 (&acc)[2][2][4][2], const Unit& u, int wr, int wc, int fr, int fq) const {
        const int row0 = u.pm * BM + wr * 64 + fr, col0 = u.pn * BM + wc * 32 + 8 * fq;
#pragma unroll
        for (int ai = 0; ai < 2; ++ai)
#pragma unroll
            for (int m = 0; m < 4; ++m) { const size_t row = (size_t)(row0 + ai * HALF + m * 16);
#pragma unroll
                for (int bj = 0; bj < 2; ++bj) { const int c = col0 + bj * HALF;
                    const u32x4 g = *(const u32x4*)(gates + row * 3072 + GOFF + c); const u32x4 o = *(const u32x4*)(merged + row * 1024 + c);
                    f32x4 a0 = acc[ai][bj][m][0], a1 = acc[ai][bj][m][1];
                    a0[0] = a0[0] * bf_lo(g.x) + bf_lo(o.x); a0[1] = a0[1] * bf_hi(g.x) + bf_hi(o.x); a0[2] = a0[2] * bf_lo(g.y) + bf_lo(o.y); a0[3] = a0[3] * bf_hi(g.y) + bf_hi(o.y);
                    a1[0] = a1[0] * bf_lo(g.z) + bf_lo(o.z); a1[1] = a1[1] * bf_hi(g.z) + bf_hi(o.z); a1[2] = a1[2] * bf_lo(g.w) + bf_lo(o.w); a1[3] = a1[3] * bf_hi(g.w) + bf_hi(o.w);
                    *(u32x4*)(merged + row * 1024 + c) = pack8(a0, a1); }
                asm volatile("" ::: "memory"); }
    }
};
struct EpiSwiglu {
    static constexpr bool PERM = true, AFTER_DRAIN = false;
    bf16_t* hid; int ldh;
    __device__ __forceinline__ void operator()(const f32x4 (&acc)[2][2][4][2], const Unit& u, int wr, int wc, int fr, int fq) const {
        const int row0 = u.pm * BM + wr * 64 + fr, col0 = u.pn * HALF + wc * 32 + 8 * fq;
#pragma unroll
        for (int ai = 0; ai < 2; ++ai)
#pragma unroll
            for (int m = 0; m < 4; ++m) { const size_t row = (size_t)(row0 + ai * HALF + m * 16);
                f32x4 g0 = acc[ai][0][m][0], g1 = acc[ai][0][m][1]; const f32x4 u0 = acc[ai][1][m][0], u1 = acc[ai][1][m][1];
#pragma unroll
                for (int j = 0; j < 4; ++j) { g0[j] = g0[j] * sigm(g0[j]) * u0[j]; g1[j] = g1[j] * sigm(g1[j]) * u1[j]; }
                *(u32x4*)(hid + row * ldh + col0) = pack8(g0, g1); }
    }
};
struct PairOrder {
    StaticOrder base;
    __device__ bool next(int i, Unit& u) const { Unit b; if (!base.next(i >> 1, b)) return false; u.pm = b.pm; u.pn = 2 * b.pn + (i & 1); return true; }
    __device__ __forceinline__ void a_ready(const Unit&) const {}
    __device__ __forceinline__ void done(const Unit&) const {}
};

template <class Epi, class Sched, bool ALIGN_EPI = false, bool SP2 = false>
__device__ __forceinline__ void gemm_phase(PG8_LAS unsigned char* lds, const Gemm g, const Sched& S, const Epi& E) {
    int tid_ = threadIdx.x; asm volatile("" : "+v"(tid_));
    const int tid = tid_, wid = __builtin_amdgcn_readfirstlane(tid >> 6), lane = tid & 63, wr = wid >> 2, wc = wid & 3, fr = lane & 15, fq = lane >> 4;
    const int K = g.K, nt = K / BK;
    unsigned voffA[2], voffB[2];
#pragma unroll
    for (int i = 0; i < 2; ++i) { int R, C; stage_rc(tid * 16 + i * 8192, R, C); const int Rb = Epi::PERM ? ((R & ~31) + perm32(R & 31)) : R;
        voffA[i] = (unsigned)(R * K + C) * 2u; voffB[i] = (unsigned)(Rb * K + C) * 2u; }
    const size_t kstep = (size_t)(BK * 2);
    const size_t hstep = (size_t)HALF * K * 2;
    const size_t tstep = 2 * hstep;
    const unsigned ldsw = (unsigned)wid * 1024u;
    const int aoff = lds_byte(wr * 64 + fr, fq * 8), boff = lds_byte(wc * 32 + fr, fq * 8);
#define PG8_SA(b, h) (((b) * 2 + (h)) * HTB)
#define PG8_SB(b, h) ((4 + (b) * 2 + (h)) * HTB)
#define PG8_STAGE(bufoff, gbase, voff) do { _Pragma("unroll") for (int _i = 0; _i < 2; ++_i) \
        __builtin_amdgcn_global_load_lds((const unsigned*)((const char*)(gbase) + (voff)[_i]), (PG8_LAS unsigned*)(lds + (bufoff) + ldsw + _i * 8192), 16, 0, 0); } while (0)
#define PG8_LDA(dst, b, h) do { _Pragma("unroll") for (int m = 0; m < 4; ++m) _Pragma("unroll") for (int k = 0; k < 2; ++k) dst[m][k] = *(const PG8_LAS bf16x8*)(lds + PG8_SA(b, h) + aoff + m * 2048 + k * 1024); } while (0)
#define PG8_LDB(dst, b, h) do { _Pragma("unroll") for (int n = 0; n < 2; ++n) _Pragma("unroll") for (int k = 0; k < 2; ++k) dst[n][k] = *(const PG8_LAS bf16x8*)(lds + PG8_SB(b, h) + boff + n * 2048 + k * 1024); } while (0)
#define PG8_MMA(ai, bj, At, Bt) do { __builtin_amdgcn_s_setprio(1); _Pragma("unroll") for (int m = 0; m < 4; ++m) _Pragma("unroll") for (int n = 0; n < 2; ++n) _Pragma("unroll") for (int k = 0; k < 2; ++k) \
        acc[ai][bj][m][n] = __builtin_amdgcn_mfma_f32_16x16x32_bf16(Bt[n][k], At[m][k], acc[ai][bj][m][n], 0, 0, 0); __builtin_amdgcn_s_setprio(0); } while (0)
#define PG8_WAIT_V(n) asm volatile("s_waitcnt vmcnt(" #n ")" ::: "memory")
#define PG8_WAIT_L(n) asm volatile("s_waitcnt lgkmcnt(" #n ")" ::: "memory")
#define PG8_BAR __builtin_amdgcn_s_barrier()
#define PG8_SCHED __builtin_amdgcn_sched_barrier(0)
    Unit cur, nxt; int ui = 0;
    if (!S.next(0, cur)) return;
    f32x4 acc[2][2][4][2];
#pragma unroll
    for (int a = 0; a < 2; ++a)
#pragma unroll
        for (int b = 0; b < 2; ++b)
#pragma unroll
            for (int m = 0; m < 4; ++m)
#pragma unroll
                for (int n = 0; n < 2; ++n) acc[a][b][m][n] = (f32x4){0.f, 0.f, 0.f, 0.f};
    bf16x8 At[4][2], B0[2][2], B1[2][2];
    const char* cA = (const char*)g.A + (size_t)cur.pm * tstep; const char* cB = (const char*)g.Bt + (size_t)cur.pn * tstep;
    S.a_ready(cur);
    if constexpr (SP2) {
        PG8_STAGE(PG8_SB(0, 0), cB, voffB); PG8_STAGE(PG8_SB(0, 1), cB + hstep, voffB); PG8_STAGE(PG8_SA(0, 0), cA, voffA); PG8_STAGE(PG8_SA(0, 1), cA + hstep, voffA);
        if (wr == 1) PG8_BAR;
        PG8_WAIT_V(2); PG8_BAR;
        PG8_STAGE(PG8_SB(1, 0), cB + kstep, voffB); PG8_STAGE(PG8_SA(1, 0), cA + kstep, voffA); PG8_STAGE(PG8_SB(1, 1), cB + hstep + kstep, voffB);
        PG8_WAIT_V(6); PG8_BAR;
    } else {
        PG8_STAGE(PG8_SB(0, 0), cB, voffB); PG8_STAGE(PG8_SA(0, 0), cA, voffA); PG8_STAGE(PG8_SB(0, 1), cB + hstep, voffB); PG8_STAGE(PG8_SA(0, 1), cA + hstep, voffA);
        if (wr == 1) PG8_BAR;
        PG8_WAIT_V(4); PG8_BAR;
        PG8_STAGE(PG8_SB(1, 0), cB + kstep, voffB); PG8_STAGE(PG8_SA(1, 0), cA + kstep, voffA); PG8_STAGE(PG8_SB(1, 1), cB + hstep + kstep, voffB);
        PG8_WAIT_V(6); PG8_BAR;
    }
    for (;;) {
        const bool has_next = S.next(ui + 1, nxt);
        const char* nA = has_next ? (const char*)g.A + (size_t)nxt.pm * tstep : cA; const char* nB = has_next ? (const char*)g.Bt + (size_t)nxt.pn * tstep : cB;
        for (int t = 0; t < nt; t += 2) {
            const bool last = (t == nt - 2);
            const char* a1 = cA + (size_t)(t + 1) * kstep;
            const char* a2 = last ? nA : cA + (size_t)(t + 2) * kstep; const char* b2 = last ? nB : cB + (size_t)(t + 2) * kstep;
            const char* a3 = a2 + kstep; const char* b3 = b2 + kstep;
            if (last && has_next) S.a_ready(nxt);
            if constexpr (SP2) {
            PG8_LDB(B0, 0, 0); PG8_LDB(B1, 0, 1); PG8_SCHED; PG8_LDA(At, 0, 0); PG8_STAGE(PG8_SA(1, 1), a1 + hstep, voffA);
            PG8_WAIT_V(8); PG8_WAIT_L(0); PG8_BAR; PG8_MMA(0, 0, At, B0); PG8_MMA(0, 1, At, B1); PG8_BAR; PG8_SCHED;
            PG8_LDA(At, 0, 1); PG8_STAGE(PG8_SB(0, 0), b2, voffB); PG8_STAGE(PG8_SB(0, 1), b2 + hstep, voffB); PG8_STAGE(PG8_SA(0, 0), a2, voffA);
            PG8_WAIT_V(8); PG8_WAIT_L(0); PG8_BAR; PG8_MMA(1, 0, At, B0); PG8_MMA(1, 1, At, B1); PG8_BAR; PG8_SCHED;
            PG8_LDB(B0, 1, 0); PG8_LDB(B1, 1, 1); PG8_SCHED; PG8_LDA(At, 1, 0); PG8_STAGE(PG8_SA(0, 1), a2 + hstep, voffA);
            PG8_WAIT_V(8); PG8_WAIT_L(0); PG8_BAR; PG8_MMA(0, 0, At, B0); PG8_MMA(0, 1, At, B1); PG8_BAR; PG8_SCHED;
            PG8_LDA(At, 1, 1); PG8_STAGE(PG8_SB(1, 0), b3, voffB); PG8_STAGE(PG8_SB(1, 1), b3 + hstep, voffB); PG8_STAGE(PG8_SA(1, 0), a3, voffA);
            PG8_WAIT_V(8); PG8_WAIT_L(0); PG8_BAR; PG8_MMA(1, 0, At, B0); PG8_MMA(1, 1, At, B1); PG8_BAR; PG8_SCHED;
            } else {
            PG8_LDB(B0, 0, 0); PG8_SCHED; PG8_LDA(At, 0, 0); PG8_STAGE(PG8_SA(1, 1), a1 + hstep, voffA);
            PG8_WAIT_L(8); PG8_BAR; PG8_WAIT_L(0); PG8_MMA(0, 0, At, B0); PG8_BAR; PG8_SCHED;
            PG8_LDB(B1, 0, 1); PG8_STAGE(PG8_SB(0, 0), b2, voffB);
            PG8_BAR; PG8_WAIT_L(0); PG8_MMA(0, 1, At, B1); PG8_BAR;
            PG8_LDA(At, 0, 1); PG8_STAGE(PG8_SA(0, 0), a2, voffA);
            PG8_BAR; PG8_WAIT_L(0); PG8_MMA(1, 0, At, B0); PG8_BAR; PG8_SCHED;
            PG8_STAGE(PG8_SB(0, 1), b2 + hstep, voffB);
            PG8_WAIT_V(6); PG8_BAR; PG8_MMA(1, 1, At, B1); PG8_BAR;
            PG8_LDB(B0, 1, 0); PG8_SCHED; PG8_LDA(At, 1, 0); PG8_STAGE(PG8_SA(0, 1), a2 + hstep, voffA);
            PG8_WAIT_L(8); PG8_BAR; PG8_WAIT_L(0); PG8_MMA(0, 0, At, B0); PG8_BAR; PG8_SCHED;
            PG8_LDB(B1, 1, 1); PG8_STAGE(PG8_SB(1, 0), b3, voffB);
            PG8_BAR; PG8_WAIT_L(0); PG8_MMA(0, 1, At, B1); PG8_BAR;
            PG8_LDA(At, 1, 1); PG8_STAGE(PG8_SA(1, 0), a3, voffA);
            PG8_BAR; PG8_WAIT_L(0); PG8_MMA(1, 0, At, B0); PG8_BAR; PG8_SCHED;
            PG8_STAGE(PG8_SB(1, 1), b3 + hstep, voffB);
            PG8_WAIT_V(6); PG8_BAR; PG8_MMA(1, 1, At, B1); PG8_BAR;
            }
        }
        if constexpr (ALIGN_EPI) { if (wr == 0) PG8_BAR; }
        if constexpr (!Epi::AFTER_DRAIN) { E(acc, cur, wr, wc, fr, fq); S.done(cur); }
        if (!has_next) break;
#pragma unroll
        for (int a = 0; a < 2; ++a)
#pragma unroll
            for (int b = 0; b < 2; ++b)
#pragma unroll
                for (int m = 0; m < 4; ++m)
#pragma unroll
                    for (int n = 0; n < 2; ++n) acc[a][b][m][n] = (f32x4){0.f, 0.f, 0.f, 0.f};
        cur = nxt; cA = nA; cB = nB; ++ui;
        if constexpr (ALIGN_EPI) { if (wr == 1) PG8_BAR; }
    }
    PG8_WAIT_V(0);
    if constexpr (!ALIGN_EPI) { if (wr == 0) PG8_BAR; }
    PG8_BAR;
    if constexpr (Epi::AFTER_DRAIN) { E.fused(acc, cur, wr, wc, fr, fq, lds, wid, lane); S.done(cur); }
#undef PG8_SA
#undef PG8_SB
#undef PG8_STAGE
#undef PG8_LDA
#undef PG8_LDB
#undef PG8_MMA
#undef PG8_WAIT_V
#undef PG8_WAIT_L
#undef PG8_BAR
#undef PG8_SCHED
}
}

constexpr int NWAVES = 8;
constexpr int BATCH = 8, SEQ = 2048, D = 1024, M = BATCH * SEQ;
constexpr int INW = 5832, N1P = 5888, FF = 2816, NLAYER = 2;
constexpr float NORM_EPS = 1e-6f;
constexpr size_t MiB = 1u << 20;
constexpr size_t WS_CTL = 0, CTL_ZERO_BYTES = 1 * MiB;
constexpr size_t WS_WINT = 1 * MiB;
constexpr size_t WS_ATTNOT = WS_WINT + (size_t)N1P * D * 2;
constexpr size_t WS_POOLET = WS_ATTNOT + 2 * MiB;
constexpr size_t WS_GLUT = WS_POOLET + 1 * MiB;
constexpr size_t WS_WOUTT = WS_GLUT + 2 * MiB;
constexpr size_t WS_S5T = WS_WOUTT + 2 * MiB;
constexpr size_t WS_S5P = WS_S5T + 4 * MiB;
constexpr size_t WS_S5Q = WS_S5P + 2 * MiB;
constexpr size_t WS_S5A = WS_S5Q + 2 * MiB;
constexpr size_t WS_BIAS = WS_S5A + 65536;
static_assert(WS_BIAS + 8192 <= 29 * MiB, "weights region");
constexpr size_t WS_HB = 29 * MiB;
constexpr size_t WS_DP = WS_HB, WS_ZB = WS_HB + 16 * MiB;
constexpr size_t WS_POOLU = 61 * MiB, WS_S5U = 77 * MiB;
constexpr size_t WS_MERGED = WS_POOLU;
constexpr size_t WS_FFNINT = WS_POOLU, WS_FFNOUTT = WS_POOLU + 11 * MiB;
constexpr size_t WS_Q = 93 * MiB, WS_QI = 125 * MiB, WS_KVX = 141 * MiB, WS_GATES = 149 * MiB;
constexpr size_t WS_F = WS_Q;
constexpr size_t WS_HID = 157 * MiB;
constexpr size_t WS_END = 245 * MiB;
static_assert(WS_FFNOUTT + (size_t)D * FF * 2 <= WS_Q && WS_HID + (size_t)M * FF * 2 <= WS_END && WS_F + (size_t)M * D * 4 <= WS_HID, "d_ws map");
constexpr int CW_BAR = 4096;
constexpr int RING_OFF = 0, RING_BYTES = 131072;
constexpr int LDSCTL_OFF = RING_BYTES, MISC_OFF = LDSCTL_OFF + 320;
constexpr int LDS_BYTES = 147456;
constexpr int NPHASE = 1 + 8 * NLAYER;

#define GAS __attribute__((address_space(1)))
#define LAS __attribute__((address_space(3)))
typedef unsigned short bf16;
typedef unsigned v4u __attribute__((ext_vector_type(4)));
typedef float f32x4 __attribute__((ext_vector_type(4)));
typedef short bf16x8 __attribute__((ext_vector_type(8)));
typedef GAS unsigned gu32;
typedef GAS unsigned long long gu64;
#define RLX_AGENT __ATOMIC_RELAXED, __HIP_MEMORY_SCOPE_AGENT
#define LDS_WAIT() asm volatile("s_waitcnt lgkmcnt(0)" ::: "memory")
#define VM_WAIT() asm volatile("s_waitcnt vmcnt(0)" ::: "memory")
__device__ __forceinline__ unsigned long long rt() { return __builtin_amdgcn_s_memrealtime(); }
__device__ __forceinline__ unsigned f2bf(float f) { unsigned u = __builtin_bit_cast(unsigned, f); return (u + 0x7fffu + ((u >> 16) & 1u)) >> 16; }
__device__ __forceinline__ unsigned pk2(float lo, float hi) { return f2bf(lo) | (f2bf(hi) << 16); }
#define XB_TMO      128
#define XB_XCNT(j)  (256  + 64 * (j))
#define XB_XSUB(j)  (1280 + 64 * (j))
#define XB_XGEN(j)  (2304 + 64 * (j))
#define XB_TOP      3328
#define XB_TOPGEN   3392
#define XCD_BAR_WORDS 3456
#define XB_SPIN_CAP (1u << 18)

__device__ __forceinline__ unsigned xb_ld(unsigned* p)              { return __hip_atomic_load(p, __ATOMIC_RELAXED, __HIP_MEMORY_SCOPE_AGENT); }
__device__ __forceinline__ unsigned xb_add(unsigned* p, unsigned v) { return __hip_atomic_fetch_add(p, v, __ATOMIC_RELAXED, __HIP_MEMORY_SCOPE_AGENT); }
__device__ __forceinline__ unsigned xb_xcc_id() { return (unsigned)__builtin_amdgcn_s_getreg((3 << 11) | 20) & 0xFu; }
#define XB_SPIN(cond, bar) do { unsigned _sp = 0; while (cond) { __builtin_amdgcn_s_sleep(1); \
    if ((++_sp & 255u) == 0u) { if (xb_ld(&(bar)[XB_TMO])) break; if (_sp > XB_SPIN_CAP) { atomicAdd(&(bar)[XB_TMO], 1u); break; } } } } while (0)

struct XcdBarrier {
    unsigned* bar; unsigned x;
    volatile LAS unsigned* st;
};

__device__ __forceinline__ XcdBarrier xcd_barrier_post(unsigned* bar, volatile LAS unsigned* st) {
    XcdBarrier b; b.bar = bar; b.x = xb_xcc_id(); b.st = st;
    if (threadIdx.x == 0) (void)xb_add(&bar[XB_XCNT(b.x)], 1u);
    return b;
}
__device__ __forceinline__ void xcd_barrier_complete(unsigned* bar, unsigned x, unsigned& nloc, unsigned& nx) {
    const unsigned G = gridDim.x * gridDim.y * gridDim.z;
    unsigned sum, cnt, mine, sp = 0u;
    for (;;) {
        sum = 0u; cnt = 0u; mine = 0u;
#pragma unroll
        for (unsigned j = 0; j < 16; ++j) { const unsigned c = xb_ld(&bar[XB_XCNT(j)]); sum += c; cnt += (c > 0u) ? 1u : 0u; mine = (j == x) ? c : mine; }
        if (sum == G) break;
        __builtin_amdgcn_s_sleep(1);
        if ((++sp & 255u) == 0u) { if (xb_ld(&bar[XB_TMO])) break; if (sp > XB_SPIN_CAP) { atomicAdd(&bar[XB_TMO], 1u); break; } }
    }
    nloc = mine > 0u ? mine : 1u; nx = cnt > 0u ? cnt : 1u;
}

__device__ __forceinline__ void xcd_barrier(const XcdBarrier& b) {
    asm volatile("s_waitcnt vmcnt(0)" ::: "memory");
    __syncthreads();
    if (threadIdx.x == 0) {
        unsigned* bar = b.bar;
        __builtin_amdgcn_s_waitcnt(0);
        unsigned nloc = b.st[0], nx = b.st[1];
        if (nloc == 0u) { xcd_barrier_complete(bar, b.x, nloc, nx); b.st[0] = nloc; b.st[1] = nx; }
        const unsigned old = xb_add(&bar[XB_XSUB(b.x)], 1u);
        const unsigned gen = old / nloc;
        if (old + 1u == (gen + 1u) * nloc) {
            __builtin_amdgcn_fence(__ATOMIC_RELEASE, "agent");
            asm volatile("s_waitcnt vmcnt(0)" ::: "memory");
            const unsigned og = xb_add(&bar[XB_TOP], 1u);
            const unsigned tg = og / nx;
            if (og + 1u == (tg + 1u) * nx) xb_add(&bar[XB_TOPGEN], 1u);
            else XB_SPIN(xb_ld(&bar[XB_TOPGEN]) == tg, bar);
            __builtin_amdgcn_fence(__ATOMIC_ACQUIRE, "agent");
            xb_add(&bar[XB_XGEN(b.x)], 1u);
            asm volatile("s_waitcnt vmcnt(0)" ::: "memory");
        } else {
            XB_SPIN(xb_ld(&bar[XB_XGEN(b.x)]) == gen, bar);
            __builtin_amdgcn_fence(__ATOMIC_ACQUIRE, "agent");
            asm volatile("s_waitcnt vmcnt(0)" ::: "memory");
        }
    }
    __syncthreads();
}

typedef short s16x4 __attribute__((ext_vector_type(4)));
typedef short v4i16_t __attribute__((ext_vector_type(4)));
typedef unsigned short u16x4 __attribute__((ext_vector_type(4)));
typedef unsigned v2u __attribute__((ext_vector_type(2)));
typedef float f32x2v __attribute__((ext_vector_type(2)));
#define DI __device__ __forceinline__
struct Frame {
    LAS unsigned char* lds;
    int tid, lane, wave, G;
};
DI float wave_sum(float v) {
#pragma unroll
    for (int o = 1; o < 64; o <<= 1) v += __shfl_xor(v, o);
    return v;
}
DI bf16x8 ldg16(const bf16* p) { return *(const GAS bf16x8*)p; }
DI bf16x8 ldg16o(const bf16* ub, unsigned off) { return *(const GAS bf16x8*)((const GAS unsigned char*)ub + off); }
DI v4u ldg16u(const bf16* ub, unsigned off) { return *(const GAS v4u*)((const GAS unsigned char*)ub + off); }
DI float bf2f(bf16 b) { return __uint_as_float(((unsigned)b) << 16); }
DI float bflo(unsigned w) { return __uint_as_float(w << 16); }
DI float bfhi(unsigned w) { return __uint_as_float(w & 0xffff0000u); }
#define MFMA16(a, b, c) __builtin_amdgcn_mfma_f32_16x16x32_bf16((a), (b), (c), 0, 0, 0)

struct MapId { DI int operator()(int n) const { return n; } };
struct MapWin { DI int operator()(int n) const {
    if (n < 512) return n;
    if (n < 1536) return n + 512;
    if (n < 1600) return n - 1536 + 2560;
    if (n < 1664) return n - 1600 + 2624;
    if (n < 2176) return n - 1664 + 2048;
    if (n < 2240) return n - 2176 + 2688;
    if (n < 2248) return n - 2240 + 2752;
    if (n < 2760) return n - 2248 + 512;
    return n - 2760 + 2816; } };
struct MapIl { int half; DI int operator()(int n) const { const int hi = n >= half ? 1 : 0, m = n - hi * half; return (m >> 7) * 256 + hi * 128 + (m & 127); } };
template <class Map> DI void transpose_item(const float* W, int K, int Ns, bf16* WT, LAS float* scr, int item, int lane, const Map& map) {
    const int nblk = (Ns + 31) / 32, kb = item / nblk, nb = item % nblk, k0 = 64 * kb, n0 = 32 * nb;
    const int nc = n0 + 4 * (lane & 7);
    f32x4 v[8];
#pragma unroll
    for (int i = 0; i < 8; ++i) { const int kk = (lane >> 3) + 8 * i; v[i] = nc < Ns ? *(const GAS f32x4*)(W + (size_t)(k0 + kk) * Ns + nc) : (f32x4){0.f, 0.f, 0.f, 0.f}; }
#pragma unroll
    for (int i = 0; i < 8; ++i) { const int kk = (lane >> 3) + 8 * i; LAS float* d = scr + kk * 33 + 4 * (lane & 7); d[0] = v[i].x; d[1] = v[i].y; d[2] = v[i].z; d[3] = v[i].w; }
    LDS_WAIT(); asm volatile("" ::: "memory");
    const int c = lane & 7;
#pragma unroll
    for (int j = 0; j < 4; ++j) { const int nn = (lane >> 3) + 8 * j; const LAS float* s = scr + (8 * c) * 33 + nn;
        if (n0 + nn < Ns) { const int dr = map(n0 + nn);
            v4u o; o.x = pk2(s[0 * 33], s[1 * 33]); o.y = pk2(s[2 * 33], s[3 * 33]); o.z = pk2(s[4 * 33], s[5 * 33]); o.w = pk2(s[6 * 33], s[7 * 33]);
            *(GAS v4u*)(WT + (size_t)dr * K + k0 + 8 * c) = o; } }
    LDS_WAIT(); asm volatile("" ::: "memory");
}
struct In {
    const float *x, *n_mix_pre, *n_mix_post, *n_ffn_pre, *n_ffn_post, *w_in, *pool_mix_w, *pool_scale, *pool_out_w, *attn_out_w, *rel_bias, *lam_re, *lam_im, *log_dt,
                *b_re, *b_im, *c_re, *c_im, *s5_d, *glu_w, *w_out, *ffn_w_in, *ffn_w_out;
};
struct Args { In in; float* out; unsigned char* ws; int ph_lo, ph_hi; };
typedef const __attribute__((address_space(4))) Args* KArgs;
DI KArgs kargs() { KArgs p = (KArgs)__builtin_amdgcn_kernarg_segment_ptr(); asm volatile("" : "+s"(p)); return p; }
template <class T> DI T* opq(T* p) { asm volatile("" : "+s"(p)); return p; }
DI int opqv(int v) { asm volatile("" : "+v"(v)); return v; }

DI void convert_A(Frame& F, KArgs A, unsigned char* ws, int l) {
    LAS float* scr = (LAS float*)(F.lds + RING_OFF + F.wave * 16384);
    const int gw = blockIdx.x * NWAVES + F.wave, NGW = F.G * NWAVES;
    const int gt = blockIdx.x * (NWAVES * 64) + F.tid, NGT = F.G * NWAVES * 64;
    bf16* WINT = (bf16*)(ws + WS_WINT); bf16* ATTNOT = (bf16*)(ws + WS_ATTNOT); bf16* POOLET = (bf16*)(ws + WS_POOLET); bf16* GLUT = (bf16*)(ws + WS_GLUT); bf16* WOUTT = (bf16*)(ws + WS_WOUTT);
    constexpr int I_WIN = (D / 64) * ((INW + 31) / 32), I_SQ = (D / 64) * (D / 32), I_GLU = (512 / 64) * (2048 / 32);
    constexpr int NITEMS = I_WIN + 2 * I_SQ + I_GLU;
    for (int it = gw; it < NITEMS; it += NGW) {
        int r = it;
        if (r < I_WIN) { transpose_item(A->in.w_in + (size_t)l * D * INW, D, INW, WINT, scr, r, F.lane, MapWin{}); continue; } r -= I_WIN;
        if (r < I_SQ) { transpose_item(A->in.attn_out_w + (size_t)l * D * D, D, D, ATTNOT, scr, r, F.lane, MapId{}); continue; } r -= I_SQ;
        if (r < I_SQ) { transpose_item(A->in.w_out + (size_t)l * D * D, D, D, WOUTT, scr, r, F.lane, MapId{}); continue; } r -= I_SQ;
        transpose_item(A->in.glu_w + (size_t)l * 512 * 2048, 512, 2048, GLUT, scr, r, F.lane, MapIl{1024});
    }
    for (int i = gt; i < 56 * D / 8; i += NGT) *(GAS v4u*)(WINT + (size_t)2760 * D + (size_t)i * 8) = (v4u){0u, 0u, 0u, 0u};
    {   const float* mw = A->in.pool_mix_w + (size_t)l * 4 * 128 * 128; const float* sc = A->in.pool_scale + (size_t)l * 512; const float* pw = A->in.pool_out_w + (size_t)l * 512 * D;
        for (int idx = gt; idx < 512 * (D / 4); idx += NGT) { const int n4 = idx & (D / 4 - 1), gc = idx >> 8, g = gc >> 7;
            const float* mrow = mw + (size_t)gc * 128; const float* scg = sc + g * 128; const GAS f32x4* pcol = (const GAS f32x4*)(pw + (size_t)(g * 128) * D) + n4;
            f32x4 s = (f32x4){0.f, 0.f, 0.f, 0.f};
            _Pragma("unroll 16") for (int d = 0; d < 128; ++d) s += (mrow[d] * scg[d]) * pcol[(size_t)d * (D / 4)];
            POOLET[(size_t)(4 * n4 + 0) * 512 + gc] = (bf16)f2bf(s.x); POOLET[(size_t)(4 * n4 + 1) * 512 + gc] = (bf16)f2bf(s.y);
            POOLET[(size_t)(4 * n4 + 2) * 512 + gc] = (bf16)f2bf(s.z); POOLET[(size_t)(4 * n4 + 3) * 512 + gc] = (bf16)f2bf(s.w); } }
    if (blockIdx.x == 0) { float* BT = (float*)(ws + WS_BIAS);
        for (int i = F.tid; i < 128 * 16; i += NWAVES * 64) { const int d = i >> 4, h = i & 15;
            int bk = d; if (d >= 16) { bk = 16 + (int)(logf((float)d / 16.0f) / logf(8.0f) * 16.0f); bk = bk > 31 ? 31 : bk; }
            BT[i] = A->in.rel_bias[bk * 16 + h]; } }
    {   bf16* S5T = (bf16*)(ws + WS_S5T); bf16* S5P = (bf16*)(ws + WS_S5P); bf16* S5Q = (bf16*)(ws + WS_S5Q); float* S5A = (float*)(ws + WS_S5A);
        LAS float* apr = (LAS float*)(F.lds + RING_OFF);
        LAS float* api = apr + 17 * 64;
        LAS float* bbr = api + 17 * 64;
        LAS float* bbi = bbr + 64 * 16;
        LAS float* Kt = bbi + 64 * 16;
        LAS float* cre = Kt + 4096;
        LAS float* cim = cre + 1024;
        __syncthreads();
        for (int task = blockIdx.x; task < 256; task += F.G) { const int g = task & 31, sub = task >> 5; const int lg = l * 32 + g;
            for (int e = F.tid; e < 1024; e += NWAVES * 64) { cre[e] = A->in.c_re[(size_t)lg * 1024 + e]; cim[e] = A->in.c_im[(size_t)lg * 1024 + e]; }
            if (F.tid < 64) { const int n = F.tid;
                const float lr = A->in.lam_re[lg * 64 + n], li = A->in.lam_im[lg * 64 + n], dt = expf(A->in.log_dt[lg]);
                const float mag = expf(lr * dt), ar = mag * cosf(li * dt), ai = mag * sinf(li * dt), den = lr * lr + li * li;
                const float cr = ((ar - 1.0f) * lr + ai * li) / den, ci = (ai * lr - (ar - 1.0f) * li) / den;
                float pr = 1.f, pi = 0.f;
                for (int t = 0; t <= 16; ++t) { apr[t * 64 + n] = pr; api[t * 64 + n] = pi; const float nr = pr * ar - pi * ai, ni = pr * ai + pi * ar; pr = nr; pi = ni; }
                for (int c = 0; c < 16; ++c) { const float br = A->in.b_re[((size_t)lg * 64 + n) * 16 + c], bi = A->in.b_im[((size_t)lg * 64 + n) * 16 + c];
                    bbr[n * 16 + c] = cr * br - ci * bi; bbi[n * 16 + c] = cr * bi + ci * br; }
                if (sub == 0) { S5A[(g * 64 + n) * 2] = apr[16 * 64 + n]; S5A[(g * 64 + n) * 2 + 1] = api[16 * 64 + n]; }
            }
            __syncthreads();
            {
                const int t = F.tid >> 5, i = (F.tid >> 1) & 15, c0 = (F.tid & 1) * 8; float acc[8];
#pragma unroll
                for (int q = 0; q < 8; ++q) acc[q] = 0.f;
                for (int n = 0; n < 64; ++n) { const float Cr = cre[i * 64 + n], Ci = cim[i * 64 + n], pr = apr[t * 64 + n], pi = api[t * 64 + n];
                    const float er = Cr * pr - Ci * pi, ei = Cr * pi + Ci * pr;
                    const f32x4 b0 = *(const LAS f32x4*)(bbr + n * 16 + c0), b1 = *(const LAS f32x4*)(bbr + n * 16 + c0 + 4), d0 = *(const LAS f32x4*)(bbi + n * 16 + c0), d1 = *(const LAS f32x4*)(bbi + n * 16 + c0 + 4);
#pragma unroll
                    for (int q = 0; q < 4; ++q) { acc[q] += er * b0[q] - ei * d0[q]; acc[4 + q] += er * b1[q] - ei * d1[q]; } }
#pragma unroll
                for (int q = 0; q < 8; ++q) Kt[(t * 16 + i) * 16 + c0 + q] = acc[q]; }
            __syncthreads();
            for (int e = F.tid; e < 32 * 256; e += NWAVES * 64) { const int r = sub * 32 + (e >> 8), k = e & 255, j = r >> 4, i = r & 15, s = k >> 4, c = k & 15;
                float v = (j >= s) ? Kt[((j - s) * 16 + i) * 16 + c] : 0.f; if (j == s && i == c) v += A->in.s5_d[l * 512 + g * 16 + i];
                S5T[((size_t)g * 256 + r) * 256 + k] = (bf16)f2bf(v); }
            for (int e = F.tid; e < 16 * 256; e += NWAVES * 64) { const int row = sub * 16 + (e >> 8), k = e & 255, n = row & 63, im = row >> 6, s = k >> 4, c = k & 15;
                const float pr = apr[(15 - s) * 64 + n], pi = api[(15 - s) * 64 + n], br = bbr[n * 16 + c], bi = bbi[n * 16 + c];
                const float v = im ? (pr * bi + pi * br) : (pr * br - pi * bi);
                S5P[((size_t)g * 128 + row) * 256 + k] = (bf16)f2bf(v); }
            for (int e = F.tid; e < 32 * 128; e += NWAVES * 64) { const int r = sub * 32 + (e >> 7), k = e & 127, j = r >> 4, i = r & 15, n = k & 63, im = k >> 6;
                const float Cr = cre[i * 64 + n], Ci = cim[i * 64 + n], pr = apr[(j + 1) * 64 + n], pi = api[(j + 1) * 64 + n];
                const float v = im ? -(Cr * pi + Ci * pr) : (Cr * pr - Ci * pi);
                S5Q[((size_t)g * 256 + r) * 128 + k] = (bf16)f2bf(v); }
            __syncthreads();
        }
    }
}
DI void convert_B(Frame& F, KArgs A, unsigned char* ws, int l) {
    LAS float* scr = (LAS float*)(F.lds + RING_OFF + F.wave * 16384);
    const int gw = blockIdx.x * NWAVES + F.wave, NGW = F.G * NWAVES;
    bf16* FFNINT = (bf16*)(ws + WS_FFNINT); bf16* FFNOUTT = (bf16*)(ws + WS_FFNOUTT);
    constexpr int I_IN = (D / 64) * (2 * FF / 32), I_OUT = (FF / 64) * (D / 32);
    for (int it = gw; it < I_IN + I_OUT; it += NGW) {
        if (it < I_IN) transpose_item(A->in.ffn_w_in + (size_t)l * D * 2 * FF, D, 2 * FF, FFNINT, scr, it, F.lane, MapIl{FF});
        else transpose_item(A->in.ffn_w_out + (size_t)l * FF * D, FF, D, FFNOUTT, scr, it - I_IN, F.lane, MapId{});
    }
}
DI void rms_rows_to_bf16(Frame& F, const float* x, const float* g, bf16* hb) {
    const int gw = blockIdx.x * NWAVES + F.wave, NGW = F.G * NWAVES;
    f32x4 gv[4];
#pragma unroll
    for (int j = 0; j < 4; ++j) gv[j] = ((const GAS f32x4*)g)[F.lane + 64 * j];
    for (int m = gw; m < M; m += NGW) {
        const GAS f32x4* xr = (const GAS f32x4*)(x + (size_t)m * D) + F.lane; f32x4 v[4]; float s = 0.f;
#pragma unroll
        for (int j = 0; j < 4; ++j) { v[j] = xr[64 * j]; s += (v[j].x * v[j].x + v[j].y * v[j].y) + (v[j].z * v[j].z + v[j].w * v[j].w); }
        const float rstd = 1.0f / sqrtf(wave_sum(s) * (1.f / D) + NORM_EPS);
        GAS v2u* o8 = (GAS v2u*)(hb + (size_t)m * D) + F.lane;
#pragma unroll
        for (int j = 0; j < 4; ++j) { v2u o; o.x = pk2(v[j].x * rstd * gv[j].x, v[j].y * rstd * gv[j].y); o.y = pk2(v[j].z * rstd * gv[j].z, v[j].w * rstd * gv[j].w); o8[64 * j] = o; }
    }
}
DI void norm_phase(Frame& F, const float* xin, float* xout, const float* f, const float* gpost, const float* gpre, bf16* hb) {
    const int gw = blockIdx.x * NWAVES + F.wave, NGW = F.G * NWAVES;
    for (int m = gw; m < M; m += NGW) {
        const GAS f32x4* fr = (const GAS f32x4*)(f + (size_t)m * D) + F.lane; const GAS f32x4* xr = (const GAS f32x4*)(xin + (size_t)m * D) + F.lane;
        f32x4 v[4], xv[4]; float s = 0.f;
#pragma unroll
        for (int j = 0; j < 4; ++j) { v[j] = fr[64 * j]; xv[j] = xr[64 * j]; s += (v[j].x * v[j].x + v[j].y * v[j].y) + (v[j].z * v[j].z + v[j].w * v[j].w); }
        const float rstd = 1.0f / sqrtf(wave_sum(s) * (1.f / D) + NORM_EPS); float s2 = 0.f;
        GAS f32x4* xo = (GAS f32x4*)(xout + (size_t)m * D) + F.lane;
#pragma unroll
        for (int j = 0; j < 4; ++j) { const f32x4 gp = ((const GAS f32x4*)gpost)[F.lane + 64 * j]; xv[j] = xv[j] + v[j] * rstd * gp; xo[64 * j] = xv[j];
            s2 += (xv[j].x * xv[j].x + xv[j].y * xv[j].y) + (xv[j].z * xv[j].z + xv[j].w * xv[j].w); }
        if (gpre) { const float rstd2 = 1.0f / sqrtf(wave_sum(s2) * (1.f / D) + NORM_EPS);
            GAS v2u* o8 = (GAS v2u*)(hb + (size_t)m * D) + F.lane;
#pragma unroll
            for (int j = 0; j < 4; ++j) { const f32x4 gq = ((const GAS f32x4*)gpre)[F.lane + 64 * j]; v2u o; o.x = pk2(xv[j].x * rstd2 * gq.x, xv[j].y * rstd2 * gq.y); o.y = pk2(xv[j].z * rstd2 * gq.z, xv[j].w * rstd2 * gq.w); o8[64 * j] = o; } }
    }
}

DI void pool_stencil(Frame& F, const bf16* POOLU, bf16* DP) {
    const int gt = blockIdx.x * (NWAVES * 64) + F.tid, NGT = F.G * NWAVES * 64;
    for (int idx = gt; idx < M * 64; idx += NGT) {
        const int t = idx >> 6, cc = idx & 63, ch0 = cc * 8, gi = cc >> 4, w = 2 << gi, pos = t & (SEQ - 1);
        const int nw = (pos + 1) < w ? (pos + 1) : w;
        float a[8], u0[8];
#pragma unroll
        for (int j = 0; j < 8; ++j) { a[j] = 0.f; u0[j] = 0.f; }
        for (int i = 0; i < nw; ++i) { const v4u v = *(const GAS v4u*)(POOLU + (size_t)(t - i) * 512 + ch0);
            const float e[8] = {bflo(v.x), bfhi(v.x), bflo(v.y), bfhi(v.y), bflo(v.z), bfhi(v.z), bflo(v.w), bfhi(v.w)};
#pragma unroll
            for (int j = 0; j < 8; ++j) { a[j] += e[j]; if (i == 0) u0[j] = e[j]; } }
        const float inv = 1.0f / (float)nw; v4u o;
        o.x = pk2(a[0] * inv - u0[0], a[1] * inv - u0[1]); o.y = pk2(a[2] * inv - u0[2], a[3] * inv - u0[3]);
        o.z = pk2(a[4] * inv - u0[4], a[5] * inv - u0[5]); o.w = pk2(a[6] * inv - u0[6], a[7] * inv - u0[7]);
        *(GAS v4u*)(DP + (size_t)t * 512 + ch0) = o;
    }
}
DI float gelu_tanh(float y) { const float u = 0.7978845608028654f * (y + 0.044715f * y * y * y); const float th = 1.0f - 2.0f * __builtin_amdgcn_rcpf(__expf(2.0f * u) + 1.0f); return 0.5f * y * (1.0f + th); }
constexpr int S5_SLD = 129, S5_XLD = 136, S5_XOFF = 69632;
DI void s5_unit(Frame& F, int b, int g, const bf16* S5U_, const bf16* S5T_, const bf16* S5P_, const bf16* S5Q_, const float* S5A_, bf16* ZB_) {
    const bf16* S5U = opq(S5U_); const bf16* S5T = opq(S5T_); const bf16* S5P = opq(S5P_); const bf16* S5Q = opq(S5Q_); const float* S5A = opq(S5A_); bf16* ZB = opq(ZB_);
    LAS float* Ssm = (LAS float*)(F.lds + RING_OFF);
    LAS bf16* XB = (LAS bf16*)(F.lds + RING_OFF + S5_XOFF);
    const int w = F.wave, lane = opqv(F.lane), fr = lane & 15, qd = lane >> 4;
    const bf16* Tg = S5T + (size_t)g * 65536; const bf16* Pg = S5P + (size_t)g * 32768; const bf16* Qg = S5Q + (size_t)g * 32768;
    const bf16* Ub = S5U + (size_t)b * SEQ * 512 + g * 16;
    f32x4 accY[2][8], accS[8];
#pragma unroll
    for (int ct = 0; ct < 8; ++ct) { accS[ct] = (f32x4){0.f, 0.f, 0.f, 0.f}; accY[0][ct] = accS[ct]; accY[1][ct] = accS[ct]; }
#pragma unroll 1
    for (int ks = 0; ks < 8; ++ks) {
        bf16x8 bfr[8];
        const int s = 2 * ks + (qd >> 1), c0 = 8 * (qd & 1);
#pragma unroll
        for (int ct = 0; ct < 8; ++ct) bfr[ct] = ldg16o(Ub + (size_t)ct * 16 * 16 * 512, (unsigned)((fr * 16 + s) * 512 + c0) * 2u);
        const bf16x8 aP = ldg16o(Pg + (size_t)(16 * w) * 256 + 32 * ks, (unsigned)(fr * 256 + 8 * qd) * 2u);
#pragma unroll
        for (int ct = 0; ct < 8; ++ct) accS[ct] = MFMA16(aP, bfr[ct], accS[ct]);
        if (ks <= w) {
            const bf16x8 aT0 = ldg16o(Tg + (size_t)(32 * w) * 256 + 32 * ks, (unsigned)(fr * 256 + 8 * qd) * 2u), aT1 = ldg16o(Tg + (size_t)(32 * w + 16) * 256 + 32 * ks, (unsigned)(fr * 256 + 8 * qd) * 2u);
#pragma unroll
            for (int ct = 0; ct < 8; ++ct) { accY[0][ct] = MFMA16(aT0, bfr[ct], accY[0][ct]); accY[1][ct] = MFMA16(aT1, bfr[ct], accY[1][ct]); }
        }
    }
#pragma unroll
    for (int ct = 0; ct < 8; ++ct)
#pragma unroll
        for (int r = 0; r < 4; ++r) Ssm[(16 * w + 4 * qd + r) * S5_SLD + 16 * ct + fr] = accS[ct][r];
    __syncthreads();
    if (F.tid < 64) { const int n = F.tid; const float ar = S5A[(g * 64 + n) * 2], ai = S5A[(g * 64 + n) * 2 + 1]; float xr = 0.f, xi = 0.f;
        for (int c = 0; c < 128; ++c) { XB[c * S5_XLD + n] = (bf16)f2bf(xr); XB[c * S5_XLD + 64 + n] = (bf16)f2bf(xi);
            const float sr = Ssm[n * S5_SLD + c], si = Ssm[(64 + n) * S5_SLD + c];
            const float nr = ar * xr - ai * xi + sr, ni = ar * xi + ai * xr + si; xr = nr; xi = ni; } }
    __syncthreads();
#pragma unroll 1
    for (int ks = 0; ks < 4; ++ks) {
        const bf16x8 aQ0 = ldg16o(Qg + (size_t)(32 * w) * 128 + 32 * ks, (unsigned)(fr * 128 + 8 * qd) * 2u), aQ1 = ldg16o(Qg + (size_t)(32 * w + 16) * 128 + 32 * ks, (unsigned)(fr * 128 + 8 * qd) * 2u);
#pragma unroll
        for (int ct = 0; ct < 8; ++ct) { const bf16x8 bx = *(const LAS bf16x8*)(XB + (16 * ct + fr) * S5_XLD + 32 * ks + 8 * qd);
            accY[0][ct] = MFMA16(aQ0, bx, accY[0][ct]); accY[1][ct] = MFMA16(aQ1, bx, accY[1][ct]); }
    }
#pragma unroll
    for (int rt = 0; rt < 2; ++rt)
#pragma unroll
        for (int ct = 0; ct < 8; ++ct) { const int tok = (16 * ct + fr) * 16 + 2 * w + rt; const f32x4 y = accY[rt][ct];
            v2u o; o.x = pk2(gelu_tanh(y[0]), gelu_tanh(y[1])); o.y = pk2(gelu_tanh(y[2]), gelu_tanh(y[3]));
            *(GAS v2u*)(ZB + (size_t)(b * SEQ + tok) * 512 + g * 16 + 4 * qd) = o; }
    __syncthreads();
}
constexpr int AT_BIAS_OFF = 0, AT_SEL_OFF = 8192, AT_V_OFF = 24576, AT_VLD = 144  ;
DI s16x4 vtr(const LAS unsigned char* p) { return __builtin_bit_cast(s16x4, __builtin_amdgcn_ds_read_tr16_b64_v4i16((LAS v4i16_t*)p)); }
#define MEMBAR() asm volatile("" ::: "memory")
DI int row16_sum(int x) {
    x += __builtin_amdgcn_update_dpp(0, x, 0xB1, 0xF, 0xF, true);
    x += __builtin_amdgcn_update_dpp(0, x, 0x4E, 0xF, 0xF, true);
    x += __builtin_amdgcn_update_dpp(0, x, 0x141, 0xF, 0xF, true);
    x += __builtin_amdgcn_update_dpp(0, x, 0x140, 0xF, 0xF, true);
    return x; }
DI int xor16_i(int x) { return __builtin_amdgcn_ds_swizzle(x, 0x401F); }
DI float xor16_f(float x) { return __int_as_float(__builtin_amdgcn_ds_swizzle(__float_as_int(x), 0x401F)); }
DI int half32_sum(int x) { x = row16_sum(x); return x + xor16_i(x); }
DI void attn_unit(Frame& F, int b, int tile, const bf16* QI_, const bf16* KVX_, bf16* QA_, const float* BIAS_) {
    const bf16* QI = opq(QI_); const bf16* KVX = opq(KVX_); bf16* QA = opq(QA_); const float* BIAS = opq(BIAS_);
    LAS float* biasL = (LAS float*)(F.lds + RING_OFF + AT_BIAS_OFF);
    const int w = F.wave;
    LAS unsigned short* selw = (LAS unsigned short*)(F.lds + RING_OFF + AT_SEL_OFF) + w * 512;
    LAS unsigned char* kbuf = F.lds + RING_OFF + AT_V_OFF;
    for (int i = F.tid; i < 2048; i += NWAVES * 64) biasL[i] = BIAS[i];
    { LAS v4u* z = (LAS v4u*)selw; z[F.lane] = (v4u){0u, 0u, 0u, 0u}; }
    const size_t rowb = (size_t)b * SEQ;
    const int tb = tile * 16 + 2 * w;
    const int ntile = (tile * 16 + 15) / 256 + 1;
    const int nkp = 8 * ntile;
    unsigned key[64];
    int nsel = 0; unsigned theta = 0u;
#ifndef AT_PROBE
#define AT_PROBE 0
#endif
    _Pragma("unroll 1") for (int rep_abc = 0; rep_abc < (AT_PROBE == 1 ? 2 : 1); ++rep_abc) {
    {
        const int lane = opqv(F.lane), fr = lane & 15, qd = lane >> 4, tq = tb + (qd >> 1), odd = qd & 1;
        const int tid = opqv(F.tid);
        bf16x8 aQ[2];
#pragma unroll
        for (int ks = 0; ks < 2; ++ks) aQ[ks] = ldg16(QI + (rowb + tb + (fr >> 3)) * 512 + (fr & 7) * 64 + 32 * ks + 8 * qd);
        const v2u wraw = *(const GAS v2u*)(KVX + (rowb + tq) * 256 + 192 + 4 * odd);
        const float wv[4] = {bflo(wraw.x), bfhi(wraw.x), bflo(wraw.y), bfhi(wraw.y)};
        const unsigned goff = (unsigned)((tid >> 3) * 256 + (tid & 7) * 8) * 2u, loff = (unsigned)((tid >> 3) * 144 + (tid & 7) * 16);
        v4u stg[4];
        const bf16* gki = KVX + rowb * 256 + 128;
#pragma unroll
        for (int i = 0; i < 4; ++i) stg[i] = ldg16u(gki + (size_t)(64 * i) * 256, goff);
#pragma unroll
        for (int i = 0; i < 4; ++i) *(LAS v4u*)(kbuf + 64 * i * 144 + loff) = stg[i];
        __syncthreads();
        const unsigned roff = (unsigned)(fr * 144 + qd * 16);
#pragma unroll 1
        for (int kt = 0; kt < ntile; ++kt) {
            const bool more = kt + 1 < ntile;
            if (more) {
#pragma unroll
                for (int i = 0; i < 4; ++i) stg[i] = ldg16u(gki + (size_t)(256 * (kt + 1) + 64 * i) * 256, goff); }
            const LAS unsigned char* kb = kbuf + (kt & 1) * (256 * 144) + roff;
            unsigned tmp[8];
#pragma unroll
            for (int j = 0; j < 8; ++j) {
                const bf16x8 e0 = *(const LAS bf16x8*)(kb + (32 * j) * 144), e1 = *(const LAS bf16x8*)(kb + (32 * j) * 144 + 64);
                const bf16x8 o0 = *(const LAS bf16x8*)(kb + (32 * j + 16) * 144), o1 = *(const LAS bf16x8*)(kb + (32 * j + 16) * 144 + 64);
                f32x4 cE = (f32x4){0.f, 0.f, 0.f, 0.f}, cO = cE;
                cE = MFMA16(aQ[0], e0, cE); cE = MFMA16(aQ[1], e1, cE); cO = MFMA16(aQ[0], o0, cO); cO = MFMA16(aQ[1], o1, cO);
                float sE = 0.f, sO = 0.f;
#pragma unroll
                for (int r = 0; r < 4; ++r) { sE += wv[r] * fmaxf(cE[r], 0.f); sO += wv[r] * fmaxf(cO[r], 0.f); }
                sE += xor16_f(sE); sO += xor16_f(sO);
                float s = odd ? sO : sE; s += 0.0f;
                const unsigned bits = __float_as_uint(s); const unsigned sk = bits ^ ((unsigned)((int)bits >> 31) | 0x80000000u);
                tmp[j] = (256 * kt + 32 * j + 16 * odd + fr <= tq) ? sk : 0u;
            }
#define KEYCASE(c) case c: _Pragma("unroll") for (int j = 0; j < 8; ++j) key[8 * c + j] = tmp[j]; break;
            switch (kt) { KEYCASE(0) KEYCASE(1) KEYCASE(2) KEYCASE(3) KEYCASE(4) KEYCASE(5) KEYCASE(6) default: _Pragma("unroll") for (int j = 0; j < 8; ++j) key[56 + j] = tmp[j]; break; }
#undef KEYCASE
            if (more) {
#pragma unroll
                for (int i = 0; i < 4; ++i) *(LAS v4u*)(kbuf + ((kt + 1) & 1) * (256 * 144) + 64 * i * 144 + loff) = stg[i]; }
            __syncthreads();
        }
    }
    theta = 0u; bool fin = false;
#pragma unroll 1
    for (int bit = 31; bit >= 0; --bit) {
        const unsigned cand = theta | (1u << bit); int cnt = 0;
#pragma unroll
        for (int ch = 0; ch < 8; ++ch) if (ch * 8 < nkp) {
#pragma unroll
            for (int j = 0; j < 8; ++j) cnt += (key[ch * 8 + j] >= cand) ? 1 : 0; }
        cnt = half32_sum(cnt);
        if (!fin && cnt >= 256) theta = cand;
        fin = fin || (cnt == 256);
        if (__all(fin)) break;
    }
    {
        const int lane = opqv(F.lane), fr = lane & 15, qd = lane >> 4, odd = qd & 1;
        int cgt = 0;
#pragma unroll
        for (int ch = 0; ch < 8; ++ch) if (ch * 8 < nkp) {
#pragma unroll
            for (int j = 0; j < 8; ++j) cgt += (key[ch * 8 + j] > theta) ? 1 : 0; }
        cgt = half32_sum(cgt);
        const int quota = (theta == 0u) ? 0 : (256 - cgt);
        int base = 0, eqseen = 0; const unsigned below = (1u << (lane & 31)) - 1u; const int sh = 32 * (qd >> 1);
        LAS unsigned short* sl = selw + (qd >> 1) * 256;
#pragma unroll 1
        for (int ch = 0; ch * 8 < nkp; ++ch) {
            unsigned tmp[8];
#define KEYCASE(c) case c: _Pragma("unroll") for (int j = 0; j < 8; ++j) tmp[j] = key[8 * c + j]; break;
            switch (ch) { KEYCASE(0) KEYCASE(1) KEYCASE(2) KEYCASE(3) KEYCASE(4) KEYCASE(5) KEYCASE(6) default: _Pragma("unroll") for (int j = 0; j < 8; ++j) tmp[j] = key[56 + j]; break; }
#undef KEYCASE
#pragma unroll
            for (int j = 0; j < 8; ++j) {
                const bool gtk = tmp[j] > theta, eqk = (tmp[j] == theta) && (theta != 0u);
                const unsigned long long be = __ballot(eqk); const unsigned e32 = (unsigned)(be >> sh); const int pe = __popc(e32 & below);
                const bool take = gtk || (eqk && (eqseen + pe) < quota);
                const unsigned long long bt = __ballot(take); const unsigned t32 = (unsigned)(bt >> sh); const int pt = __popc(t32 & below);
                if (take) sl[base + pt] = (unsigned short)(256 * ch + 32 * j + 16 * odd + fr);
                base += __popc(t32); eqseen += __popc(e32);
            }
        }
        nsel = base;
    }
    }
#pragma unroll 1
    for (int qq2 = 0; qq2 < (AT_PROBE == 2 ? 4 : 2); ++qq2) { const int qq = qq2 & 1;
        const int lane = opqv(F.lane), fr = lane & 15, qd = lane >> 4;
        LAS unsigned char* Vs = F.lds + RING_OFF + AT_V_OFF + w * (64 * AT_VLD);
        const int t = tb + qq; const int ns = __shfl(nsel, 32 * qq);
        const LAS unsigned short* sl = selw + qq * 256;
        bf16* qrow = QA + (rowb + t) * 1024; bf16* orow = (qq2 < 2) ? qrow : (bf16*)((unsigned char*)QA + (WS_END - WS_Q)) + (size_t)(t & 2047) * 1024;
        bf16x8 bq[2];
#pragma unroll
        for (int ks = 0; ks < 2; ++ks) bq[ks] = ldg16(qrow + fr * 64 + 32 * ks + 8 * qd);
        f32x4 st[16];
#pragma unroll
        for (int blk = 0; blk < 16; ++blk) { const int kidx = sl[16 * blk + fr];
            const unsigned ko = (unsigned)(kidx * 256 + 8 * qd) * 2u; const bf16x8 a0 = ldg16o(KVX + rowb * 256, ko), a1 = ldg16o(KVX + rowb * 256 + 32, ko);
            f32x4 c = (f32x4){0.f, 0.f, 0.f, 0.f}; c = MFMA16(a0, bq[0], c); c = MFMA16(a1, bq[1], c); st[blk] = c;
            if ((blk & 7) == 7) MEMBAR(); }
        float mx = -3.0e38f;
#pragma unroll
        for (int blk = 0; blk < 16; ++blk) { const u16x4 k4 = *(const LAS u16x4*)(sl + 16 * blk + 4 * qd);
#pragma unroll
            for (int r = 0; r < 4; ++r) { int dist = t - (int)k4[r]; dist = dist < 0 ? 0 : (dist > 127 ? 127 : dist);
                float lg = st[blk][r] + biasL[dist * 16 + fr]; if (16 * blk + 4 * qd + r >= ns) lg = -1.0e30f; st[blk][r] = lg; mx = fmaxf(mx, lg); } }
        mx = fmaxf(mx, __shfl_xor(mx, 16)); mx = fmaxf(mx, __shfl_xor(mx, 32));
        float sum = 0.f;
#pragma unroll
        for (int blk = 0; blk < 16; ++blk)
#pragma unroll
            for (int r = 0; r < 4; ++r) { const float p = __expf(st[blk][r] - mx); st[blk][r] = p; sum += p; }
        sum += __shfl_xor(sum, 16); sum += __shfl_xor(sum, 32);
        const float inv = 1.0f / sum;
        f32x4 o[4];
#pragma unroll
        for (int nb = 0; nb < 4; ++nb) o[nb] = (f32x4){0.f, 0.f, 0.f, 0.f};
        v4u vv[8];
#pragma unroll
        for (int i = 0; i < 8; ++i) { const int piece = lane + 64 * i, row = piece >> 3, pc = piece & 7; const int kidx = sl[row];
            vv[i] = ldg16u(KVX + rowb * 256 + 64, (unsigned)(kidx * 256 + 8 * pc) * 2u); }
#pragma unroll
        for (int vr = 0; vr < 4; ++vr) {
#pragma unroll
            for (int i = 0; i < 8; ++i) { const int piece = lane + 64 * i, row = piece >> 3, pc = piece & 7; *(LAS v4u*)(Vs + row * AT_VLD + pc * 16) = vv[i]; }
            if (vr < 3) {
#pragma unroll
                for (int i = 0; i < 8; ++i) { const int piece = lane + 64 * i, row = piece >> 3, pc = piece & 7; const int kidx = sl[64 * (vr + 1) + row];
                    vv[i] = ldg16u(KVX + rowb * 256 + 64, (unsigned)(kidx * 256 + 8 * pc) * 2u); } }
#pragma unroll
            for (int kk = 0; kk < 2; ++kk) {
                const f32x4 p0 = st[4 * vr + 2 * kk] * inv, p1 = st[4 * vr + 2 * kk + 1] * inv;
                const v4u pw = (v4u){pk2(p0[0], p0[1]), pk2(p0[2], p0[3]), pk2(p1[0], p1[1]), pk2(p1[2], p1[3])};
                const bf16x8 pa = __builtin_bit_cast(bf16x8, pw);
                const int q4 = fr >> 2, p4 = fr & 3;
#pragma unroll
                for (int nb = 0; nb < 4; ++nb) {
                    const s16x4 lo = vtr(Vs + (32 * kk + 4 * qd + q4) * AT_VLD + (16 * nb + 4 * p4) * 2);
                    const s16x4 hi = vtr(Vs + (32 * kk + 16 + 4 * qd + q4) * AT_VLD + (16 * nb + 4 * p4) * 2);
                    const bf16x8 bv = (bf16x8){lo[0], lo[1], lo[2], lo[3], hi[0], hi[1], hi[2], hi[3]};
                    o[nb] = MFMA16(pa, bv, o[nb]);
                }
            }
        }
#pragma unroll
        for (int nb = 0; nb < 4; ++nb)
#pragma unroll
            for (int r = 0; r < 4; ++r) orow[(4 * qd + r) * 64 + 16 * nb + fr] = (bf16)f2bf(o[nb][r]);
    }
    __syncthreads();
}

#ifndef PH_MASK
#define PH_MASK 0x1ff
#endif
#define PH_ON(k) (((PH_MASK) >> (k)) & 1)
#ifndef PH_DUP
#define PH_DUP 0
#endif
#define NREP(k) ((((PH_DUP) >> (k)) & 1) ? 2 : 1)
#ifndef MK_SP2
#define MK_SP2 true
#endif
#ifndef MK_ALIGN
#define MK_ALIGN true
#endif
__global__ void __launch_bounds__(NWAVES * 64, 2) hybrid_fwd(Args args) {
    extern __shared__ __attribute__((aligned(16))) unsigned char lds[];
#define MKFRAME() Frame F; F.lds = (LAS unsigned char*)lds; F.tid = opqv((int)threadIdx.x); F.lane = F.tid & 63; F.wave = __builtin_amdgcn_readfirstlane(F.tid >> 6); F.G = gridDim.x
    const int lo = args.ph_lo, hi = args.ph_hi;
    {   KArgs A = kargs(); gu32* ctl = (gu32*)(A->ws + WS_CTL); MKFRAME();
        for (int u = F.tid; u < (LDS_BYTES - LDSCTL_OFF) / 4; u += NWAVES * 64) ((LAS unsigned*)(F.lds + LDSCTL_OFF))[u] = 0u;
        __syncthreads();
        volatile LAS unsigned* MISC = (volatile LAS unsigned*)(F.lds + MISC_OFF);
        (void)xcd_barrier_post((unsigned*)(ctl + CW_BAR), MISC + 8); }
#define IN(k) (lo <= (k) && (k) < hi)
#define BOTH(k) (IN(k) && IN((k) + 1))
#define GRID_BAR() do { KArgs Ab = kargs(); XcdBarrier bar; bar.bar = (unsigned*)((gu32*)(Ab->ws + WS_CTL) + CW_BAR); bar.x = xb_xcc_id(); bar.st = (volatile LAS unsigned*)((LAS unsigned char*)lds + MISC_OFF) + 8; xcd_barrier(bar); } while (0)
#define WSP(T, off) ((T*)(ws + (off)))

    if (PH_ON(0) && IN(0)) { KArgs A = kargs(); unsigned char* ws = A->ws; MKFRAME();
        _Pragma("unroll 1") for (int rep = 0; rep < NREP(11); ++rep) convert_A(F, A, ws, 0);
        rms_rows_to_bf16(F, A->in.x, A->in.n_mix_pre, WSP(bf16, WS_HB)); if (BOTH(0)) GRID_BAR(); }

#pragma unroll 1
    for (int l = 0; l < NLAYER; ++l) {
        const int pb = 1 + 8 * l;
        if (PH_ON(1) && IN(pb)) { KArgs A = kargs(); unsigned char* ws = A->ws; MKFRAME();
            pg8::Gemm g{WSP(bf16, WS_HB), WSP(bf16, WS_WINT), M, N1P, D}; pg8::StaticOrder S; S.init(M, N1P, F.G, (int)blockIdx.x);
            pg8::EpiRoute E{WSP(bf16, WS_POOLU), WSP(bf16, WS_S5U), WSP(bf16, WS_Q), WSP(bf16, WS_QI), WSP(bf16, WS_KVX), WSP(bf16, WS_GATES)};
            _Pragma("unroll 1") for (int rep = 0; rep < NREP(1); ++rep)
            pg8::gemm_phase<pg8::EpiRoute, pg8::StaticOrder, MK_ALIGN, MK_SP2>(F.lds + RING_OFF, g, S, E);
            if (BOTH(pb)) GRID_BAR();
        }
        if (PH_ON(2) && IN(pb + 1)) { KArgs A = kargs(); unsigned char* ws = A->ws; MKFRAME();
#ifndef NO_POOL
            _Pragma("unroll 1") for (int rep = 0; rep < NREP(9); ++rep)
            pool_stencil(F, WSP(bf16, WS_POOLU), WSP(bf16, WS_DP));
#endif
#ifndef NO_S5
            _Pragma("unroll 1") for (int rep = 0; rep < NREP(10); ++rep)
#pragma unroll 1
            for (int u = blockIdx.x; u < 256; u += F.G) s5_unit(F, u & 7, u >> 3, WSP(bf16, WS_S5U), WSP(bf16, WS_S5T), WSP(bf16, WS_S5P), WSP(bf16, WS_S5Q), WSP(float, WS_S5A), WSP(bf16, WS_ZB));
#endif
#ifndef NO_ATTN
#pragma unroll 1
            for (int u4 = 4 * blockIdx.x; u4 < 1024; u4 += 4 * F.G) {
#pragma unroll 1
                for (int h = 0; h < 4; ++h) { const int u = u4 >> 2, b = u & 7, j = u >> 3;
                    const int tile = (h & 2 ? 64 : 0) + ((h & 1) ? 63 - j : j);
                    attn_unit(F, b, tile, WSP(bf16, WS_QI), WSP(bf16, WS_KVX), WSP(bf16, WS_Q), WSP(float, WS_BIAS)); } }
#endif
            if (BOTH(pb + 1)) GRID_BAR();
        }
        if (PH_ON(3) && IN(pb + 2)) {
          _Pragma("unroll 1") for (int rep = 0; rep < NREP(3); ++rep) {
            if (rep) { VM_WAIT(); __builtin_amdgcn_fence(__ATOMIC_ACQUIRE, "agent"); VM_WAIT(); __syncthreads(); }
            { KArgs A = kargs(); unsigned char* ws = A->ws; MKFRAME();
              pg8::Gemm g{WSP(bf16, WS_ZB), WSP(bf16, WS_GLUT), M, 2048, 512}; pg8::PairOrder S; S.base.init(M, D, F.G, (int)blockIdx.x);
              pg8::EpiGlu E{WSP(bf16, WS_MERGED), WSP(bf16, WS_GATES)};
              pg8::gemm_phase<pg8::EpiGlu, pg8::PairOrder, MK_ALIGN, MK_SP2>(F.lds + RING_OFF, g, S, E); }
            VM_WAIT(); __builtin_amdgcn_fence(__ATOMIC_ACQUIRE, "agent"); VM_WAIT(); __syncthreads();
            { KArgs A = kargs(); unsigned char* ws = A->ws; MKFRAME();
              pg8::Gemm g{WSP(bf16, WS_DP), WSP(bf16, WS_POOLET), M, D, 512}; pg8::StaticOrder S; S.init(M, D, F.G, (int)blockIdx.x);
              pg8::EpiAccum<0> E{WSP(bf16, WS_MERGED), WSP(bf16, WS_GATES)};
              pg8::gemm_phase<pg8::EpiAccum<0>, pg8::StaticOrder, MK_ALIGN, MK_SP2>(F.lds + RING_OFF, g, S, E); }
            VM_WAIT(); __builtin_amdgcn_fence(__ATOMIC_ACQUIRE, "agent"); VM_WAIT(); __syncthreads();
            { KArgs A = kargs(); unsigned char* ws = A->ws; MKFRAME();
              pg8::Gemm g{WSP(bf16, WS_Q), WSP(bf16, WS_ATTNOT), M, D, D}; pg8::StaticOrder S; S.init(M, D, F.G, (int)blockIdx.x);
              pg8::EpiAccum<1024> E{WSP(bf16, WS_MERGED), WSP(bf16, WS_GATES)};
              pg8::gemm_phase<pg8::EpiAccum<1024>, pg8::StaticOrder, MK_ALIGN, MK_SP2>(F.lds + RING_OFF, g, S, E); }
          }
            if (BOTH(pb + 2)) GRID_BAR();
        }
        if (PH_ON(4) && IN(pb + 3)) { KArgs A = kargs(); unsigned char* ws = A->ws; MKFRAME();
            pg8::Gemm g{WSP(bf16, WS_MERGED), WSP(bf16, WS_WOUTT), M, D, D}; pg8::StaticOrder S; S.init(M, D, F.G, (int)blockIdx.x);
            pg8::EpiF32 E{WSP(float, WS_F), D};
            _Pragma("unroll 1") for (int rep = 0; rep < NREP(4); ++rep)
            pg8::gemm_phase<pg8::EpiF32, pg8::StaticOrder, MK_ALIGN, MK_SP2>(F.lds + RING_OFF, g, S, E);
            if (BOTH(pb + 3)) GRID_BAR();
        }
        if (PH_ON(5) && IN(pb + 4)) { KArgs A = kargs(); unsigned char* ws = A->ws; MKFRAME();
            _Pragma("unroll 1") for (int rep = 0; rep < NREP(12); ++rep) convert_B(F, A, ws, l);
            norm_phase(F, l == 0 ? A->in.x : (const float*)A->out, A->out, WSP(float, WS_F), A->in.n_mix_post + l * D, A->in.n_ffn_pre + l * D, WSP(bf16, WS_HB));
            if (BOTH(pb + 4)) GRID_BAR();
        }
        if (PH_ON(6) && IN(pb + 5)) { KArgs A = kargs(); unsigned char* ws = A->ws; MKFRAME();
            pg8::Gemm g{WSP(bf16, WS_HB), WSP(bf16, WS_FFNINT), M, 2 * FF, D}; pg8::StaticOrder S; S.init(M, 2 * FF, F.G, (int)blockIdx.x);
            pg8::EpiSwiglu E{WSP(bf16, WS_HID), FF};
            _Pragma("unroll 1") for (int rep = 0; rep < NREP(6); ++rep)
            pg8::gemm_phase<pg8::EpiSwiglu, pg8::StaticOrder, MK_ALIGN, MK_SP2>(F.lds + RING_OFF, g, S, E);
            if (BOTH(pb + 5)) GRID_BAR();
        }
        if (PH_ON(7) && IN(pb + 6)) { KArgs A = kargs(); unsigned char* ws = A->ws; MKFRAME();
            pg8::Gemm g{WSP(bf16, WS_HID), WSP(bf16, WS_FFNOUTT), M, D, FF}; pg8::StaticOrder S; S.init(M, D, F.G, (int)blockIdx.x);
            pg8::EpiF32 E{WSP(float, WS_F), D};
            _Pragma("unroll 1") for (int rep = 0; rep < NREP(7); ++rep)
            pg8::gemm_phase<pg8::EpiF32, pg8::StaticOrder, MK_ALIGN, MK_SP2>(F.lds + RING_OFF, g, S, E);
            if (BOTH(pb + 6)) GRID_BAR();
        }
        if (PH_ON(8) && IN(pb + 7)) { KArgs A = kargs(); unsigned char* ws = A->ws; MKFRAME();
            if (l + 1 < NLAYER) { _Pragma("unroll 1") for (int rep = 0; rep < NREP(11); ++rep) convert_A(F, A, ws, l + 1); }
            norm_phase(F, (const float*)A->out, A->out, WSP(float, WS_F), A->in.n_ffn_post + l * D, (l + 1 < NLAYER) ? A->in.n_mix_pre + (l + 1) * D : (const float*)nullptr, WSP(bf16, WS_HB));
            if (BOTH(pb + 7)) GRID_BAR();
        }
    }
#undef WSP
#undef IN
#undef BOTH
#undef GRID_BAR
}

#ifndef MK_ONE_LAUNCH
#define MK_ONE_LAUNCH 1
#endif
extern "C" void kernel_launch(void* const* d_in, const int* in_sizes, int n_in, void* d_out, int out_size, void* d_ws, size_t ws_size, hipStream_t stream) {
    static int grid = 0;
    if (grid == 0) {
        if (n_in != 23 || in_sizes[0] != M * D || out_size != M * D || ws_size < WS_END) { fprintf(stderr, "kernel_launch: unexpected shapes (n_in %d, in0 %d, out %d, ws %zu); nothing launched\n", n_in, n_in > 0 ? in_sizes[0] : -1, out_size, ws_size); grid = -1; return; }
        int dev = 0, cus = 0, per_cu = 0;
        if (hipGetDevice(&dev) != hipSuccess || hipDeviceGetAttribute(&cus, hipDeviceAttributeMultiprocessorCount, dev) != hipSuccess) { grid = -1; return; }
        if (hipFuncSetAttribute((const void*)hybrid_fwd, hipFuncAttributeMaxDynamicSharedMemorySize, LDS_BYTES) != hipSuccess) { fprintf(stderr, "kernel_launch: hipFuncSetAttribute failed\n"); grid = -1; return; }
        if (hipOccupancyMaxActiveBlocksPerMultiprocessor(&per_cu, (const void*)hybrid_fwd, NWAVES * 64, LDS_BYTES) != hipSuccess || per_cu < 1) { fprintf(stderr, "kernel_launch: occupancy query says %d\n", per_cu); per_cu = 1; }
        (void)hipGetLastError();
        grid = cus;
    }
    if (grid < 0) return;
    if (hipMemsetAsync((char*)d_ws + WS_CTL, 0, CTL_ZERO_BYTES, stream) != hipSuccess) return;
    Args a{};
    const float** ip = (const float**)&a.in;
    for (int i = 0; i < 23; ++i) ip[i] = (const float*)d_in[i];
    a.out = (float*)d_out; a.ws = (unsigned char*)d_ws;
#if MK_ONE_LAUNCH
    a.ph_lo = 0; a.ph_hi = NPHASE;
    hipLaunchKernelGGL(hybrid_fwd, dim3(grid), dim3(NWAVES * 64), LDS_BYTES, stream, a);
#else
    for (int ph = 0; ph < NPHASE; ++ph) { a.ph_lo = ph; a.ph_hi = ph + 1;
        hipLaunchKernelGGL(hybrid_fwd, dim3(grid), dim3(NWAVES * 64), LDS_BYTES, stream, a); }
#endif
}
```

```cpp
#include <hip/hip_runtime.h>
#include <cstdio>
#include <cstdint>
namespace pg8 {
#define PG8_LAS __attribute__((address_space(3)))
typedef unsigned short bf16_t;
typedef short bf16x8 __attribute__((ext_vector_type(8)));
typedef float f32x4 __attribute__((ext_vector_type(4)));
typedef unsigned u32x4 __attribute__((ext_vector_type(4)));
constexpr int BM = 256, BK = 64, HALF = 128, HTB = HALF * BK * 2  , STAGE_BYTES = 8 * HTB, NXCD = 8, WGM = 8;

__host__ __device__ __forceinline__ int lds_byte(int r, int c) { const int st = (r >> 4) * 2 + (c >> 5), rr = r & 15, cc = c & 31, ob = rr * 64 + cc * 2; return st * 1024 + (ob ^ (((ob >> 9) & 1) << 5)); }
__host__ __device__ __forceinline__ void stage_rc(int b, int& R, int& C) { const int st = b / 1024, sb = b % 1024, swz = sb ^ (((sb >> 9) & 1) << 5); R = (st >> 1) * 16 + swz / 64; C = (st & 1) * 32 + (swz % 64) / 2; }
__host__ __device__ __forceinline__ int perm32(int rho) { const int n = rho >> 4, i = rho & 15; return 8 * (i >> 2) + 4 * n + (i & 3); }

struct Unit { int pm, pn; };
struct Gemm { const bf16_t* A; const bf16_t* Bt; int M, N, K; };

struct StaticOrder {
    int nM, nN, nwg, G, c;
    __host__ __device__ void init(int M, int N, int G_, int c_) { nM = M / BM; nN = N / BM; nwg = nM * nN; G = G_; c = c_; }
    __host__ __device__ bool next(int i, Unit& u) const {
        const long L = (long)i * G + c; if (L >= nwg) return false;
        int wgid = (int)L; { const int q = nwg / NXCD, r = nwg % NXCD, xcd = wgid % NXCD, off = wgid / NXCD; wgid = (xcd < r ? xcd * (q + 1) : r * (q + 1) + (xcd - r) * q) + off; }
        const int nig = WGM * nN, gid = wgid / nig, fm = gid * WGM, gsz = (nM - fm) < WGM ? (nM - fm) : WGM;
        u.pm = fm + ((wgid % nig) % gsz); u.pn = (wgid % nig) / gsz; return true;
    }
    __device__ __forceinline__ void a_ready(const Unit&) const {}
    __device__ __forceinline__ void done(const Unit&) const {}
};

__device__ __forceinline__ unsigned cvt_pk_bf16(float lo, float hi) { unsigned r; asm volatile("v_cvt_pk_bf16_f32 %0, %1, %2" : "=v"(r) : "v"(lo), "v"(hi)); return r; }
typedef float f32x2 __attribute__((ext_vector_type(2)));
__device__ __forceinline__ float sigm(float x) { return __builtin_amdgcn_rcpf(1.0f + __expf(-x)); }
__device__ __forceinline__ float bf_lo(unsigned w) { return __uint_as_float(w << 16); }
__device__ __forceinline__ float bf_hi(unsigned w) { return __uint_as_float(w & 0xffff0000u); }
__device__ __forceinline__ u32x4 pack8(const f32x4& v0, const f32x4& v1) { u32x4 w; w.x = cvt_pk_bf16(v0[0], v0[1]); w.y = cvt_pk_bf16(v0[2], v0[3]); w.z = cvt_pk_bf16(v1[0], v1[1]); w.w = cvt_pk_bf16(v1[2], v1[3]); return w; }

struct EpiF32 {
    static constexpr bool PERM = false, AFTER_DRAIN = false;
    float* C; int ldc;
    __device__ __forceinline__ void operator()(const f32x4 (&acc)[2][2][4][2], const Unit& u, int wr, int wc, int fr, int fq) const {
        const int row0 = u.pm * BM + wr * 64 + fr, col0 = u.pn * BM + wc * 32 + 4 * fq;
#pragma unroll
        for (int ai = 0; ai < 2; ++ai)
#pragma unroll
            for (int m = 0; m < 4; ++m) { float* rowp = C + (size_t)(row0 + ai * HALF + m * 16) * ldc + col0;
#pragma unroll
                for (int bj = 0; bj < 2; ++bj)
#pragma unroll
                    for (int n = 0; n < 2; ++n) *(f32x4*)(rowp + bj * HALF + n * 16) = acc[ai][bj][m][n]; }
    }
};
struct EpiRoute {
    static constexpr bool PERM = true, AFTER_DRAIN = false;
    bf16_t *poolu, *s5u, *q, *qi, *kvx, *gates;
    __device__ __forceinline__ void operator()(const f32x4 (&acc)[2][2][4][2], const Unit& u, int wr, int wc, int fr, int fq) const {
        const int row0 = u.pm * BM + wr * 64 + fr; const int pn = u.pn;
        bf16_t* base; int ld, colt, mode = 0;
        if (pn < 2) { base = poolu; ld = 512; colt = pn * 256; }
        else if (pn < 4) { base = s5u; ld = 512; colt = (pn - 2) * 256; }
        else if (pn < 8) { base = q; ld = 1024; colt = (pn - 4) * 256; mode = 2; }
        else if (pn < 10) { base = qi; ld = 512; colt = (pn - 8) * 256; }
        else if (pn == 10) { base = kvx; ld = 256; colt = 0; }
        else { base = gates; ld = 3072; colt = (pn - 11) * 256; mode = 1; }
        const int col0 = colt + wc * 32 + 8 * fq;
#pragma unroll
        for (int ai = 0; ai < 2; ++ai)
#pragma unroll
            for (int m = 0; m < 4; ++m) { bf16_t* rowp = base + (size_t)(row0 + ai * HALF + m * 16) * ld + col0;
#pragma unroll
                for (int bj = 0; bj < 2; ++bj) { f32x4 v0 = acc[ai][bj][m][0], v1 = acc[ai][bj][m][1];
                    if (mode == 1) {
#pragma unroll
                        for (int j = 0; j < 4; ++j) { v0[j] = sigm(v0[j]); v1[j] = sigm(v1[j]); } }
                    else if (mode == 2) { v0 = v0 * 0.125f; v1 = v1 * 0.125f; }
                    *(u32x4*)(rowp + bj * HALF) = pack8(v0, v1); } }
    }
};
struct EpiGlu {
    static constexpr bool PERM = true, AFTER_DRAIN = false;
    bf16_t* merged; const bf16_t* gates;
    __device__ __forceinline__ void operator()(const f32x4 (&acc)[2][2][4][2], const Unit& u, int wr, int wc, int fr, int fq) const {
        const int row0 = u.pm * BM + wr * 64 + fr, col0 = u.pn * HALF + wc * 32 + 8 * fq;
#pragma unroll
        for (int ai = 0; ai < 2; ++ai)
#pragma unroll
            for (int m = 0; m < 4; ++m) { const size_t row = (size_t)(row0 + ai * HALF + m * 16);
                const u32x4 g = *(const u32x4*)(gates + row * 3072 + 2048 + col0);
                f32x4 a0 = acc[ai][0][m][0], a1 = acc[ai][0][m][1]; const f32x4 s0 = acc[ai][1][m][0], s1 = acc[ai][1][m][1];
#pragma unroll
                for (int j = 0; j < 4; ++j) { a0[j] *= sigm(s0[j]); a1[j] *= sigm(s1[j]); }
                a0[0] *= bf_lo(g.x); a0[1] *= bf_hi(g.x); a0[2] *= bf_lo(g.y); a0[3] *= bf_hi(g.y);
                a1[0] *= bf_lo(g.z); a1[1] *= bf_hi(g.z); a1[2] *= bf_lo(g.w); a1[3] *= bf_hi(g.w);
                *(u32x4*)(merged + row * 1024 + col0) = pack8(a0, a1);
                asm volatile("" ::: "memory"); }
    }
};
template <int GOFF> struct EpiAccum {
    static constexpr bool PERM = true, AFTER_DRAIN = false;
    bf16_t* merged; const bf16_t* gates;
    __device__ __forceinline__ void operator()(const f32x4 (&acc)[2][2][4][2], const Unit& u, int wr, int wc, int fr, int fq) const {
        const int row0 = u.pm * BM + wr * 64 + fr, col0 = u.pn * BM + wc * 32 + 8 * fq;
#pragma unroll
        for (int ai = 0; ai < 2; ++ai)
#pragma unroll
            for (int m = 0; m < 4; ++m) { const size_t row = (size_t)(row0 + ai * HALF + m * 16);
#pragma unroll
                for (int bj = 0; bj < 2; ++bj) { const int c = col0 + bj * HALF;
                    const u32x4 g = *(const u32x4*)(gates + row * 3072 + GOFF + c); const u32x4 o = *(const u32x4*)(merged + row * 1024 + c);
                    f32x4 a0 = acc[ai][bj][m][0], a1 = acc[ai][bj][m][1];
                    a0[0] = a0[0] * bf_lo(g.x) + bf_lo(o.x); a0[1] = a0[1] * bf_hi(g.x) + bf_hi(o.x); a0[2] = a0[2] * bf_lo(g.y) + bf_lo(o.y); a0[3] = a0[3] * bf_hi(g.y) + bf_hi(o.y);
                    a1[0] = a1[0] * bf_lo(g.z) + bf_lo(o.z); a1[1] = a1[1] * bf_hi(g.z) + bf_hi(o.z); a1[2] = a1[2] * bf_lo(g.w) + bf_lo(o.w); a1[3] = a1[3] * bf_hi(g.w) + bf_hi(o.w);
                    *(u32x4*)(merged + row * 1024 + c) = pack8(a0, a1); }
                asm volatile("" ::: "memory"); }
    }
};
struct EpiSwiglu {
    static constexpr bool PERM = true, AFTER_DRAIN = false;
    bf16_t* hid; int ldh;
    __device__ __forceinline__ void operator()(const f32x4 (&acc)[2][2][4][2], const Unit& u, int wr, int wc, int fr, int fq) const {
        const int row0 = u.pm * BM + wr * 64 + fr, col0 = u.pn * HALF + wc * 32 + 8 * fq;
#pragma unroll
        for (int ai = 0; ai < 2; ++ai)
#pragma unroll
            for (int m = 0; m < 4; ++m) { const size_t row = (size_t)(row0 + ai * HALF + m * 16);
                f32x4 g0 = acc[ai][0][m][0], g1 = acc[ai][0][m][1]; const f32x4 u0 = acc[ai][1][m][0], u1 = acc[ai][1][m][1];
#pragma unroll
                for (int j = 0; j < 4; ++j) { g0[j] = g0[j] * sigm(g0[j]) * u0[j]; g1[j] = g1[j] * sigm(g1[j]) * u1[j]; }
                *(u32x4*)(hid + row * ldh + col0) = pack8(g0, g1); }
    }
};
struct PairOrder {
    StaticOrder base;
    __device__ bool next(int i, Unit& u) const { Unit b; if (!base.next(i >> 1, b)) return false; u.pm = b.pm; u.pn = 2 * b.pn + (i & 1); return true; }
    __device__ __forceinline__ void a_ready(const Unit&) const {}
    __device__ __forceinline__ void done(const Unit&) const {}
};

template <class Epi, class Sched, bool ALIGN_EPI = false, bool SP2 = false>
__device__ __forceinline__ void gemm_phase(PG8_LAS unsigned char* lds, const Gemm g, const Sched& S, const Epi& E) {
    int tid_ = threadIdx.x; asm volatile("" : "+v"(tid_));
    const int tid = tid_, wid = __builtin_amdgcn_readfirstlane(tid >> 6), lane = tid & 63, wr = wid >> 2, wc = wid & 3, fr = lane & 15, fq = lane >> 4;
    const int K = g.K, nt = K / BK;
    unsigned voffA[2], voffB[2];
#pragma unroll
    for (int i = 0; i < 2; ++i) { int R, C; stage_rc(tid * 16 + i * 8192, R, C); const int Rb = Epi::PERM ? ((R & ~31) + perm32(R & 31)) : R;
        voffA[i] = (unsigned)(R * K + C) * 2u; voffB[i] = (unsigned)(Rb * K + C) * 2u; }
    const size_t kstep = (size_t)(BK * 2);
    const size_t hstep = (size_t)HALF * K * 2;
    const size_t tstep = 2 * hstep;
    const unsigned ldsw = (unsigned)wid * 1024u;
    const int aoff = lds_byte(wr * 64 + fr, fq * 8), boff = lds_byte(wc * 32 + fr, fq * 8);
#define PG8_SA(b, h) (((b) * 2 + (h)) * HTB)
#define PG8_SB(b, h) ((4 + (b) * 2 + (h)) * HTB)
#define PG8_STAGE(bufoff, gbase, voff) do { _Pragma("unroll") for (int _i = 0; _i < 2; ++_i) \
        __builtin_amdgcn_global_load_lds((const unsigned*)((const char*)(gbase) + (voff)[_i]), (PG8_LAS unsigned*)(lds + (bufoff) + ldsw + _i * 8192), 16, 0, 0); } while (0)
#define PG8_LDA(dst, b, h) do { _Pragma("unroll") for (int m = 0; m < 4; ++m) _Pragma("unroll") for (int k = 0; k < 2; ++k) dst[m][k] = *(const PG8_LAS bf16x8*)(lds + PG8_SA(b, h) + aoff + m * 2048 + k * 1024); } while (0)
#define PG8_LDB(dst, b, h) do { _Pragma("unroll") for (int n = 0; n < 2; ++n) _Pragma("unroll") for (int k = 0; k < 2; ++k) dst[n][k] = *(const PG8_LAS bf16x8*)(lds + PG8_SB(b, h) + boff + n * 2048 + k * 1024); } while (0)
#define PG8_MMA(ai, bj, At, Bt) do { __builtin_amdgcn_s_setprio(1); _Pragma("unroll") for (int m = 0; m < 4; ++m) _Pragma("unroll") for (int n = 0; n < 2; ++n) _Pragma("unroll") for (int k = 0; k < 2; ++k) \
        acc[ai][bj][m][n] = __builtin_amdgcn_mfma_f32_16x16x32_bf16(Bt[n][k], At[m][k], acc[ai][bj][m][n], 0, 0, 0); __builtin_amdgcn_s_setprio(0); } while (0)
#define PG8_WAIT_V(n) asm volatile("s_waitcnt vmcnt(" #n ")" ::: "memory")
#define PG8_WAIT_L(n) asm volatile("s_waitcnt lgkmcnt(" #n ")" ::: "memory")
#define PG8_BAR __builtin_amdgcn_s_barrier()
#define PG8_SCHED __builtin_amdgcn_sched_barrier(0)
    Unit cur, nxt; int ui = 0;
    if (!S.next(0, cur)) return;
    f32x4 acc[2][2][4][2];
#pragma unroll
    for (int a = 0; a < 2; ++a)
#pragma unroll
        for (int b = 0; b < 2; ++b)
#pragma unroll
            for (int m = 0; m < 4; ++m)
#pragma unroll
                for (int n = 0; n < 2; ++n) acc[a][b][m][n] = (f32x4){0.f, 0.f, 0.f, 0.f};
    bf16x8 At[4][2], B0[2][2], B1[2][2];
    const char* cA = (const char*)g.A + (size_t)cur.pm * tstep; const char* cB = (const char*)g.Bt + (size_t)cur.pn * tstep;
    S.a_ready(cur);
    if constexpr (SP2) {
        PG8_STAGE(PG8_SB(0, 0), cB, voffB); PG8_STAGE(PG8_SB(0, 1), cB + hstep, voffB); PG8_STAGE(PG8_SA(0, 0), cA, voffA); PG8_STAGE(PG8_SA(0, 1), cA + hstep, voffA);
        if (wr == 1) PG8_BAR;
        PG8_WAIT_V(2); PG8_BAR;
        PG8_STAGE(PG8_SB(1, 0), cB + kstep, voffB); PG8_STAGE(PG8_SA(1, 0), cA + kstep, voffA); PG8_STAGE(PG8_SB(1, 1), cB + hstep + kstep, voffB);
        PG8_WAIT_V(6); PG8_BAR;
    } else {
        PG8_STAGE(PG8_SB(0, 0), cB, voffB); PG8_STAGE(PG8_SA(0, 0), cA, voffA); PG8_STAGE(PG8_SB(0, 1), cB + hstep, voffB); PG8_STAGE(PG8_SA(0, 1), cA + hstep, voffA);
        if (wr == 1) PG8_BAR;
        PG8_WAIT_V(4); PG8_BAR;
        PG8_STAGE(PG8_SB(1, 0), cB + kstep, voffB); PG8_STAGE(PG8_SA(1, 0), cA + kstep, voffA); PG8_STAGE(PG8_SB(1, 1), cB + hstep + kstep, voffB);
        PG8_WAIT_V(6); PG8_BAR;
    }
    for (;;) {
        const bool has_next = S.next(ui + 1, nxt);
        const char* nA = has_next ? (const char*)g.A + (size_t)nxt.pm * tstep : cA; const char* nB = has_next ? (const char*)g.Bt + (size_t)nxt.pn * tstep : cB;
        for (int t = 0; t < nt; t += 2) {
            const bool last = (t == nt - 2);
            const char* a1 = cA + (size_t)(t + 1) * kstep;
            const char* a2 = last ? nA : cA + (size_t)(t + 2) * kstep; const char* b2 = last ? nB : cB + (size_t)(t + 2) * kstep;
            const char* a3 = a2 + kstep; const char* b3 = b2 + kstep;
            if (last && has_next) S.a_ready(nxt);
            if constexpr (SP2) {
            PG8_LDB(B0, 0, 0); PG8_LDB(B1, 0, 1); PG8_SCHED; PG8_LDA(At, 0, 0); PG8_STAGE(PG8_SA(1, 1), a1 + hstep, voffA);
            PG8_WAIT_V(8); PG8_WAIT_L(0); PG8_BAR; PG8_MMA(0, 0, At, B0); PG8_MMA(0, 1, At, B1); PG8_BAR; PG8_SCHED;
            PG8_LDA(At, 0, 1); PG8_STAGE(PG8_SB(0, 0), b2, voffB); PG8_STAGE(PG8_SB(0, 1), b2 + hstep, voffB); PG8_STAGE(PG8_SA(0, 0), a2, voffA);
            PG8_WAIT_V(8); PG8_WAIT_L(0); PG8_BAR; PG8_MMA(1, 0, At, B0); PG8_MMA(1, 1, At, B1); PG8_BAR; PG8_SCHED;
            PG8_LDB(B0, 1, 0); PG8_LDB(B1, 1, 1); PG8_SCHED; PG8_LDA(At, 1, 0); PG8_STAGE(PG8_SA(0, 1), a2 + hstep, voffA);
            PG8_WAIT_V(8); PG8_WAIT_L(0); PG8_BAR; PG8_MMA(0, 0, At, B0); PG8_MMA(0, 1, At, B1); PG8_BAR; PG8_SCHED;
            PG8_LDA(At, 1, 1); PG8_STAGE(PG8_SB(1, 0), b3, voffB); PG8_STAGE(PG8_SB(1, 1), b3 + hstep, voffB); PG8_STAGE(PG8_SA(1, 0), a3, voffA);
            PG8_WAIT_V(8); PG8_WAIT_L(0); PG8_BAR; PG8_MMA(1, 0, At, B0); PG8_MMA(1, 1, At, B1); PG8_BAR; PG8_SCHED;
            } else {
            PG8_LDB(B0, 0, 0); PG8_SCHED; PG8_LDA(At, 0, 0); PG8_STAGE(PG8_SA(1, 1), a1 + hstep, voffA);
            PG8_WAIT_L(8); PG8_BAR; PG8_WAIT_L(0); PG8_MMA(0, 0, At, B0); PG8_BAR; PG8_SCHED;
            PG8_LDB(B1, 0, 1); PG8_STAGE(PG8_SB(0, 0), b2, voffB);
            PG8_BAR; PG8_WAIT_L(0); PG8_MMA(0, 1, At, B1); PG8_BAR;
            PG8_LDA(At, 0, 1); PG8_STAGE(PG8_SA(0, 0), a2, voffA);
            PG8_BAR; PG8_WAIT_L(0); PG8_MMA(1, 0, At, B0); PG8_BAR; PG8_SCHED;
            PG8_STAGE(PG8_SB(0, 1), b2 + hstep, voffB);
            PG8_WAIT_V(6); PG8_BAR; PG8_MMA(1, 1, At, B1); PG8_BAR;
            PG8_LDB(B0, 1, 0); PG8_SCHED; PG8_LDA(At, 1, 0); PG8_STAGE(PG8_SA(0, 1), a2 + hstep, voffA);
            PG8_WAIT_L(8); PG8_BAR; PG8_WAIT_L(0); PG8_MMA(0, 0, At, B0); PG8_BAR; PG8_SCHED;
            PG8_LDB(B1, 1, 1); PG8_STAGE(PG8_SB(1, 0), b3, voffB);
            PG8_BAR; PG8_WAIT_L(0); PG8_MMA(0, 1, At, B1); PG8_BAR;
            PG8_LDA(At, 1, 1); PG8_STAGE(PG8_SA(1, 0), a3, voffA);
            PG8_BAR; PG8_WAIT_L(0); PG8_MMA(1, 0, At, B0); PG8_BAR; PG8_SCHED;
            PG8_STAGE(PG8_SB(1, 1), b3 + hstep, voffB);
            PG8_WAIT_V(6); PG8_BAR; PG8_MMA(1, 1, At, B1); PG8_BAR;
            }
        }
        if constexpr (ALIGN_EPI) { if (wr == 0) PG8_BAR; }
        if constexpr (!Epi::AFTER_DRAIN) { E(acc, cur, wr, wc, fr, fq); S.done(cur); }
        if (!has_next) break;
#pragma unroll
        for (int a = 0; a < 2; ++a)
#pragma unroll
            for (int b = 0; b < 2; ++b)
#pragma unroll
                for (int m = 0; m < 4; ++m)
#pragma unroll
                    for (int n = 0; n < 2; ++n) acc[a][b][m][n] = (f32x4){0.f, 0.f, 0.f, 0.f};
        cur = nxt; cA = nA; cB = nB; ++ui;
        if constexpr (ALIGN_EPI) { if (wr == 1) PG8_BAR; }
    }
    PG8_WAIT_V(0);
    if constexpr (!ALIGN_EPI) { if (wr == 0) PG8_BAR; }
    PG8_BAR;
    if constexpr (Epi::AFTER_DRAIN) { E.fused(acc, cur, wr, wc, fr, fq, lds, wid, lane); S.done(cur); }
#undef PG8_SA
#undef PG8_SB
#undef PG8_STAGE
#undef PG8_LDA
#undef PG8_LDB
#undef PG8_MMA
#undef PG8_WAIT_V
#undef PG8_WAIT_L
#undef PG8_BAR
#undef PG8_SCHED
}
}

constexpr int NWAVES = 8;
constexpr int BATCH = 8, SEQ = 2048, D = 1024, M = BATCH * SEQ;
constexpr int INW = 5832, N1P = 5888, FF = 2816, NLAYER = 2;
constexpr float NORM_EPS = 1e-6f;
constexpr size_t MiB = 1u << 20;
constexpr size_t WS_CTL = 0, CTL_ZERO_BYTES = 1 * MiB;
constexpr size_t WS_WINT = 1 * MiB;
constexpr size_t WS_ATTNOT = WS_WINT + (size_t)N1P * D * 2;
constexpr size_t WS_POOLET = WS_ATTNOT + 2 * MiB;
constexpr size_t WS_GLUT = WS_POOLET + 1 * MiB;
constexpr size_t WS_WOUTT = WS_GLUT + 2 * MiB;
constexpr size_t WS_S5T = WS_WOUTT + 2 * MiB;
constexpr size_t WS_S5P = WS_S5T + 4 * MiB;
constexpr size_t WS_S5Q = WS_S5P + 2 * MiB;
constexpr size_t WS_S5A = WS_S5Q + 2 * MiB;
constexpr size_t WS_BIAS = WS_S5A + 65536;
static_assert(WS_BIAS + 8192 <= 29 * MiB, "weights region");
constexpr size_t WS_HB = 29 * MiB;
constexpr size_t WS_DP = WS_HB, WS_ZB = WS_HB + 16 * MiB;
constexpr size_t WS_POOLU = 61 * MiB, WS_S5U = 77 * MiB;
constexpr size_t WS_MERGED = WS_POOLU;
constexpr size_t WS_FFNINT = WS_POOLU, WS_FFNOUTT = WS_POOLU + 11 * MiB;
constexpr size_t WS_Q = 93 * MiB, WS_QI = 125 * MiB, WS_KVX = 141 * MiB, WS_GATES = 149 * MiB;
constexpr size_t WS_F = WS_Q;
constexpr size_t WS_HID = 157 * MiB;
constexpr size_t WS_END = 245 * MiB;
static_assert(WS_FFNOUTT + (size_t)D * FF * 2 <= WS_Q && WS_HID + (size_t)M * FF * 2 <= WS_END && WS_F + (size_t)M * D * 4 <= WS_HID, "d_ws map");
constexpr int CW_BAR = 4096;
constexpr int RING_OFF = 0, RING_BYTES = 131072;
constexpr int LDSCTL_OFF = RING_BYTES, MISC_OFF = LDSCTL_OFF + 320;
constexpr int LDS_BYTES = 147456;
constexpr int NPHASE = 1 + 8 * NLAYER;

#define GAS __attribute__((address_space(1)))
#define LAS __attribute__((address_space(3)))
typedef unsigned short bf16;
typedef unsigned v4u __attribute__((ext_vector_type(4)));
typedef float f32x4 __attribute__((ext_vector_type(4)));
typedef short bf16x8 __attribute__((ext_vector_type(8)));
typedef GAS unsigned gu32;
typedef GAS unsigned long long gu64;
#define RLX_AGENT __ATOMIC_RELAXED, __HIP_MEMORY_SCOPE_AGENT
#define LDS_WAIT() asm volatile("s_waitcnt lgkmcnt(0)" ::: "memory")
#define VM_WAIT() asm volatile("s_waitcnt vmcnt(0)" ::: "memory")
__device__ __forceinline__ unsigned long long rt() { return __builtin_amdgcn_s_memrealtime(); }
__device__ __forceinline__ unsigned f2bf(float f) { unsigned u = __builtin_bit_cast(unsigned, f); return (u + 0x7fffu + ((u >> 16) & 1u)) >> 16; }
__device__ __forceinline__ unsigned pk2(float lo, float hi) { return f2bf(lo) | (f2bf(hi) << 16); }
#define XB_TMO      128
#define XB_XCNT(j)  (256  + 64 * (j))
#define XB_XSUB(j)  (1280 + 64 * (j))
#define XB_XGEN(j)  (2304 + 64 * (j))
#define XB_TOP      3328
#define XB_TOPGEN   3392
#define XCD_BAR_WORDS 3456
#define XB_SPIN_CAP (1u << 18)

__device__ __forceinline__ unsigned xb_ld(unsigned* p)              { return __hip_atomic_load(p, __ATOMIC_RELAXED, __HIP_MEMORY_SCOPE_AGENT); }
__device__ __forceinline__ unsigned xb_add(unsigned* p, unsigned v) { return __hip_atomic_fetch_add(p, v, __ATOMIC_RELAXED, __HIP_MEMORY_SCOPE_AGENT); }
__device__ __forceinline__ unsigned xb_xcc_id() { return (unsigned)__builtin_amdgcn_s_getreg((3 << 11) | 20) & 0xFu; }
#define XB_SPIN(cond, bar) do { unsigned _sp = 0; while (cond) { __builtin_amdgcn_s_sleep(1); \
    if ((++_sp & 255u) == 0u) { if (xb_ld(&(bar)[XB_TMO])) break; if (_sp > XB_SPIN_CAP) { atomicAdd(&(bar)[XB_TMO], 1u); break; } } } } while (0)

struct XcdBarrier {
    unsigned* bar; unsigned x;
    volatile LAS unsigned* st;
};

__device__ __forceinline__ XcdBarrier xcd_barrier_post(unsigned* bar, volatile LAS unsigned* st) {
    XcdBarrier b; b.bar = bar; b.x = xb_xcc_id(); b.st = st;
    if (threadIdx.x == 0) (void)xb_add(&bar[XB_XCNT(b.x)], 1u);
    return b;
}
__device__ __forceinline__ void xcd_barrier_complete(unsigned* bar, unsigned x, unsigned& nloc, unsigned& nx) {
    const unsigned G = gridDim.x * gridDim.y * gridDim.z;
    unsigned sum, cnt, mine, sp = 0u;
    for (;;) {
        sum = 0u; cnt = 0u; mine = 0u;
#pragma unroll
        for (unsigned j = 0; j < 16; ++j) { const unsigned c = xb_ld(&bar[XB_XCNT(j)]); sum += c; cnt += (c > 0u) ? 1u : 0u; mine = (j == x) ? c : mine; }
        if (sum == G) break;
        __builtin_amdgcn_s_sleep(1);
        if ((++sp & 255u) == 0u) { if (xb_ld(&bar[XB_TMO])) break; if (sp > XB_SPIN_CAP) { atomicAdd(&bar[XB_TMO], 1u); break; } }
    }
    nloc = mine > 0u ? mine : 1u; nx = cnt > 0u ? cnt : 1u;
}

__device__ __forceinline__ void xcd_barrier(const XcdBarrier& b) {
    asm volatile("s_waitcnt vmcnt(0)" ::: "memory");
    __syncthreads();
    if (threadIdx.x == 0) {
        unsigned* bar = b.bar;
        __builtin_amdgcn_s_waitcnt(0);
        unsigned nloc = b.st[0], nx = b.st[1];
        if (nloc == 0u) { xcd_barrier_complete(bar, b.x, nloc, nx); b.st[0] = nloc; b.st[1] = nx; }
        const unsigned old = xb_add(&bar[XB_XSUB(b.x)], 1u);
        const unsigned gen = old / nloc;
        if (old + 1u == (gen + 1u) * nloc) {
            __builtin_amdgcn_fence(__ATOMIC_RELEASE, "agent");
            asm volatile("s_waitcnt vmcnt(0)" ::: "memory");
            const unsigned og = xb_add(&bar[XB_TOP], 1u);
            const unsigned tg = og / nx;
            if (og + 1u == (tg + 1u) * nx) xb_add(&bar[XB_TOPGEN], 1u);
            else XB_SPIN(xb_ld(&bar[XB_TOPGEN]) == tg, bar);
            __builtin_amdgcn_fence(__ATOMIC_ACQUIRE, "agent");
            xb_add(&bar[XB_XGEN(b.x)], 1u);
            asm volatile("s_waitcnt vmcnt(0)" ::: "memory");
        } else {
            XB_SPIN(xb_ld(&bar[XB_XGEN(b.x)]) == gen, bar);
            __builtin_amdgcn_fence(__ATOMIC_ACQUIRE, "agent");
            asm volatile("s_waitcnt vmcnt(0)" ::: "memory");
        }
    }
    __syncthreads();
}

typedef short s16x4 __attribute__((ext_vector_type(4)));
typedef short v4i16_t __attribute__((ext_vector_type(4)));
typedef unsigned short u16x4 __attribute__((ext_vector_type(4)));
typedef unsigned v2u __attribute__((ext_vector_type(2)));
typedef float f32x2v __attribute__((ext_vector_type(2)));
#define DI __device__ __forceinline__
struct Frame {
    LAS unsigned char* lds;
    int tid, lane, wave, G;
};
DI float wave_sum(float v) {
#pragma unroll
    for (int o = 1; o < 64; o <<= 1) v += __shfl_xor(v, o);
    return v;
}
DI bf16x8 ldg16(const bf16* p) { return *(const GAS bf16x8*)p; }
DI bf16x8 ldg16o(const bf16* ub, unsigned off) { return *(const GAS bf16x8*)((const GAS unsigned char*)ub + off); }
DI v4u ldg16u(const bf16* ub, unsigned off) { return *(const GAS v4u*)((const GAS unsigned char*)ub + off); }
DI float bf2f(bf16 b) { return __uint_as_float(((unsigned)b) << 16); }
DI float bflo(unsigned w) { return __uint_as_float(w << 16); }
DI float bfhi(unsigned w) { return __uint_as_float(w & 0xffff0000u); }
#define MFMA16(a, b, c) __builtin_amdgcn_mfma_f32_16x16x32_bf16((a), (b), (c), 0, 0, 0)

struct MapId { DI int operator()(int n) const { return n; } };
struct MapWin { DI int operator()(int n) const {
    if (n < 512) return n;
    if (n < 1536) return n + 512;
    if (n < 1600) return n - 1536 + 2560;
    if (n < 1664) return n - 1600 + 2624;
    if (n < 2176) return n - 1664 + 2048;
    if (n < 2240) return n - 2176 + 2688;
    if (n < 2248) return n - 2240 + 2752;
    if (n < 2760) return n - 2248 + 512;
    return n - 2760 + 2816; } };
struct MapIl { int half; DI int operator()(int n) const { const int hi = n >= half ? 1 : 0, m = n - hi * half; return (m >> 7) * 256 + hi * 128 + (m & 127); } };
template <class Map> DI void transpose_item(const float* W, int K, int Ns, bf16* WT, LAS float* scr, int item, int lane, const Map& map) {
    const int nblk = (Ns + 31) / 32, kb = item / nblk, nb = item % nblk, k0 = 64 * kb, n0 = 32 * nb;
    const int nc = n0 + 4 * (lane & 7);
    f32x4 v[8];
#pragma unroll
    for (int i = 0; i < 8; ++i) { const int kk = (lane >> 3) + 8 * i; v[i] = nc < Ns ? *(const GAS f32x4*)(W + (size_t)(k0 + kk) * Ns + nc) : (f32x4){0.f, 0.f, 0.f, 0.f}; }
#pragma unroll
    for (int i = 0; i < 8; ++i) { const int kk = (lane >> 3) + 8 * i; LAS float* d = scr + kk * 33 + 4 * (lane & 7); d[0] = v[i].x; d[1] = v[i].y; d[2] = v[i].z; d[3] = v[i].w; }
    LDS_WAIT(); asm volatile("" ::: "memory");
    const int c = lane & 7;
#pragma unroll
    for (int j = 0; j < 4; ++j) { const int nn = (lane >> 3) + 8 * j; const LAS float* s = scr + (8 * c) * 33 + nn;
        if (n0 + nn < Ns) { const int dr = map(n0 + nn);
            v4u o; o.x = pk2(s[0 * 33], s[1 * 33]); o.y = pk2(s[2 * 33], s[3 * 33]); o.z = pk2(s[4 * 33], s[5 * 33]); o.w = pk2(s[6 * 33], s[7 * 33]);
            *(GAS v4u*)(WT + (size_t)dr * K + k0 + 8 * c) = o; } }
    LDS_WAIT(); asm volatile("" ::: "memory");
}
struct In {
    const float *x, *n_mix_pre, *n_mix_post, *n_ffn_pre, *n_ffn_post, *w_in, *pool_mix_w, *pool_scale, *pool_out_w, *attn_out_w, *rel_bias, *lam_re, *lam_im, *log_dt,
                *b_re, *b_im, *c_re, *c_im, *s5_d, *glu_w, *w_out, *ffn_w_in, *ffn_w_out;
};
struct Args { In in; float* out; unsigned char* ws; int ph_lo, ph_hi; };
typedef const __attribute__((address_space(4))) Args* KArgs;
DI KArgs kargs() { KArgs p = (KArgs)__builtin_amdgcn_kernarg_segment_ptr(); asm volatile("" : "+s"(p)); return p; }
template <class T> DI T* opq(T* p) { asm volatile("" : "+s"(p)); return p; }
DI int opqv(int v) { asm volatile("" : "+v"(v)); return v; }

DI void convert_A(Frame& F, KArgs A, unsigned char* ws, int l) {
    LAS float* scr = (LAS float*)(F.lds + RING_OFF + F.wave * 16384);
    const int gw = blockIdx.x * NWAVES + F.wave, NGW = F.G * NWAVES;
    const int gt = blockIdx.x * (NWAVES * 64) + F.tid, NGT = F.G * NWAVES * 64;
    bf16* WINT = (bf16*)(ws + WS_WINT); bf16* ATTNOT = (bf16*)(ws + WS_ATTNOT); bf16* POOLET = (bf16*)(ws + WS_POOLET); bf16* GLUT = (bf16*)(ws + WS_GLUT); bf16* WOUTT = (bf16*)(ws + WS_WOUTT);
    constexpr int I_WIN = (D / 64) * ((INW + 31) / 32), I_SQ = (D / 64) * (D / 32), I_GLU = (512 / 64) * (2048 / 32);
    constexpr int NITEMS = I_WIN + 2 * I_SQ + I_GLU;
    for (int it = gw; it < NITEMS; it += NGW) {
        int r = it;
        if (r < I_WIN) { transpose_item(A->in.w_in + (size_t)l * D * INW, D, INW, WINT, scr, r, F.lane, MapWin{}); continue; } r -= I_WIN;
        if (r < I_SQ) { transpose_item(A->in.attn_out_w + (size_t)l * D * D, D, D, ATTNOT, scr, r, F.lane, MapId{}); continue; } r -= I_SQ;
        if (r < I_SQ) { transpose_item(A->in.w_out + (size_t)l * D * D, D, D, WOUTT, scr, r, F.lane, MapId{}); continue; } r -= I_SQ;
        transpose_item(A->in.glu_w + (size_t)l * 512 * 2048, 512, 2048, GLUT, scr, r, F.lane, MapIl{1024});
    }
    for (int i = gt; i < 56 * D / 8; i += NGT) *(GAS v4u*)(WINT + (size_t)2760 * D + (size_t)i * 8) = (v4u){0u, 0u, 0u, 0u};
    {   const float* mw = A->in.pool_mix_w + (size_t)l * 4 * 128 * 128; const float* sc = A->in.pool_scale + (size_t)l * 512; const float* pw = A->in.pool_out_w + (size_t)l * 512 * D;
        for (int idx = gt; idx < 512 * (D / 4); idx += NGT) { const int n4 = idx & (D / 4 - 1), gc = idx >> 8, g = gc >> 7;
            const float* mrow = mw + (size_t)gc * 128; const float* scg = sc + g * 128; const GAS f32x4* pcol = (const GAS f32x4*)(pw + (size_t)(g * 128) * D) + n4;
            f32x4 s = (f32x4){0.f, 0.f, 0.f, 0.f};
            _Pragma("unroll 16") for (int d = 0; d < 128; ++d) s += (mrow[d] * scg[d]) * pcol[(size_t)d * (D / 4)];
            POOLET[(size_t)(4 * n4 + 0) * 512 + gc] = (bf16)f2bf(s.x); POOLET[(size_t)(4 * n4 + 1) * 512 + gc] = (bf16)f2bf(s.y);
            POOLET[(size_t)(4 * n4 + 2) * 512 + gc] = (bf16)f2bf(s.z); POOLET[(size_t)(4 * n4 + 3) * 512 + gc] = (bf16)f2bf(s.w); } }
    if (blockIdx.x == 0) { float* BT = (float*)(ws + WS_BIAS);
        for (int i = F.tid; i < 128 * 16; i += NWAVES * 64) { const int d = i >> 4, h = i & 15;
            int bk = d; if (d >= 16) { bk = 16 + (int)(logf((float)d / 16.0f) / logf(8.0f) * 16.0f); bk = bk > 31 ? 31 : bk; }
            BT[i] = A->in.rel_bias[bk * 16 + h]; } }
    {   bf16* S5T = (bf16*)(ws + WS_S5T); bf16* S5P = (bf16*)(ws + WS_S5P); bf16* S5Q = (bf16*)(ws + WS_S5Q); float* S5A = (float*)(ws + WS_S5A);
        LAS float* apr = (LAS float*)(F.lds + RING_OFF);
        LAS float* api = apr + 17 * 64;
        LAS float* bbr = api + 17 * 64;
        LAS float* bbi = bbr + 64 * 16;
        LAS float* Kt = bbi + 64 * 16;
        LAS float* cre = Kt + 4096;
        LAS float* cim = cre + 1024;
        __syncthreads();
        for (int task = blockIdx.x; task < 256; task += F.G) { const int g = task & 31, sub = task >> 5; const int lg = l * 32 + g;
            for (int e = F.tid; e < 1024; e += NWAVES * 64) { cre[e] = A->in.c_re[(size_t)lg * 1024 + e]; cim[e] = A->in.c_im[(size_t)lg * 1024 + e]; }
            if (F.tid < 64) { const int n = F.tid;
                const float lr = A->in.lam_re[lg * 64 + n], li = A->in.lam_im[lg * 64 + n], dt = expf(A->in.log_dt[lg]);
                const float mag = expf(lr * dt), ar = mag * cosf(li * dt), ai = mag * sinf(li * dt), den = lr * lr + li * li;
                const float cr = ((ar - 1.0f) * lr + ai * li) / den, ci = (ai * lr - (ar - 1.0f) * li) / den;
                float pr = 1.f, pi = 0.f;
                for (int t = 0; t <= 16; ++t) { apr[t * 64 + n] = pr; api[t * 64 + n] = pi; const float nr = pr * ar - pi * ai, ni = pr * ai + pi * ar; pr = nr; pi = ni; }
                for (int c = 0; c < 16; ++c) { const float br = A->in.b_re[((size_t)lg * 64 + n) * 16 + c], bi = A->in.b_im[((size_t)lg * 64 + n) * 16 + c];
                    bbr[n * 16 + c] = cr * br - ci * bi; bbi[n * 16 + c] = cr * bi + ci * br; }
                if (sub == 0) { S5A[(g * 64 + n) * 2] = apr[16 * 64 + n]; S5A[(g * 64 + n) * 2 + 1] = api[16 * 64 + n]; }
            }
            __syncthreads();
            {
                const int t = F.tid >> 5, i = (F.tid >> 1) & 15, c0 = (F.tid & 1) * 8; float acc[8];
#pragma unroll
                for (int q = 0; q < 8; ++q) acc[q] = 0.f;
                for (int n = 0; n < 64; ++n) { const float Cr = cre[i * 64 + n], Ci = cim[i * 64 + n], pr = apr[t * 64 + n], pi = api[t * 64 + n];
                    const float er = Cr * pr - Ci * pi, ei = Cr * pi + Ci * pr;
                    const f32x4 b0 = *(const LAS f32x4*)(bbr + n * 16 + c0), b1 = *(const LAS f32x4*)(bbr + n * 16 + c0 + 4), d0 = *(const LAS f32x4*)(bbi + n * 16 + c0), d1 = *(const LAS f32x4*)(bbi + n * 16 + c0 + 4);
#pragma unroll
                    for (int q = 0; q < 4; ++q) { acc[q] += er * b0[q] - ei * d0[q]; acc[4 + q] += er * b1[q] - ei * d1[q]; } }
#pragma unroll
                for (int q = 0; q < 8; ++q) Kt[(t * 16 + i) * 16 + c0 + q] = acc[q]; }
            __syncthreads();
            for (int e = F.tid; e < 32 * 256; e += NWAVES * 64) { const int r = sub * 32 + (e >> 8), k = e & 255, j = r >> 4, i = r & 15, s = k >> 4, c = k & 15;
                float v = (j >= s) ? Kt[((j - s) * 16 + i) * 16 + c] : 0.f; if (j == s && i == c) v += A->in.s5_d[l * 512 + g * 16 + i];
                S5T[((size_t)g * 256 + r) * 256 + k] = (bf16)f2bf(v); }
            for (int e = F.tid; e < 16 * 256; e += NWAVES * 64) { const int row = sub * 16 + (e >> 8), k = e & 255, n = row & 63, im = row >> 6, s = k >> 4, c = k & 15;
                const float pr = apr[(15 - s) * 64 + n], pi = api[(15 - s) * 64 + n], br = bbr[n * 16 + c], bi = bbi[n * 16 + c];
                const float v = im ? (pr * bi + pi * br) : (pr * br - pi * bi);
                S5P[((size_t)g * 128 + row) * 256 + k] = (bf16)f2bf(v); }
            for (int e = F.tid; e < 32 * 128; e += NWAVES * 64) { const int r = sub * 32 + (e >> 7), k = e & 127, j = r >> 4, i = r & 15, n = k & 63, im = k >> 6;
                const float Cr = cre[i * 64 + n], Ci = cim[i * 64 + n], pr = apr[(j + 1) * 64 + n], pi = api[(j + 1) * 64 + n];
                const float v = im ? -(Cr * pi + Ci * pr) : (Cr * pr - Ci * pi);
                S5Q[((size_t)g * 256 + r) * 128 + k] = (bf16)f2bf(v); }
            __syncthreads();
        }
    }
}
DI void convert_B(Frame& F, KArgs A, unsigned char* ws, int l) {
    LAS float* scr = (LAS float*)(F.lds + RING_OFF + F.wave * 16384);
    const int gw = blockIdx.x * NWAVES + F.wave, NGW = F.G * NWAVES;
    bf16* FFNINT = (bf16*)(ws + WS_FFNINT); bf16* FFNOUTT = (bf16*)(ws + WS_FFNOUTT);
    constexpr int I_IN = (D / 64) * (2 * FF / 32), I_OUT = (FF / 64) * (D / 32);
    for (int it = gw; it < I_IN + I_OUT; it += NGW) {
        if (it < I_IN) transpose_item(A->in.ffn_w_in + (size_t)l * D * 2 * FF, D, 2 * FF, FFNINT, scr, it, F.lane, MapIl{FF});
        else transpose_item(A->in.ffn_w_out + (size_t)l * FF * D, FF, D, FFNOUTT, scr, it - I_IN, F.lane, MapId{});
    }
}
DI void rms_rows_to_bf16(Frame& F, const float* x, const float* g, bf16* hb) {
    const int gw = blockIdx.x * NWAVES + F.wave, NGW = F.G * NWAVES;
    f32x4 gv[4];
#pragma unroll
    for (int j = 0; j < 4; ++j) gv[j] = ((const GAS f32x4*)g)[F.lane + 64 * j];
    for (int m = gw; m < M; m += NGW) {
        const GAS f32x4* xr = (const GAS f32x4*)(x + (size_t)m * D) + F.lane; f32x4 v[4]; float s = 0.f;
#pragma unroll
        for (int j = 0; j < 4; ++j) { v[j] = xr[64 * j]; s += (v[j].x * v[j].x + v[j].y * v[j].y) + (v[j].z * v[j].z + v[j].w * v[j].w); }
        const float rstd = 1.0f / sqrtf(wave_sum(s) * (1.f / D) + NORM_EPS);
        GAS v2u* o8 = (GAS v2u*)(hb + (size_t)m * D) + F.lane;
#pragma unroll
        for (int j = 0; j < 4; ++j) { v2u o; o.x = pk2(v[j].x * rstd * gv[j].x, v[j].y * rstd * gv[j].y); o.y = pk2(v[j].z * rstd * gv[j].z, v[j].w * rstd * gv[j].w); o8[64 * j] = o; }
    }
}
DI void norm_phase(Frame& F, const float* xin, float* xout, const float* f, const float* gpost, const float* gpre, bf16* hb) {
    const int gw = blockIdx.x * NWAVES + F.wave, NGW = F.G * NWAVES;
    for (int m = gw; m < M; m += NGW) {
        const GAS f32x4* fr = (const GAS f32x4*)(f + (size_t)m * D) + F.lane; const GAS f32x4* xr = (const GAS f32x4*)(xin + (size_t)m * D) + F.lane;
        f32x4 v[4], xv[4]; float s = 0.f;
#pragma unroll
        for (int j = 0; j < 4; ++j) { v[j] = fr[64 * j]; xv[j] = xr[64 * j]; s += (v[j].x * v[j].x + v[j].y * v[j].y) + (v[j].z * v[j].z + v[j].w * v[j].w); }
        const float rstd = 1.0f / sqrtf(wave_sum(s) * (1.f / D) + NORM_EPS); float s2 = 0.f;
        GAS f32x4* xo = (GAS f32x4*)(xout + (size_t)m * D) + F.lane;
#pragma unroll
        for (int j = 0; j < 4; ++j) { const f32x4 gp = ((const GAS f32x4*)gpost)[F.lane + 64 * j]; xv[j] = xv[j] + v[j] * rstd * gp; xo[64 * j] = xv[j];
            s2 += (xv[j].x * xv[j].x + xv[j].y * xv[j].y) + (xv[j].z * xv[j].z + xv[j].w * xv[j].w); }
        if (gpre) { const float rstd2 = 1.0f / sqrtf(wave_sum(s2) * (1.f / D) + NORM_EPS);
            GAS v2u* o8 = (GAS v2u*)(hb + (size_t)m * D) + F.lane;
#pragma unroll
            for (int j = 0; j < 4; ++j) { const f32x4 gq = ((const GAS f32x4*)gpre)[F.lane + 64 * j]; v2u o; o.x = pk2(xv[j].x * rstd2 * gq.x, xv[j].y * rstd2 * gq.y); o.y = pk2(xv[j].z * rstd2 * gq.z, xv[j].w * rstd2 * gq.w); o8[64 * j] = o; } }
    }
}

DI void pool_stencil(Frame& F, const bf16* POOLU, bf16* DP) {
    const int gt = blockIdx.x * (NWAVES * 64) + F.tid, NGT = F.G * NWAVES * 64;
    for (int idx = gt; idx < M * 64; idx += NGT) {
        const int t = idx >> 6, cc = idx & 63, ch0 = cc * 8, gi = cc >> 4, w = 2 << gi, pos = t & (SEQ - 1);
        const int nw = (pos + 1) < w ? (pos + 1) : w;
        float a[8], u0[8];
#pragma unroll
        for (int j = 0; j < 8; ++j) { a[j] = 0.f; u0[j] = 0.f; }
        for (int i = 0; i < nw; ++i) { const v4u v = *(const GAS v4u*)(POOLU + (size_t)(t - i) * 512 + ch0);
            const float e[8] = {bflo(v.x), bfhi(v.x), bflo(v.y), bfhi(v.y), bflo(v.z), bfhi(v.z), bflo(v.w), bfhi(v.w)};
#pragma unroll
            for (int j = 0; j < 8; ++j) { a[j] += e[j]; if (i == 0) u0[j] = e[j]; } }
        const float inv = 1.0f / (float)nw; v4u o;
        o.x = pk2(a[0] * inv - u0[0], a[1] * inv - u0[1]); o.y = pk2(a[2] * inv - u0[2], a[3] * inv - u0[3]);
        o.z = pk2(a[4] * inv - u0[4], a[5] * inv - u0[5]); o.w = pk2(a[6] * inv - u0[6], a[7] * inv - u0[7]);
        *(GAS v4u*)(DP + (size_t)t * 512 + ch0) = o;
    }
}
DI float gelu_tanh(float y) { const float u = 0.7978845608028654f * (y + 0.044715f * y * y * y); const float th = 1.0f - 2.0f * __builtin_amdgcn_rcpf(__expf(2.0f * u) + 1.0f); return 0.5f * y * (1.0f + th); }
constexpr int S5_SLD = 129, S5_XLD = 136, S5_XOFF = 69632;
DI void s5_unit(Frame& F, int b, int g, const bf16* S5U_, const bf16* S5T_, const bf16* S5P_, const bf16* S5Q_, const float* S5A_, bf16* ZB_) {
    const bf16* S5U = opq(S5U_); const bf16* S5T = opq(S5T_); const bf16* S5P = opq(S5P_); const bf16* S5Q = opq(S5Q_); const float* S5A = opq(S5A_); bf16* ZB = opq(ZB_);
    LAS float* Ssm = (LAS float*)(F.lds + RING_OFF);
    LAS bf16* XB = (LAS bf16*)(F.lds + RING_OFF + S5_XOFF);
    const int w = F.wave, lane = opqv(F.lane), fr = lane & 15, qd = lane >> 4;
    const bf16* Tg = S5T + (size_t)g * 65536; const bf16* Pg = S5P + (size_t)g * 32768; const bf16* Qg = S5Q + (size_t)g * 32768;
    const bf16* Ub = S5U + (size_t)b * SEQ * 512 + g * 16;
    f32x4 accY[2][8], accS[8];
#pragma unroll
    for (int ct = 0; ct < 8; ++ct) { accS[ct] = (f32x4){0.f, 0.f, 0.f, 0.f}; accY[0][ct] = accS[ct]; accY[1][ct] = accS[ct]; }
    {   const unsigned aoff = (unsigned)(fr * 256 + 8 * qd) * 2u;
        bf16x8 bfr[8], aP, aT0, aT1, nb[8], nP, nT0, nT1;
#define S5_LOADK(ks_, B_, P_, T0_, T1_) do { const int s_ = 2 * (ks_) + (qd >> 1), c0_ = 8 * (qd & 1); \
        _Pragma("unroll") for (int ct = 0; ct < 8; ++ct) B_[ct] = ldg16o(Ub + (size_t)ct * 16 * 16 * 512, (unsigned)((fr * 16 + s_) * 512 + c0_) * 2u); \
        P_ = ldg16o(Pg + (size_t)(16 * w) * 256 + 32 * (ks_), aoff); \
        T0_ = ldg16o(Tg + (size_t)(32 * w) * 256 + 32 * (ks_), aoff); T1_ = ldg16o(Tg + (size_t)(32 * w + 16) * 256 + 32 * (ks_), aoff); } while (0)
        S5_LOADK(0, bfr, aP, aT0, aT1);
#pragma unroll 1
        for (int ks = 0; ks < 8; ++ks) {
            if (ks < 7) S5_LOADK(ks + 1, nb, nP, nT0, nT1);
#pragma unroll
            for (int ct = 0; ct < 8; ++ct) accS[ct] = MFMA16(aP, bfr[ct], accS[ct]);
            if (ks <= w) {
#pragma unroll
                for (int ct = 0; ct < 8; ++ct) { accY[0][ct] = MFMA16(aT0, bfr[ct], accY[0][ct]); accY[1][ct] = MFMA16(aT1, bfr[ct], accY[1][ct]); }
            }
#pragma unroll
            for (int ct = 0; ct < 8; ++ct) bfr[ct] = nb[ct];
            aP = nP; aT0 = nT0; aT1 = nT1;
        }
#undef S5_LOADK
    }
#pragma unroll
    for (int ct = 0; ct < 8; ++ct)
#pragma unroll
        for (int r = 0; r < 4; ++r) Ssm[(16 * w + 4 * qd + r) * S5_SLD + 16 * ct + fr] = accS[ct][r];
    __syncthreads();
    if (F.tid < 64) { const int n = F.tid; const float ar = S5A[(g * 64 + n) * 2], ai = S5A[(g * 64 + n) * 2 + 1]; float xr = 0.f, xi = 0.f;
#pragma unroll 1
        for (int c0 = 0; c0 < 128; c0 += 16) { float sr[16], si[16];
#pragma unroll
            for (int j = 0; j < 16; ++j) { sr[j] = Ssm[n * S5_SLD + c0 + j]; si[j] = Ssm[(64 + n) * S5_SLD + c0 + j]; }
#pragma unroll
            for (int j = 0; j < 16; ++j) { XB[(c0 + j) * S5_XLD + n] = (bf16)f2bf(xr); XB[(c0 + j) * S5_XLD + 64 + n] = (bf16)f2bf(xi);
                const float nr = ar * xr - ai * xi + sr[j], ni = ar * xi + ai * xr + si[j]; xr = nr; xi = ni; } } }
    __syncthreads();
    {   bf16x8 aQ[4][2];
#pragma unroll
        for (int ks = 0; ks < 4; ++ks) { aQ[ks][0] = ldg16o(Qg + (size_t)(32 * w) * 128 + 32 * ks, (unsigned)(fr * 128 + 8 * qd) * 2u); aQ[ks][1] = ldg16o(Qg + (size_t)(32 * w + 16) * 128 + 32 * ks, (unsigned)(fr * 128 + 8 * qd) * 2u); }
#pragma unroll
        for (int ks = 0; ks < 4; ++ks) {
#pragma unroll
            for (int ct = 0; ct < 8; ++ct) { const bf16x8 bx = *(const LAS bf16x8*)(XB + (16 * ct + fr) * S5_XLD + 32 * ks + 8 * qd);
                accY[0][ct] = MFMA16(aQ[ks][0], bx, accY[0][ct]); accY[1][ct] = MFMA16(aQ[ks][1], bx, accY[1][ct]); }
        }
    }
#pragma unroll
    for (int rt = 0; rt < 2; ++rt)
#pragma unroll
        for (int ct = 0; ct < 8; ++ct) { const int tok = (16 * ct + fr) * 16 + 2 * w + rt; const f32x4 y = accY[rt][ct];
            v2u o; o.x = pk2(gelu_tanh(y[0]), gelu_tanh(y[1])); o.y = pk2(gelu_tanh(y[2]), gelu_tanh(y[3]));
            *(GAS v2u*)(ZB + (size_t)(b * SEQ + tok) * 512 + g * 16 + 4 * qd) = o; }
    __syncthreads();
}
constexpr int AT_BIAS_OFF = 0, AT_SEL_OFF = 8192, AT_V_OFF = 24576, AT_VLD = 144  ;
DI s16x4 vtr(const LAS unsigned char* p) { return __builtin_bit_cast(s16x4, __builtin_amdgcn_ds_read_tr16_b64_v4i16((LAS v4i16_t*)p)); }
#define MEMBAR() asm volatile("" ::: "memory")
DI int row16_sum(int x) {
    x += __builtin_amdgcn_update_dpp(0, x, 0xB1, 0xF, 0xF, true);
    x += __builtin_amdgcn_update_dpp(0, x, 0x4E, 0xF, 0xF, true);
    x += __builtin_amdgcn_update_dpp(0, x, 0x141, 0xF, 0xF, true);
    x += __builtin_amdgcn_update_dpp(0, x, 0x140, 0xF, 0xF, true);
    return x; }
DI int xor16_i(int x) { return __builtin_amdgcn_ds_swizzle(x, 0x401F); }
DI float xor16_f(float x) { return __int_as_float(__builtin_amdgcn_ds_swizzle(__float_as_int(x), 0x401F)); }
DI int half32_sum(int x) { x = row16_sum(x); return x + xor16_i(x); }
DI void attn_unit(Frame& F, int b, int tile, const bf16* QI_, const bf16* KVX_, bf16* QA_, const float* BIAS_) {
    const bf16* QI = opq(QI_); const bf16* KVX = opq(KVX_); bf16* QA = opq(QA_); const float* BIAS = opq(BIAS_);
    LAS float* biasL = (LAS float*)(F.lds + RING_OFF + AT_BIAS_OFF);
    const int w = F.wave;
    LAS unsigned short* selw = (LAS unsigned short*)(F.lds + RING_OFF + AT_SEL_OFF) + w * 512;
    LAS unsigned char* kbuf = F.lds + RING_OFF + AT_V_OFF;
    for (int i = F.tid; i < 2048; i += NWAVES * 64) biasL[i] = BIAS[i];
    { LAS v4u* z = (LAS v4u*)selw; z[F.lane] = (v4u){0u, 0u, 0u, 0u}; }
    const size_t rowb = (size_t)b * SEQ;
    const int tb = tile * 16 + 2 * w;
    const int ntile = (tile * 16 + 15) / 256 + 1;
    const int nkp = 8 * ntile;
    unsigned key[64];
    int nsel = 0; unsigned theta = 0u;
#ifndef AT_PROBE
#define AT_PROBE 0
#endif
    _Pragma("unroll 1") for (int rep_abc = 0; rep_abc < (AT_PROBE == 1 ? 2 : 1); ++rep_abc) {
    {
        const int lane = opqv(F.lane), fr = lane & 15, qd = lane >> 4, tq = tb + (qd >> 1), odd = qd & 1;
        const int tid = opqv(F.tid);
        bf16x8 aQ[2];
#pragma unroll
        for (int ks = 0; ks < 2; ++ks) aQ[ks] = ldg16(QI + (rowb + tb + (fr >> 3)) * 512 + (fr & 7) * 64 + 32 * ks + 8 * qd);
        const v2u wraw = *(const GAS v2u*)(KVX + (rowb + tq) * 256 + 192 + 4 * odd);
        const float wv[4] = {bflo(wraw.x), bfhi(wraw.x), bflo(wraw.y), bfhi(wraw.y)};
        const unsigned goff = (unsigned)((tid >> 3) * 256 + (tid & 7) * 8) * 2u, loff = (unsigned)((tid >> 3) * 144 + (tid & 7) * 16);
        v4u stg[4];
        const bf16* gki = KVX + rowb * 256 + 128;
#pragma unroll
        for (int i = 0; i < 4; ++i) stg[i] = ldg16u(gki + (size_t)(64 * i) * 256, goff);
#pragma unroll
        for (int i = 0; i < 4; ++i) *(LAS v4u*)(kbuf + 64 * i * 144 + loff) = stg[i];
        __syncthreads();
        const unsigned roff = (unsigned)(fr * 144 + qd * 16);
#pragma unroll 1
        for (int kt = 0; kt < ntile; ++kt) {
            const bool more = kt + 1 < ntile;
            if (more) {
#pragma unroll
                for (int i = 0; i < 4; ++i) stg[i] = ldg16u(gki + (size_t)(256 * (kt + 1) + 64 * i) * 256, goff); }
            const LAS unsigned char* kb = kbuf + (kt & 1) * (256 * 144) + roff;
            unsigned tmp[8];
#pragma unroll
            for (int j = 0; j < 8; ++j) {
                const bf16x8 e0 = *(const LAS bf16x8*)(kb + (32 * j) * 144), e1 = *(const LAS bf16x8*)(kb + (32 * j) * 144 + 64);
                const bf16x8 o0 = *(const LAS bf16x8*)(kb + (32 * j + 16) * 144), o1 = *(const LAS bf16x8*)(kb + (32 * j + 16) * 144 + 64);
                f32x4 cE = (f32x4){0.f, 0.f, 0.f, 0.f}, cO = cE;
                cE = MFMA16(aQ[0], e0, cE); cE = MFMA16(aQ[1], e1, cE); cO = MFMA16(aQ[0], o0, cO); cO = MFMA16(aQ[1], o1, cO);
                float sE = 0.f, sO = 0.f;
#pragma unroll
                for (int r = 0; r < 4; ++r) { sE += wv[r] * fmaxf(cE[r], 0.f); sO += wv[r] * fmaxf(cO[r], 0.f); }
                sE += xor16_f(sE); sO += xor16_f(sO);
                float s = odd ? sO : sE; s += 0.0f;
                const unsigned bits = __float_as_uint(s); const unsigned sk = bits ^ ((unsigned)((int)bits >> 31) | 0x80000000u);
                tmp[j] = (256 * kt + 32 * j + 16 * odd + fr <= tq) ? sk : 0u;
            }
#define KEYCASE(c) case c: _Pragma("unroll") for (int j = 0; j < 8; ++j) key[8 * c + j] = tmp[j]; break;
            switch (kt) { KEYCASE(0) KEYCASE(1) KEYCASE(2) KEYCASE(3) KEYCASE(4) KEYCASE(5) KEYCASE(6) default: _Pragma("unroll") for (int j = 0; j < 8; ++j) key[56 + j] = tmp[j]; break; }
#undef KEYCASE
            if (more) {
#pragma unroll
                for (int i = 0; i < 4; ++i) *(LAS v4u*)(kbuf + ((kt + 1) & 1) * (256 * 144) + 64 * i * 144 + loff) = stg[i]; }
            __syncthreads();
        }
    }
    theta = 0u; bool fin = false;
#pragma unroll 1
    for (int bit = 31; bit >= 0; --bit) {
        const unsigned cand = theta | (1u << bit); int cnt = 0;
#pragma unroll
        for (int ch = 0; ch < 8; ++ch) if (ch * 8 < nkp) {
#pragma unroll
            for (int j = 0; j < 8; ++j) cnt += (key[ch * 8 + j] >= cand) ? 1 : 0; }
        cnt = half32_sum(cnt);
        if (!fin && cnt >= 256) theta = cand;
        fin = fin || (cnt == 256);
        if (__all(fin)) break;
    }
    {
        const int lane = opqv(F.lane), fr = lane & 15, qd = lane >> 4, odd = qd & 1;
        int cgt = 0;
#pragma unroll
        for (int ch = 0; ch < 8; ++ch) if (ch * 8 < nkp) {
#pragma unroll
            for (int j = 0; j < 8; ++j) cgt += (key[ch * 8 + j] > theta) ? 1 : 0; }
        cgt = half32_sum(cgt);
        const int quota = (theta == 0u) ? 0 : (256 - cgt);
        int base = 0, eqseen = 0; const unsigned below = (1u << (lane & 31)) - 1u; const int sh = 32 * (qd >> 1);
        LAS unsigned short* sl = selw + (qd >> 1) * 256;
#pragma unroll 1
        for (int ch = 0; ch * 8 < nkp; ++ch) {
            unsigned tmp[8];
#define KEYCASE(c) case c: _Pragma("unroll") for (int j = 0; j < 8; ++j) tmp[j] = key[8 * c + j]; break;
            switch (ch) { KEYCASE(0) KEYCASE(1) KEYCASE(2) KEYCASE(3) KEYCASE(4) KEYCASE(5) KEYCASE(6) default: _Pragma("unroll") for (int j = 0; j < 8; ++j) tmp[j] = key[56 + j]; break; }
#undef KEYCASE
#pragma unroll
            for (int j = 0; j < 8; ++j) {
                const bool gtk = tmp[j] > theta, eqk = (tmp[j] == theta) && (theta != 0u);
                const unsigned long long be = __ballot(eqk); const unsigned e32 = (unsigned)(be >> sh); const int pe = __popc(e32 & below);
                const bool take = gtk || (eqk && (eqseen + pe) < quota);
                const unsigned long long bt = __ballot(take); const unsigned t32 = (unsigned)(bt >> sh); const int pt = __popc(t32 & below);
                if (take) sl[base + pt] = (unsigned short)(256 * ch + 32 * j + 16 * odd + fr);
                base += __popc(t32); eqseen += __popc(e32);
            }
        }
        nsel = base;
    }
    }
#pragma unroll 1
    for (int qq2 = 0; qq2 < (AT_PROBE == 2 ? 4 : 2); ++qq2) { const int qq = qq2 & 1;
        const int lane = opqv(F.lane), fr = lane & 15, qd = lane >> 4;
        LAS unsigned char* Vs = F.lds + RING_OFF + AT_V_OFF + w * (64 * AT_VLD);
        const int t = tb + qq; const int ns = __shfl(nsel, 32 * qq);
        const LAS unsigned short* sl = selw + qq * 256;
        bf16* qrow = QA + (rowb + t) * 1024; bf16* orow = (qq2 < 2) ? qrow : (bf16*)((unsigned char*)QA + (WS_END - WS_Q)) + (size_t)(t & 2047) * 1024;
        bf16x8 bq[2];
#pragma unroll
        for (int ks = 0; ks < 2; ++ks) bq[ks] = ldg16(qrow + fr * 64 + 32 * ks + 8 * qd);
        f32x4 st[16];
#pragma unroll
        for (int blk = 0; blk < 16; ++blk) { const int kidx = sl[16 * blk + fr];
            const unsigned ko = (unsigned)(kidx * 256 + 8 * qd) * 2u; const bf16x8 a0 = ldg16o(KVX + rowb * 256, ko), a1 = ldg16o(KVX + rowb * 256 + 32, ko);
            f32x4 c = (f32x4){0.f, 0.f, 0.f, 0.f}; c = MFMA16(a0, bq[0], c); c = MFMA16(a1, bq[1], c); st[blk] = c;
            if ((blk & 7) == 7) MEMBAR(); }
        v4u vv[8];
#pragma unroll
        for (int i = 0; i < 8; ++i) { const int piece = lane + 64 * i, row = piece >> 3, pc = piece & 7; const int kidx = sl[row];
            vv[i] = ldg16u(KVX + rowb * 256 + 64, (unsigned)(kidx * 256 + 8 * pc) * 2u); }
        float mx = -3.0e38f;
#pragma unroll
        for (int blk = 0; blk < 16; ++blk) { const u16x4 k4 = *(const LAS u16x4*)(sl + 16 * blk + 4 * qd);
#pragma unroll
            for (int r = 0; r < 4; ++r) { int dist = t - (int)k4[r]; dist = dist > 127 ? 127 : dist;
                const float lg = st[blk][r] + biasL[dist * 16 + fr]; st[blk][r] = lg; } }
        if (ns < 256) {
#pragma unroll
            for (int blk = 0; blk < 16; ++blk)
#pragma unroll
                for (int r = 0; r < 4; ++r) if (16 * blk + 4 * qd + r >= ns) st[blk][r] = -1.0e30f; }
#pragma unroll
        for (int blk = 0; blk < 16; ++blk) mx = fmaxf(mx, fmaxf(fmaxf(st[blk][0], st[blk][1]), fmaxf(st[blk][2], st[blk][3])));
        mx = fmaxf(mx, __shfl_xor(mx, 16)); mx = fmaxf(mx, __shfl_xor(mx, 32));
        float sum = 0.f;
#pragma unroll
        for (int blk = 0; blk < 16; ++blk)
#pragma unroll
            for (int r = 0; r < 4; ++r) { const float p = __expf(st[blk][r] - mx); st[blk][r] = p; sum += p; }
        sum += __shfl_xor(sum, 16); sum += __shfl_xor(sum, 32);
        const float inv = 1.0f / sum;
        f32x4 o[4];
#pragma unroll
        for (int nb = 0; nb < 4; ++nb) o[nb] = (f32x4){0.f, 0.f, 0.f, 0.f};
#pragma unroll
        for (int vr = 0; vr < 4; ++vr) {
#pragma unroll
            for (int i = 0; i < 8; ++i) { const int piece = lane + 64 * i, row = piece >> 3, pc = piece & 7; *(LAS v4u*)(Vs + row * AT_VLD + pc * 16) = vv[i]; }
            if (vr < 3) {
#pragma unroll
                for (int i = 0; i < 8; ++i) { const int piece = lane + 64 * i, row = piece >> 3, pc = piece & 7; const int kidx = sl[64 * (vr + 1) + row];
                    vv[i] = ldg16u(KVX + rowb * 256 + 64, (unsigned)(kidx * 256 + 8 * pc) * 2u); } }
#pragma unroll
            for (int kk = 0; kk < 2; ++kk) {
                const f32x4 p0 = st[4 * vr + 2 * kk] * inv, p1 = st[4 * vr + 2 * kk + 1] * inv;
                const v4u pw = (v4u){pk2(p0[0], p0[1]), pk2(p0[2], p0[3]), pk2(p1[0], p1[1]), pk2(p1[2], p1[3])};
                const bf16x8 pa = __builtin_bit_cast(bf16x8, pw);
                const int q4 = fr >> 2, p4 = fr & 3;
#pragma unroll
                for (int nb = 0; nb < 4; ++nb) {
                    const s16x4 lo = vtr(Vs + (32 * kk + 4 * qd + q4) * AT_VLD + (16 * nb + 4 * p4) * 2);
                    const s16x4 hi = vtr(Vs + (32 * kk + 16 + 4 * qd + q4) * AT_VLD + (16 * nb + 4 * p4) * 2);
                    const bf16x8 bv = (bf16x8){lo[0], lo[1], lo[2], lo[3], hi[0], hi[1], hi[2], hi[3]};
                    o[nb] = MFMA16(pa, bv, o[nb]);
                }
            }
        }
#pragma unroll
        for (int nb = 0; nb < 4; ++nb)
#pragma unroll
            for (int r = 0; r < 4; ++r) orow[(4 * qd + r) * 64 + 16 * nb + fr] = (bf16)f2bf(o[nb][r]);
    }
    __syncthreads();
}

#ifndef PH_MASK
#define PH_MASK 0x1ff
#endif
#define PH_ON(k) (((PH_MASK) >> (k)) & 1)
#ifndef PH_DUP
#define PH_DUP 0
#endif
#define NREP(k) ((((PH_DUP) >> (k)) & 1) ? 2 : 1)
#ifndef MK_SP2
#define MK_SP2 true
#endif
#ifndef MK_ALIGN
#define MK_ALIGN true
#endif
__global__ void __launch_bounds__(NWAVES * 64, 2) hybrid_fwd(Args args) {
    extern __shared__ __attribute__((aligned(16))) unsigned char lds[];
#define MKFRAME() Frame F; F.lds = (LAS unsigned char*)lds; F.tid = opqv((int)threadIdx.x); F.lane = F.tid & 63; F.wave = __builtin_amdgcn_readfirstlane(F.tid >> 6); F.G = gridDim.x
    const int lo = args.ph_lo, hi = args.ph_hi;
    {   KArgs A = kargs(); gu32* ctl = (gu32*)(A->ws + WS_CTL); MKFRAME();
        for (int u = F.tid; u < (LDS_BYTES - LDSCTL_OFF) / 4; u += NWAVES * 64) ((LAS unsigned*)(F.lds + LDSCTL_OFF))[u] = 0u;
        __syncthreads();
        volatile LAS unsigned* MISC = (volatile LAS unsigned*)(F.lds + MISC_OFF);
        (void)xcd_barrier_post((unsigned*)(ctl + CW_BAR), MISC + 8); }
#define IN(k) (lo <= (k) && (k) < hi)
#define BOTH(k) (IN(k) && IN((k) + 1))
#define GRID_BAR() do { KArgs Ab = kargs(); XcdBarrier bar; bar.bar = (unsigned*)((gu32*)(Ab->ws + WS_CTL) + CW_BAR); bar.x = xb_xcc_id(); bar.st = (volatile LAS unsigned*)((LAS unsigned char*)lds + MISC_OFF) + 8; xcd_barrier(bar); } while (0)
#define WSP(T, off) ((T*)(ws + (off)))

    if (PH_ON(0) && IN(0)) { KArgs A = kargs(); unsigned char* ws = A->ws; MKFRAME();
        _Pragma("unroll 1") for (int rep = 0; rep < NREP(11); ++rep) convert_A(F, A, ws, 0);
        rms_rows_to_bf16(F, A->in.x, A->in.n_mix_pre, WSP(bf16, WS_HB)); if (BOTH(0)) GRID_BAR(); }

#pragma unroll 1
    for (int l = 0; l < NLAYER; ++l) {
        const int pb = 1 + 8 * l;
        if (PH_ON(1) && IN(pb)) { KArgs A = kargs(); unsigned char* ws = A->ws; MKFRAME();
            pg8::Gemm g{WSP(bf16, WS_HB), WSP(bf16, WS_WINT), M, N1P, D}; pg8::StaticOrder S; S.init(M, N1P, F.G, (int)blockIdx.x);
            pg8::EpiRoute E{WSP(bf16, WS_POOLU), WSP(bf16, WS_S5U), WSP(bf16, WS_Q), WSP(bf16, WS_QI), WSP(bf16, WS_KVX), WSP(bf16, WS_GATES)};
            _Pragma("unroll 1") for (int rep = 0; rep < NREP(1); ++rep)
            pg8::gemm_phase<pg8::EpiRoute, pg8::StaticOrder, MK_ALIGN, MK_SP2>(F.lds + RING_OFF, g, S, E);
            if (BOTH(pb)) GRID_BAR();
        }
        if (PH_ON(2) && IN(pb + 1)) { KArgs A = kargs(); unsigned char* ws = A->ws; MKFRAME();
#ifndef NO_POOL
            _Pragma("unroll 1") for (int rep = 0; rep < NREP(9); ++rep)
            pool_stencil(F, WSP(bf16, WS_POOLU), WSP(bf16, WS_DP));
#endif
#ifndef NO_S5
            _Pragma("unroll 1") for (int rep = 0; rep < NREP(10); ++rep)
#pragma unroll 1
            for (int u = blockIdx.x; u < 256; u += F.G) s5_unit(F, u & 7, u >> 3, WSP(bf16, WS_S5U), WSP(bf16, WS_S5T), WSP(bf16, WS_S5P), WSP(bf16, WS_S5Q), WSP(float, WS_S5A), WSP(bf16, WS_ZB));
#endif
#ifndef NO_ATTN
#pragma unroll 1
            for (int u4 = 4 * blockIdx.x; u4 < 1024; u4 += 4 * F.G) {
#pragma unroll 1
                for (int h = 0; h < 4; ++h) { const int u = u4 >> 2, b = u & 7, j = u >> 3;
                    const int tile = (h & 2 ? 64 : 0) + ((h & 1) ? 63 - j : j);
                    attn_unit(F, b, tile, WSP(bf16, WS_QI), WSP(bf16, WS_KVX), WSP(bf16, WS_Q), WSP(float, WS_BIAS)); } }
#endif
            if (BOTH(pb + 1)) GRID_BAR();
        }
        if (PH_ON(3) && IN(pb + 2)) {
          _Pragma("unroll 1") for (int rep = 0; rep < NREP(3); ++rep) {
            if (rep) { VM_WAIT(); __builtin_amdgcn_fence(__ATOMIC_ACQUIRE, "agent"); VM_WAIT(); __syncthreads(); }
            { KArgs A = kargs(); unsigned char* ws = A->ws; MKFRAME();
              pg8::Gemm g{WSP(bf16, WS_ZB), WSP(bf16, WS_GLUT), M, 2048, 512}; pg8::PairOrder S; S.base.init(M, D, F.G, (int)blockIdx.x);
              pg8::EpiGlu E{WSP(bf16, WS_MERGED), WSP(bf16, WS_GATES)};
              pg8::gemm_phase<pg8::EpiGlu, pg8::PairOrder, MK_ALIGN, MK_SP2>(F.lds + RING_OFF, g, S, E); }
            VM_WAIT(); __builtin_amdgcn_fence(__ATOMIC_ACQUIRE, "agent"); VM_WAIT(); __syncthreads();
            { KArgs A = kargs(); unsigned char* ws = A->ws; MKFRAME();
              pg8::Gemm g{WSP(bf16, WS_DP), WSP(bf16, WS_POOLET), M, D, 512}; pg8::StaticOrder S; S.init(M, D, F.G, (int)blockIdx.x);
              pg8::EpiAccum<0> E{WSP(bf16, WS_MERGED), WSP(bf16, WS_GATES)};
              pg8::gemm_phase<pg8::EpiAccum<0>, pg8::StaticOrder, MK_ALIGN, MK_SP2>(F.lds + RING_OFF, g, S, E); }
            VM_WAIT(); __builtin_amdgcn_fence(__ATOMIC_ACQUIRE, "agent"); VM_WAIT(); __syncthreads();
            { KArgs A = kargs(); unsigned char* ws = A->ws; MKFRAME();
              pg8::Gemm g{WSP(bf16, WS_Q), WSP(bf16, WS_ATTNOT), M, D, D}; pg8::StaticOrder S; S.init(M, D, F.G, (int)blockIdx.x);
              pg8::EpiAccum<1024> E{WSP(bf16, WS_MERGED), WSP(bf16, WS_GATES)};
              pg8::gemm_phase<pg8::EpiAccum<1024>, pg8::StaticOrder, MK_ALIGN, MK_SP2>(F.lds + RING_OFF, g, S, E); }
          }
            if (BOTH(pb + 2)) GRID_BAR();
        }
        if (PH_ON(4) && IN(pb + 3)) { KArgs A = kargs(); unsigned char* ws = A->ws; MKFRAME();
            pg8::Gemm g{WSP(bf16, WS_MERGED), WSP(bf16, WS_WOUTT), M, D, D}; pg8::StaticOrder S; S.init(M, D, F.G, (int)blockIdx.x);
            pg8::EpiF32 E{WSP(float, WS_F), D};
            _Pragma("unroll 1") for (int rep = 0; rep < NREP(4); ++rep)
            pg8::gemm_phase<pg8::EpiF32, pg8::StaticOrder, MK_ALIGN, MK_SP2>(F.lds + RING_OFF, g, S, E);
            if (BOTH(pb + 3)) GRID_BAR();
        }
        if (PH_ON(5) && IN(pb + 4)) { KArgs A = kargs(); unsigned char* ws = A->ws; MKFRAME();
            _Pragma("unroll 1") for (int rep = 0; rep < NREP(12); ++rep) convert_B(F, A, ws, l);
            _Pragma("unroll 1") for (int rep = 0; rep < ((l == 0) ? NREP(13) : 1); ++rep)
            norm_phase(F, l == 0 ? A->in.x : (const float*)A->out, A->out, WSP(float, WS_F), A->in.n_mix_post + l * D, A->in.n_ffn_pre + l * D, WSP(bf16, WS_HB));
            if (BOTH(pb + 4)) GRID_BAR();
        }
        if (PH_ON(6) && IN(pb + 5)) { KArgs A = kargs(); unsigned char* ws = A->ws; MKFRAME();
            pg8::Gemm g{WSP(bf16, WS_HB), WSP(bf16, WS_FFNINT), M, 2 * FF, D}; pg8::StaticOrder S; S.init(M, 2 * FF, F.G, (int)blockIdx.x);
            pg8::EpiSwiglu E{WSP(bf16, WS_HID), FF};
            _Pragma("unroll 1") for (int rep = 0; rep < NREP(6); ++rep)
            pg8::gemm_phase<pg8::EpiSwiglu, pg8::StaticOrder, MK_ALIGN, MK_SP2>(F.lds + RING_OFF, g, S, E);
            if (BOTH(pb + 5)) GRID_BAR();
        }
        if (PH_ON(7) && IN(pb + 6)) { KArgs A = kargs(); unsigned char* ws = A->ws; MKFRAME();
            pg8::Gemm g{WSP(bf16, WS_HID), WSP(bf16, WS_FFNOUTT), M, D, FF}; pg8::StaticOrder S; S.init(M, D, F.G, (int)blockIdx.x);
            pg8::EpiF32 E{WSP(float, WS_F), D};
            _Pragma("unroll 1") for (int rep = 0; rep < NREP(7); ++rep)
            pg8::gemm_phase<pg8::EpiF32, pg8::StaticOrder, MK_ALIGN, MK_SP2>(F.lds + RING_OFF, g, S, E);
            if (BOTH(pb + 6)) GRID_BAR();
        }
        if (PH_ON(8) && IN(pb + 7)) { KArgs A = kargs(); unsigned char* ws = A->ws; MKFRAME();
            if (l + 1 < NLAYER) { _Pragma("unroll 1") for (int rep = 0; rep < NREP(11); ++rep) convert_A(F, A, ws, l + 1); }
            norm_phase(F, (const float*)A->out, A->out, WSP(float, WS_F), A->in.n_ffn_post + l * D, (l + 1 < NLAYER) ? A->in.n_mix_pre + (l + 1) * D : (const float*)nullptr, WSP(bf16, WS_HB));
            if (BOTH(pb + 7)) GRID_BAR();
        }
    }
#undef WSP
#undef IN
#undef BOTH
#undef GRID_BAR
}

#ifndef MK_ONE_LAUNCH
#define MK_ONE_LAUNCH 1
#endif
extern "C" void kernel_launch(void* const* d_in, const int* in_sizes, int n_in, void* d_out, int out_size, void* d_ws, size_t ws_size, hipStream_t stream) {
    static int grid = 0;
    if (grid == 0) {
        if (n_in != 23 || in_sizes[0] != M * D || out_size != M * D || ws_size < WS_END) { fprintf(stderr, "kernel_launch: unexpected shapes (n_in %d, in0 %d, out %d, ws %zu); nothing launched\n", n_in, n_in > 0 ? in_sizes[0] : -1, out_size, ws_size); grid = -1; return; }
        int dev = 0, cus = 0, per_cu = 0;
        if (hipGetDevice(&dev) != hipSuccess || hipDeviceGetAttribute(&cus, hipDeviceAttributeMultiprocessorCount, dev) != hipSuccess) { grid = -1; return; }
        if (hipFuncSetAttribute((const void*)hybrid_fwd, hipFuncAttributeMaxDynamicSharedMemorySize, LDS_BYTES) != hipSuccess) { fprintf(stderr, "kernel_launch: hipFuncSetAttribute failed\n"); grid = -1; return; }
        if (hipOccupancyMaxActiveBlocksPerMultiprocessor(&per_cu, (const void*)hybrid_fwd, NWAVES * 64, LDS_BYTES) != hipSuccess || per_cu < 1) { fprintf(stderr, "kernel_launch: occupancy query says %d\n", per_cu); per_cu = 1; }
        (void)hipGetLastError();
        grid = cus;
    }
    if (grid < 0) return;
    if (hipMemsetAsync((char*)d_ws + WS_CTL, 0, CTL_ZERO_BYTES, stream) != hipSuccess) return;
    Args a{};
    const float** ip = (const float**)&a.in;
    for (int i = 0; i < 23; ++i) ip[i] = (const float*)d_in[i];
    a.out = (float*)d_out; a.ws = (unsigned char*)d_ws;
#if MK_ONE_LAUNCH
    a.ph_lo = 0; a.ph_hi = NPHASE;
    hipLaunchKernelGGL(hybrid_fwd, dim3(grid), dim3(NWAVES * 64), LDS_BYTES, stream, a);
#else
    for (int ph = 0; ph < NPHASE; ++ph) { a.ph_lo = ph; a.ph_hi = ph + 1;
        hipLaunchKernelGGL(hybrid_fwd, dim3(grid), dim3(NWAVES * 64), LDS_BYTES, stream, a); }
#endif
}
```
